# Optimizing an MI355X kernel written in HIP

```python
import jax, jax.numpy as jnp
from jax import lax
import numpy as np

D_MODEL = 1024
BATCH = 32
SEQ = 256
DEPTH = 1
DEC_BATCH = 4
DEC_SEQ = 4096
PAST_LEN = 256

GRID_W = 64
FFN_DIM = 2816
GMLP_GROUPS = 8
GMLP_GROUP_DIM = 128
GMLP_DIM = GMLP_GROUPS * GMLP_GROUP_DIM
CHUNK = 128
MLA_HEADS = 8
QK_NOPE_DIM = 128
QK_ROPE_DIM = 64
V_HEAD_DIM = 128
Q_LORA_RANK = 256
KV_LORA_RANK = 256
MLA_DIM = MLA_HEADS * V_HEAD_DIM
ROPE_BASE = 10000.0
Q_BLOCK = 128
N_MOD = 9
EPS = 1e-6
IN_DIM = 2 * GMLP_DIM + Q_LORA_RANK + KV_LORA_RANK + QK_ROPE_DIM + 2 * D_MODEL

kernel_name = "hybrid_gmlp_mla_macaron_diffusion_step"


def rms_norm(x, g):
    xf = x.astype(jnp.float32)
    y = xf * lax.rsqrt(jnp.mean(xf * xf, axis=-1, keepdims=True) + EPS)
    return (y * g.astype(jnp.float32)).astype(x.dtype)


def modulate(x, shift, scale):
    return x * (1 + scale[:, None, :]) + shift[:, None, :]


def adaln(cond, mod_w, mod_b):
    m = jax.nn.silu(cond) @ mod_w + mod_b
    return m.reshape(cond.shape[0], N_MOD, D_MODEL)


def swiglu(h, w_in, w_out):
    g, u = jnp.split(h @ w_in, 2, axis=-1)
    return (jax.nn.silu(g) * u) @ w_out


def axial_angles(L):
    rows = L // GRID_W
    r = jnp.repeat(jnp.arange(rows, dtype=jnp.float32), GRID_W)
    col = jnp.tile(jnp.arange(GRID_W, dtype=jnp.float32), rows)
    half = QK_ROPE_DIM // 2
    inv = 1.0 / (ROPE_BASE ** (jnp.arange(0, half, 2, dtype=jnp.float32) / half))
    return r[:, None] * inv, col[:, None] * inv


def rope_half(x, ang):
    x1, x2 = jnp.split(x, 2, axis=-1)
    cos, sin = jnp.cos(ang), jnp.sin(ang)
    return jnp.concatenate([x1 * cos - x2 * sin, x2 * cos + x1 * sin], axis=-1)


def axial_rope(x, ang_r, ang_c):
    xf = x.astype(jnp.float32)
    xr, xc = jnp.split(xf, 2, axis=-1)
    return jnp.concatenate([rope_half(xr, ang_r), rope_half(xc, ang_c)], axis=-1).astype(x.dtype)


def chunk_gmlp(u, v, v_norm, w_s, b_s):
    B, L, _ = u.shape
    nc = L // CHUNK
    vv = rms_norm(v, v_norm).reshape(B, nc, CHUNK, GMLP_GROUPS, GMLP_GROUP_DIM)
    mixed = jnp.einsum('gpq,bcqgd->bcpgd', w_s, vv) + b_s[:, :, None]
    return u * mixed.reshape(B, L, GMLP_DIM)


def q_up(q_lat, q_norm, w_q_up):
    B, L, _ = q_lat.shape
    q = (rms_norm(q_lat, q_norm) @ w_q_up).reshape(B, L, MLA_HEADS, QK_NOPE_DIM + QK_ROPE_DIM)
    return q[..., :QK_NOPE_DIM], q[..., QK_NOPE_DIM:]


def kv_up(ckv, w_kv_up):
    B, L, _ = ckv.shape
    kv = (ckv @ w_kv_up).reshape(B, L, MLA_HEADS, QK_NOPE_DIM + V_HEAD_DIM)
    return kv[..., :QK_NOPE_DIM], kv[..., QK_NOPE_DIM:]


def attend_block(qn, qr, kn, kr, v):
    s = jnp.einsum('bqhd,bkhd->bhqk', qn, kn) + jnp.einsum('bqhr,bkr->bhqk', qr, kr)
    s = s.astype(jnp.float32) * ((QK_NOPE_DIM + QK_ROPE_DIM) ** -0.5)
    p = jax.nn.softmax(s, axis=-1).astype(v.dtype)
    return jnp.einsum('bhqk,bkhd->bqhd', p, v)


def mla_attention(q_nope, q_rope, k_nope, k_rope, v):
    B, L = q_nope.shape[:2]
    nb = L // Q_BLOCK

    def blocks(t):
        return jnp.moveaxis(t.reshape(B, nb, Q_BLOCK, *t.shape[2:]), 1, 0)

    out = lax.map(lambda qs: attend_block(qs[0], qs[1], k_nope, k_rope, v),
                  (blocks(q_nope), blocks(q_rope)))
    return jnp.moveaxis(out, 0, 1).reshape(B, L, MLA_DIM)


def trunk_layer(x, mods, lw, ctx_ckv, ctx_krope):
    sh1, sc1, g1, sh2, sc2, g2, sh3, sc3, g3 = [mods[:, i] for i in range(N_MOD)]
    B, L, _ = x.shape
    h = modulate(rms_norm(x, lw['norm_ffn1']), sh1, sc1)
    x = x + 0.5 * g1[:, None, :] * swiglu(h, lw['ffn1_w_in'], lw['ffn1_w_out'])
    h = modulate(rms_norm(x, lw['norm_mix']), sh2, sc2)
    proj = h @ lw['w_in']
    offs = np.cumsum([GMLP_DIM, GMLP_DIM, Q_LORA_RANK, KV_LORA_RANK, QK_ROPE_DIM]).tolist()
    u, v, q_lat, ckv_raw, krope, gate_logits = jnp.split(proj, offs, axis=-1)
    out_a = chunk_gmlp(u, v, lw['gmlp_v_norm'], lw['gmlp_w_s'], lw['gmlp_b_s'])
    ckv = rms_norm(ckv_raw, lw['kv_norm'])
    q_nope, q_rope = q_up(q_lat, lw['q_norm'], lw['w_q_up'])
    k_nope, vals = kv_up(ckv, lw['w_kv_up'])
    k_rope = krope
    if ctx_ckv is not None:
        ang_r, ang_c = axial_angles(L)
        q_rope = axial_rope(q_rope, ang_r[:, None, :], ang_c[:, None, :])
        k_rope = axial_rope(krope, ang_r, ang_c)
        ck_nope, c_vals = kv_up(ctx_ckv, lw['w_kv_up'])
        k_nope = jnp.concatenate([ck_nope, k_nope], axis=1)
        vals = jnp.concatenate([c_vals, vals], axis=1)
        k_rope = jnp.concatenate([ctx_krope, k_rope], axis=1)
    out_b = mla_attention(q_nope, q_rope, k_nope, k_rope, vals)
    ga, gb = jnp.split(jax.nn.sigmoid(gate_logits), 2, axis=-1)
    merged = (ga * (out_a @ lw['w_a_proj']) + gb * (out_b @ lw['w_b_proj'])) @ lw['w_o']
    x = x + g2[:, None, :] * merged
    h = modulate(rms_norm(x, lw['norm_ffn2']), sh3, sc3)
    x = x + 0.5 * g3[:, None, :] * swiglu(h, lw['ffn2_w_in'], lw['ffn2_w_out'])
    return x, ckv, krope


def setup_inputs(seed: int = 0) -> dict:
    key = jax.random.key(seed)
    ks = iter(jax.random.split(key, 40))

    def nrm(shape, scale=1.0):
        return jax.random.normal(next(ks), shape, jnp.float32) * scale

    def gain(n):
        return 1.0 + nrm((DEPTH, n), 0.01)

    return {
        'x_prompt': nrm((BATCH, SEQ, D_MODEL)),
        'x_sample': nrm((DEC_BATCH, DEC_SEQ, D_MODEL)),
        'c': nrm((DEC_BATCH, D_MODEL)),
        'cache_ckv': nrm((DEC_BATCH, DEPTH, PAST_LEN, KV_LORA_RANK)),
        'cache_krope': nrm((DEC_BATCH, DEPTH, PAST_LEN, QK_ROPE_DIM)),
        'c_ctx': nrm((D_MODEL,)),
        'mod_w': nrm((DEPTH, D_MODEL, N_MOD * D_MODEL), 0.5 * D_MODEL ** -0.5),
        'mod_b': nrm((DEPTH, N_MOD * D_MODEL), 0.01),
        'norm_ffn1': gain(D_MODEL),
        'ffn1_w_in': nrm((DEPTH, D_MODEL, 2 * FFN_DIM), D_MODEL ** -0.5),
        'ffn1_w_out': nrm((DEPTH, FFN_DIM, D_MODEL), FFN_DIM ** -0.5),
        'norm_mix': gain(D_MODEL),
        'w_in': nrm((DEPTH, D_MODEL, IN_DIM), D_MODEL ** -0.5),
        'gmlp_v_norm': gain(GMLP_DIM),
        'gmlp_w_s': nrm((DEPTH, GMLP_GROUPS, CHUNK, CHUNK), CHUNK ** -0.5),
        'gmlp_b_s': 1.0 + nrm((DEPTH, CHUNK, GMLP_GROUPS), 0.01),
        'q_norm': gain(Q_LORA_RANK),
        'w_q_up': nrm((DEPTH, Q_LORA_RANK, MLA_HEADS * (QK_NOPE_DIM + QK_ROPE_DIM)), Q_LORA_RANK ** -0.5),
        'kv_norm': gain(KV_LORA_RANK),
        'w_kv_up': nrm((DEPTH, KV_LORA_RANK, MLA_HEADS * (QK_NOPE_DIM + V_HEAD_DIM)), KV_LORA_RANK ** -0.5),
        'w_a_proj': nrm((DEPTH, GMLP_DIM, D_MODEL), GMLP_DIM ** -0.5),
        'w_b_proj': nrm((DEPTH, MLA_DIM, D_MODEL), MLA_DIM ** -0.5),
        'w_o': nrm((DEPTH, D_MODEL, D_MODEL), D_MODEL ** -0.5),
        'norm_ffn2': gain(D_MODEL),
        'ffn2_w_in': nrm((DEPTH, D_MODEL, 2 * FFN_DIM), D_MODEL ** -0.5),
        'ffn2_w_out': nrm((DEPTH, FFN_DIM, D_MODEL), FFN_DIM ** -0.5),
        'norm_final': 1.0 + nrm((D_MODEL,), 0.01),
    }


def reference(x_prompt, x_sample, c, cache_ckv, cache_krope, c_ctx, mod_w, mod_b,
              norm_ffn1, ffn1_w_in, ffn1_w_out, norm_mix, w_in, gmlp_v_norm, gmlp_w_s,
              gmlp_b_s, q_norm, w_q_up, kv_norm, w_kv_up, w_a_proj, w_b_proj, w_o,
              norm_ffn2, ffn2_w_in, ffn2_w_out, norm_final):
    xp, xs = x_prompt, x_sample
    ckv_list, krope_list = [], []
    for l in range(DEPTH):
        lw = {
            'norm_ffn1': norm_ffn1[l], 'ffn1_w_in': ffn1_w_in[l], 'ffn1_w_out': ffn1_w_out[l],
            'norm_mix': norm_mix[l], 'w_in': w_in[l], 'gmlp_v_norm': gmlp_v_norm[l],
            'gmlp_w_s': gmlp_w_s[l], 'gmlp_b_s': gmlp_b_s[l], 'q_norm': q_norm[l],
            'w_q_up': w_q_up[l], 'kv_norm': kv_norm[l], 'w_kv_up': w_kv_up[l],
            'w_a_proj': w_a_proj[l], 'w_b_proj': w_b_proj[l], 'w_o': w_o[l],
            'norm_ffn2': norm_ffn2[l], 'ffn2_w_in': ffn2_w_in[l], 'ffn2_w_out': ffn2_w_out[l],
        }
        mods_ctx = adaln(c_ctx[None, :], mod_w[l], mod_b[l])
        xp, ckv_l, krope_l = trunk_layer(xp, mods_ctx, lw, None, None)
        ckv_list.append(ckv_l)
        krope_list.append(krope_l)
        mods_lat = adaln(c, mod_w[l], mod_b[l])
        xs, _, _ = trunk_layer(xs, mods_lat, lw, cache_ckv[:, l], cache_krope[:, l])
    y_prompt = rms_norm(xp, norm_final)
    y_sample = rms_norm(xs, norm_final)
    new_ckv = jnp.stack(ckv_list, axis=1)
    new_krope = jnp.stack(krope_list, axis=1)
    return (y_prompt, y_sample, new_ckv, new_krope)
```

```cpp
#include <hip/hip_runtime.h>
#include <cstdio>
#include <cstdint>

constexpr int DM = 1024;
constexpr int T_CTX = 8192, T_LAT = 16384, T_ALL = 24576;
constexpr int TC = 8192, NCHUNK = 3;
constexpr int FF = 2816, FF2 = 5632;
constexpr int NIN = 4864;
constexpr int NQ = 1536, NKV = 2048;
constexpr int KEYROWS = 8704;
constexpr float EPS = 1e-6f;
constexpr int NMOD = 5;
constexpr int NPH = 18;

template <int O> __device__ __forceinline__ float xor_swz(float v) {
    return __builtin_bit_cast(float, __builtin_amdgcn_ds_swizzle(__builtin_bit_cast(int, v), (O << 10) | 0x1f)); }
__device__ __forceinline__ float add_xor32(float v) {
    auto r = __builtin_amdgcn_permlane32_swap(__builtin_bit_cast(unsigned, v), __builtin_bit_cast(unsigned, v), false, false);
    const unsigned r0 = r[0], r1 = r[1];
    return __builtin_bit_cast(float, r0) + __builtin_bit_cast(float, r1); }
__device__ __forceinline__ float add_xor16(float v) {
    auto r = __builtin_amdgcn_permlane16_swap(__builtin_bit_cast(unsigned, v), __builtin_bit_cast(unsigned, v), false, false);
    const unsigned r0 = r[0], r1 = r[1];
    return __builtin_bit_cast(float, r0) + __builtin_bit_cast(float, r1); }
template <int CTRL> __device__ __forceinline__ float dpp_get(float v) {
    return __builtin_bit_cast(float, __builtin_amdgcn_update_dpp(0, __builtin_bit_cast(int, v), CTRL, 0xF, 0xF, true)); }
__device__ __forceinline__ float wave_sum(float v) {
    v += dpp_get<0xB1>(v); v += dpp_get<0x4E>(v); v += dpp_get<0x141>(v); v += dpp_get<0x140>(v); v = add_xor16(v); return add_xor32(v); }
__device__ __forceinline__ float lane_bcast(float v, int srclane) {
    return __builtin_bit_cast(float, __builtin_amdgcn_ds_bpermute(srclane << 2, __builtin_bit_cast(int, v))); }

__device__ __forceinline__ int fresh_lane() { int l; asm volatile("v_mbcnt_lo_u32_b32 %0, -1, 0\n\tv_mbcnt_hi_u32_b32 %0, -1, %0" : "=v"(l)); return l; }

namespace pg8 {
#define PG8_LAS __attribute__((address_space(3)))
typedef unsigned short bf16_t;
typedef short bf16x8 __attribute__((ext_vector_type(8)));
typedef float f32x4 __attribute__((ext_vector_type(4)));
typedef unsigned u32x4 __attribute__((ext_vector_type(4)));
constexpr int BM = 256, BK = 64, HALF = 128, HTB = HALF * BK * 2  , STAGE_BYTES = 8 * HTB, NXCD = 8, WGM = 8;

__host__ __device__ __forceinline__ int lds_byte(int r, int c) { const int st = (r >> 4) * 2 + (c >> 5), rr = r & 15, cc = c & 31, ob = rr * 64 + cc * 2; return st * 1024 + (ob ^ (((ob >> 9) & 1) << 5)); }
__host__ __device__ __forceinline__ void stage_rc(int b, int& R, int& C) { const int st = b / 1024, sb = b % 1024, swz = sb ^ (((sb >> 9) & 1) << 5); R = (st >> 1) * 16 + swz / 64; C = (st & 1) * 32 + (swz % 64) / 2; }
__host__ __device__ __forceinline__ int perm32(int rho) { const int n = rho >> 4, i = rho & 15; return 8 * (i >> 2) + 4 * n + (i & 3); }

struct Unit { int pm, pn, half; };
struct Gemm { const bf16_t* A; const bf16_t* Bt; int M, N, K, lda; };

struct StaticOrder {
    int nM, nN, nwg, G, c, pair, pm0, pn0;
    __host__ __device__ void init(int M, int N, int G_, int c_) { nM = M / BM; nN = N / BM; nwg = nM * nN; G = G_; c = c_; pair = 0; pm0 = 0; pn0 = 0; }
    __host__ __device__ __forceinline__ bool next(int i, Unit& u) const {
        if (pair) { if (i > 1) return false; u.pm = pm0; u.pn = pn0 + 4 * i; u.half = 0; return true; }
        const int rfull = nwg / G, R = nwg - rfull * G;
        if (i == rfull && R > 0 && 2 * R <= G) { if (c >= 2 * R) return false;
            const bool ok = at((long)rfull * G + (((c >> 4) << 3) | (c & 7)), u); u.half = 1 + ((c >> 3) & 1); return ok; }
        return at((long)i * G + c, u);
    }
    __host__ __device__ __forceinline__ bool at(const long L, Unit& u) const {
        if (L >= nwg) return false;
        int wgid = (int)L; { const int q = nwg / NXCD, r = nwg % NXCD, xcd = wgid % NXCD, off = wgid / NXCD; wgid = (xcd < r ? xcd * (q + 1) : r * (q + 1) + (xcd - r) * q) + off; }
        const int nig = WGM * nN, gid = wgid / nig, fm = gid * WGM, gsz = (nM - fm) < WGM ? (nM - fm) : WGM;
        u.pm = fm + ((wgid % nig) % gsz); u.pn = (wgid % nig) / gsz; u.half = 0; return true;
    }
    __device__ __forceinline__ void a_ready(const Unit&) const {}
    __device__ __forceinline__ void done(const Unit&) const {}
};

typedef float f32x2c_t __attribute__((ext_vector_type(2))); typedef __bf16 bf16x2c_t __attribute__((ext_vector_type(2)));
__device__ __forceinline__ unsigned cvt_pk_bf16(float lo, float hi) { f32x2c_t v = {lo, hi}; bf16x2c_t b = __builtin_convertvector(v, bf16x2c_t); return __builtin_bit_cast(unsigned, b); }
typedef float f32x2 __attribute__((ext_vector_type(2)));
typedef unsigned u32x2 __attribute__((ext_vector_type(2)));
__device__ __forceinline__ float silu_f(float x) { return x * __builtin_amdgcn_rcpf(1.f + __expf(-x)); }
__device__ __forceinline__ float sigm_f(float x) { return __builtin_amdgcn_rcpf(1.f + __expf(-x)); }
__device__ __forceinline__ u32x4 pack8(const f32x4 a, const f32x4 b) { u32x4 w; w.x = cvt_pk_bf16(a[0], a[1]); w.y = cvt_pk_bf16(a[2], a[3]); w.z = cvt_pk_bf16(b[0], b[1]); w.w = cvt_pk_bf16(b[2], b[3]); return w; }
__device__ __forceinline__ float bf_lo(unsigned w) { return __builtin_bit_cast(float, w << 16); }
__device__ __forceinline__ float bf_hi(unsigned w) { return __builtin_bit_cast(float, w & 0xffff0000u); }
__device__ __forceinline__ float dot4(const f32x4 x) { return (x[0] * x[0] + x[1] * x[1]) + (x[2] * x[2] + x[3] * x[3]); }
__device__ __forceinline__ int mod_index(int gpm) { return gpm < 32 ? 0 : 1 + ((gpm - 32) >> 4); }

template <int NP>
__device__ __forceinline__ void row_rstd(const float* ssp, int rbase, float invn, int fq, int lane, float (&rs)[2][4]) {
    float v[2];
#pragma unroll
    for (int ai = 0; ai < 2; ++ai) {
        const float* p = ssp + (size_t)(rbase + ai * 128 + fq * 16) * NP; float s;
        if constexpr (NP == 1) { s = p[0]; }
        else { s = 0.f;
#pragma unroll
            for (int q = 0; q < NP / 4; ++q) { const f32x4 t = *(const f32x4*)(p + 4 * q); s += (t[0] + t[1]) + (t[2] + t[3]); } }
        v[ai] = rsqrtf(s * invn + EPS);
    }
#pragma unroll
    for (int ai = 0; ai < 2; ++ai) {
        const unsigned x = __builtin_bit_cast(unsigned, v[ai]);
        auto s16 = __builtin_amdgcn_permlane16_swap(x, x, false, false); const unsigned e = s16[0], o = s16[1];
        auto se = __builtin_amdgcn_permlane32_swap(e, e, false, false); const unsigned e0 = se[0], e2 = se[1];
        auto so = __builtin_amdgcn_permlane32_swap(o, o, false, false); const unsigned o1 = so[0], o3 = so[1];
        rs[ai][0] = __builtin_bit_cast(float, e0); rs[ai][1] = __builtin_bit_cast(float, o1); rs[ai][2] = __builtin_bit_cast(float, e2); rs[ai][3] = __builtin_bit_cast(float, o3); }
    (void)lane;
}

struct EpiSwiGLU {
    static constexpr bool PERM = true, AFTER_DRAIN = false, MID = false;
    bf16_t* ACT; const float* ssp; int np; const float* bias;
    __device__ __forceinline__ void operator()(const f32x4 (&acc)[2][2][4][2], const Unit& u, int wr, int wc, int fr, int fq) const {
        const int lane = fr + 16 * fq, rl0 = u.pm * BM + wr * 64 + fr, mi = mod_index(u.pm);
        float rs[2][4];
        if (np == 1) row_rstd<1>(ssp, rl0, 1.f / DM, fq, lane, rs); else row_rstd<16>(ssp, rl0, 1.f / DM, fq, lane, rs);
        const float* bp = bias + (size_t)mi * FF2 + u.pn * BM + wc * 32 + 8 * fq;
        f32x4 bg[2], bu[2];
#pragma unroll
        for (int n = 0; n < 2; ++n) { bg[n] = *(const f32x4*)(bp + 4 * n); bu[n] = *(const f32x4*)(bp + HALF + 4 * n); }
#pragma unroll
        for (int ai = 0; ai < 2; ++ai) if (u.half != 2 - ai)
#pragma unroll
            for (int m = 0; m < 4; ++m) { const float r = rs[ai][m]; bf16_t* op = ACT + (unsigned)((rl0 + ai * HALF + m * 16) * FF + u.pn * HALF + wc * 32 + 8 * fq);
                f32x4 a[2];
#pragma unroll
                for (int n = 0; n < 2; ++n) { const f32x4 zg = acc[ai][0][m][n] * r + bg[n], zu = acc[ai][1][m][n] * r + bu[n];
#pragma unroll
                    for (int i = 0; i < 4; ++i) a[n][i] = silu_f(zg[i]) * zu[i]; }
                *(u32x4*)op = pack8(a[0], a[1]); }
    }
};

struct EpiResid {
    static constexpr bool PERM = true, AFTER_DRAIN = false, MID = false;
    const float* csb;
    const float* gate; const float* cs; int cs_stride; bf16_t* XS; float* ssp; int prow0;
    __device__ __forceinline__ void operator()(const f32x4 (&acc)[2][2][4][2], const Unit& u, int wr, int wc, int fr, int fq) const {
        const int gpm = prow0 + u.pm, mi = mod_index(gpm), grow0 = gpm * BM + wr * 64 + fr, c0 = u.pn * BM + wc * 32 + 8 * fq;
#pragma unroll
        for (int ai = 0; ai < 2; ++ai) if (u.half != 2 - ai) { float s[4] = {0.f, 0.f, 0.f, 0.f};
#pragma unroll
            for (int bj = 0; bj < 2; ++bj) {
                u32x4 w[4]; f32x4 gvb[2], cvb[2], ivb[2];
#pragma unroll
                for (int m = 0; m < 4; ++m) w[m] = *(const u32x4*)(XS + (unsigned)((grow0 + ai * HALF + m * 16) * DM + c0 + bj * HALF));
#pragma unroll
                for (int n = 0; n < 2; ++n) { gvb[n] = *(const f32x4*)(gate + mi * DM + c0 + bj * HALF + 4 * n); cvb[n] = *(const f32x4*)(cs + mi * cs_stride + c0 + bj * HALF + 4 * n);
                    ivb[n] = *(const f32x4*)(csb + mi * DM + c0 + bj * HALF + 4 * n);
#pragma unroll
                    for (int i = 0; i < 4; ++i) ivb[n][i] = ivb[n][i] == 0.f ? 0.f : __builtin_amdgcn_rcpf(ivb[n][i]); }
#pragma unroll
                for (int m = 0; m < 4; ++m) { const unsigned off = (unsigned)((grow0 + ai * HALF + m * 16) * DM + c0 + bj * HALF);
                    const f32x4 x0 = (f32x4){bf_lo(w[m][0]), bf_hi(w[m][0]), bf_lo(w[m][1]), bf_hi(w[m][1])} * ivb[0] + gvb[0] * acc[ai][bj][m][0];
                    const f32x4 x1 = (f32x4){bf_lo(w[m][2]), bf_hi(w[m][2]), bf_lo(w[m][3]), bf_hi(w[m][3])} * ivb[1] + gvb[1] * acc[ai][bj][m][1];
                    s[m] += dot4(x0) + dot4(x1);
                    *(u32x4*)(XS + off) = pack8(x0 * cvb[0], x1 * cvb[1]); }
                asm volatile("" ::: "memory");
            }
#pragma unroll
            for (int m = 0; m < 4; ++m) { float t = s[m]; t = add_xor16(t); t = add_xor32(t);
                if (fq == 0) ssp[(unsigned)((grow0 + ai * HALF + m * 16) * 16 + 4 * u.pn + wc)] = t; }
        }
    }
};

struct EpiWin {
    static constexpr bool PERM = true, AFTER_DRAIN = false, MID = false;
    const float* ssp2; const float* bias; bf16_t* OAB; bf16_t* QL_; bf16_t* CKV_; bf16_t* KR_; float* SSV_; float* SSQ_; float* SSC_; float* nckv; float* nkr; const float* rope; int chunk; long set2_bytes, ss2_bytes; int pn0;
    __device__ __forceinline__ void operator()(const f32x4 (&acc)[2][2][4][2], const Unit& u, int wr, int wc, int fr, int fq) const {
        const bool set2 = u.pm >= 32; const int pml = u.pm & 31;
        const int lane = fr + 16 * fq, rlo0 = u.pm * BM + wr * 64 + fr, rl0 = pml * BM + wr * 64 + fr, gpm = chunk * 32 + u.pm, mi = mod_index(gpm), pn = u.pn + pn0, c0 = wc * 32 + 8 * fq;
        const int kr0 = (chunk == 0 ? pml : 17 * (pml >> 4) + 1 + (pml & 15)) * BM + wr * 64 + fr;
        bf16_t* QL = (bf16_t*)((char*)QL_ + (set2 ? set2_bytes : 0)); bf16_t* CKV = (bf16_t*)((char*)CKV_ + (set2 ? set2_bytes : 0)); bf16_t* KR = (bf16_t*)((char*)KR_ + (set2 ? set2_bytes : 0));
        float* SSV = (float*)((char*)SSV_ + (set2 ? ss2_bytes : 0)); float* SSQ = (float*)((char*)SSQ_ + (set2 ? ss2_bytes : 0)); float* SSC = (float*)((char*)SSC_ + (set2 ? ss2_bytes : 0));
        float rs[2][4]; row_rstd<16>(ssp2, gpm * BM + wr * 64 + fr, 1.f / DM, fq, lane, rs);
        const float* bp = bias + (size_t)mi * NIN + pn * BM + c0;
        f32x4 bv[2][2];
#pragma unroll
        for (int bj = 0; bj < 2; ++bj)
#pragma unroll
            for (int n = 0; n < 2; ++n) bv[bj][n] = *(const f32x4*)(bp + bj * HALF + 4 * n);
        if (pn < 8) {
            bf16_t* dst = OAB + (pn < 4 ? pn * BM : DM + (pn - 4) * BM) + c0;
#pragma unroll
            for (int ai = 0; ai < 2; ++ai) if (u.half != 2 - ai)
#pragma unroll
                for (int m = 0; m < 4; ++m) { const int row = rl0 + ai * HALF + m * 16, rowo = rlo0 + ai * HALF + m * 16; const float r = rs[ai][m]; float s = 0.f;
#pragma unroll
                    for (int bj = 0; bj < 2; ++bj) { const f32x4 z0 = acc[ai][bj][m][0] * r + bv[bj][0], z1 = acc[ai][bj][m][1] * r + bv[bj][1]; s += dot4(z0) + dot4(z1);
                        *(u32x4*)(dst + (unsigned)(rowo * 2048 + bj * HALF)) = pack8(z0, z1); }
                    if (pn >= 4) { s = add_xor16(s); s = add_xor32(s); if (fq == 0) SSV[(size_t)row * 16 + 4 * (pn - 4) + wc] = s; } }
        } else if (pn == 8) {
#pragma unroll
            for (int ai = 0; ai < 2; ++ai) if (u.half != 2 - ai)
#pragma unroll
                for (int m = 0; m < 4; ++m) { const int row = rl0 + ai * HALF + m * 16; const float r = rs[ai][m]; float s = 0.f;
#pragma unroll
                    for (int bj = 0; bj < 2; ++bj) { const f32x4 z0 = acc[ai][bj][m][0] * r + bv[bj][0], z1 = acc[ai][bj][m][1] * r + bv[bj][1]; s += dot4(z0) + dot4(z1);
                        *(u32x4*)(QL + (size_t)row * 256 + bj * HALF + c0) = pack8(z0, z1); }
                    s = add_xor16(s); s = add_xor32(s); if (fq == 0) SSQ[(size_t)row * 4 + wc] = s; }
        } else if (pn == 9) {
#pragma unroll
            for (int ai = 0; ai < 2; ++ai) if (u.half != 2 - ai)
#pragma unroll
                for (int m = 0; m < 4; ++m) { const int row = rl0 + ai * HALF + m * 16, krow = kr0 + ai * HALF + m * 16; const float r = rs[ai][m]; float s = 0.f;
#pragma unroll
                    for (int bj = 0; bj < 2; ++bj) { const f32x4 z0 = acc[ai][bj][m][0] * r + bv[bj][0], z1 = acc[ai][bj][m][1] * r + bv[bj][1]; s += dot4(z0) + dot4(z1);
                        *(u32x4*)(CKV + (size_t)krow * 256 + bj * HALF + c0) = pack8(z0, z1);
                        if (chunk == 0) { *(f32x4*)(nckv + (size_t)row * 256 + bj * HALF + c0) = z0; *(f32x4*)(nckv + (size_t)row * 256 + bj * HALF + c0 + 4) = z1; } }
                    s = add_xor16(s); s = add_xor32(s); if (fq == 0) SSC[(size_t)krow * 4 + wc] = s; }
        } else if (wc < 2) {
#pragma unroll
            for (int ai = 0; ai < 2; ++ai) if (u.half != 2 - ai)
#pragma unroll
                for (int m = 0; m < 4; ++m) { const int row = rl0 + ai * HALF + m * 16, krow = kr0 + ai * HALF + m * 16; const float r = rs[ai][m];
                    const f32x4 z0 = acc[ai][0][m][0] * r + bv[0][0], z1 = acc[ai][0][m][1] * r + bv[0][1]; f32x4 o0 = z0, o1 = z1;
                    if (chunk == 0) { *(f32x4*)(nkr + (size_t)row * 64 + 32 * wc + 4 * fq) = z0; *(f32x4*)(nkr + (size_t)row * 64 + 32 * wc + 16 + 4 * fq) = z1; }
                    else { const int t = row & 4095, pos = wc == 0 ? (t >> 6) : (t & 63); const f32x4 cs_ = *(const f32x4*)(rope + pos * 16 + 4 * fq), sn_ = *(const f32x4*)(rope + 1024 + pos * 16 + 4 * fq);
                        o0 = z0 * cs_ - z1 * sn_; o1 = z1 * cs_ + z0 * sn_; }
                    *(u32x4*)(KR + (size_t)krow * 64 + 32 * wc + 8 * fq) = pack8(o0, o1); }
        }
    }
};

struct EpiQ {
    static constexpr bool PERM = true, AFTER_DRAIN = false, MID = false;
    bf16_t* Q; const float* SSQ; const float* rope; int chunk;
    __device__ __forceinline__ void operator()(const f32x4 (&acc)[2][2][4][2], const Unit& u, int wr, int wc, int fr, int fq) const {
        const int lane = fr + 16 * fq, rl0 = u.pm * BM + wr * 64 + fr;
        float rs[2][4]; row_rstd<4>(SSQ, rl0, 1.f / 256.f, fq, lane, rs);
#pragma unroll
        for (int ai = 0; ai < 2; ++ai) if (u.half != 2 - ai)
#pragma unroll
            for (int m = 0; m < 4; ++m) rs[ai][m] *= 0.10411754584f;
#pragma unroll
        for (int bj = 0; bj < 2; ++bj) { const int C32 = u.pn * BM + bj * HALF + wc * 32, w = C32 % 192; const bool rot = (w >= 128) && (chunk > 0); const bool colang = (w >= 160);
#pragma unroll
            for (int ai = 0; ai < 2; ++ai) if (u.half != 2 - ai)
#pragma unroll
                for (int m = 0; m < 4; ++m) { const int row = rl0 + ai * HALF + m * 16; const float r = rs[ai][m];
                    f32x4 z0 = acc[ai][bj][m][0] * r, z1 = acc[ai][bj][m][1] * r;
                    if (rot) { const int t = row & 4095, pos = colang ? (t & 63) : (t >> 6); const f32x4 cs_ = *(const f32x4*)(rope + pos * 16 + 4 * fq), sn_ = *(const f32x4*)(rope + 1024 + pos * 16 + 4 * fq);
                        const f32x4 o0 = z0 * cs_ - z1 * sn_, o1 = z1 * cs_ + z0 * sn_; z0 = o0; z1 = o1; }
                    *(u32x4*)(Q + (unsigned)(row * NQ + C32 + 8 * fq)) = pack8(z0, z1); } }
    }
};

struct EpiKV {
    static constexpr bool PERM = true, AFTER_DRAIN = false, MID = false;
    bf16_t* KN; bf16_t* V; const float* SSC; int chunk;
    __device__ __forceinline__ void operator()(const f32x4 (&acc)[2][2][4][2], const Unit& u, int wr, int wc, int fr, int fq) const {
        const int lane = fr + 16 * fq, rl0 = u.pm * BM + wr * 64 + fr, c0 = wc * 32 + 8 * fq;
        float rs[2][4]; row_rstd<4>(SSC, rl0, 1.f / 256.f, fq, lane, rs);
        const bool cache = (chunk > 0) && (u.pm % 17 == 0);
        bf16_t* dst = (u.pn < 4 ? KN + u.pn * BM : V + (u.pn - 4) * BM) + c0;
#pragma unroll
        for (int ai = 0; ai < 2; ++ai) if (u.half != 2 - ai)
#pragma unroll
            for (int m = 0; m < 4; ++m) { const int row = rl0 + ai * HALF + m * 16; const float r = cache ? 1.f : rs[ai][m];
#pragma unroll
                for (int bj = 0; bj < 2; ++bj) *(u32x4*)(dst + (unsigned)(row * DM + bj * HALF)) = pack8(acc[ai][bj][m][0] * r, acc[ai][bj][m][1] * r); }
    }
};

struct EpiGate {
    static constexpr bool PERM = true, AFTER_DRAIN = false, MID = false;
    const float* ssp2; const float* bias; bf16_t* G; int prow0;
    __device__ __forceinline__ void operator()(const f32x4 (&acc)[2][2][4][2], const Unit& u, int wr, int wc, int fr, int fq) const {
        const int lane = fr + 16 * fq, rl0 = u.pm * BM + wr * 64 + fr, gpm = prow0 + u.pm, mi = mod_index(gpm), c0 = u.pn * BM + wc * 32 + 8 * fq;
        float rs[2][4]; row_rstd<16>(ssp2, gpm * BM + wr * 64 + fr, 1.f / DM, fq, lane, rs);
        const float* bp = bias + (size_t)mi * NIN + 2816 + c0;
        f32x4 bv[2][2];
#pragma unroll
        for (int bj = 0; bj < 2; ++bj)
#pragma unroll
            for (int n = 0; n < 2; ++n) bv[bj][n] = *(const f32x4*)(bp + bj * HALF + 4 * n);
#pragma unroll
        for (int ai = 0; ai < 2; ++ai) if (u.half != 2 - ai)
#pragma unroll
            for (int m = 0; m < 4; ++m) { const int row = rl0 + ai * HALF + m * 16; const float r = rs[ai][m];
#pragma unroll
                for (int bj = 0; bj < 2; ++bj) { f32x4 z0 = acc[ai][bj][m][0] * r + bv[bj][0], z1 = acc[ai][bj][m][1] * r + bv[bj][1];
#pragma unroll
                    for (int i = 0; i < 4; ++i) { z0[i] = sigm_f(z0[i]); z1[i] = sigm_f(z1[i]); }
                    *(u32x4*)(G + (unsigned)(row * 2048 + bj * HALF + c0)) = pack8(z0, z1); } }
    }
};

struct EpiMerge {
    static constexpr bool PERM = true, AFTER_DRAIN = false, MID = true;
    bf16_t* G;
    __device__ __forceinline__ void mid(f32x4 (&acc)[2][2][4][2], const Unit& u, int wr, int wc, int fr, int fq) const {
        const int rl0 = u.pm * BM + wr * 64 + fr, c0 = u.pn * BM + wc * 32 + 8 * fq;
#pragma unroll
        for (int ai = 0; ai < 2; ++ai) if (u.half != 2 - ai)
#pragma unroll
            for (int mh = 0; mh < 2; ++mh) { u32x4 ga[2][2], gb[2][2];
#pragma unroll
                for (int m2 = 0; m2 < 2; ++m2) { const bf16_t* gp = G + (unsigned)((rl0 + ai * HALF + (2 * mh + m2) * 16) * 2048 + c0);
#pragma unroll
                    for (int bj = 0; bj < 2; ++bj) { ga[m2][bj] = *(const u32x4*)(gp + bj * HALF); gb[m2][bj] = *(const u32x4*)(gp + DM + bj * HALF); } }
#pragma unroll
                for (int m2 = 0; m2 < 2; ++m2)
#pragma unroll
                    for (int bj = 0; bj < 2; ++bj)
#pragma unroll
                        for (int k = 0; k < 4; ++k) { const int m = 2 * mh + m2;
                            const float r0 = bf_lo(ga[m2][bj][k]) * __builtin_amdgcn_rcpf(fmaxf(bf_lo(gb[m2][bj][k]), 1e-30f)), r1 = bf_hi(ga[m2][bj][k]) * __builtin_amdgcn_rcpf(fmaxf(bf_hi(gb[m2][bj][k]), 1e-30f));
                            acc[ai][bj][m][k >> 1][(k & 1) * 2] *= r0; acc[ai][bj][m][k >> 1][(k & 1) * 2 + 1] *= r1; }
                asm volatile("" ::: "memory"); }
    }
    __device__ __forceinline__ void operator()(const f32x4 (&acc)[2][2][4][2], const Unit& u, int wr, int wc, int fr, int fq) const {
        const int rl0 = u.pm * BM + wr * 64 + fr, c0 = u.pn * BM + wc * 32 + 8 * fq;
#pragma unroll
        for (int ai = 0; ai < 2; ++ai) if (u.half != 2 - ai) { u32x4 gb[4][2];
#pragma unroll
            for (int m = 0; m < 4; ++m)
#pragma unroll
                for (int bj = 0; bj < 2; ++bj) gb[m][bj] = *(const u32x4*)(G + (size_t)(rl0 + ai * HALF + m * 16) * 2048 + DM + c0 + bj * HALF);
#pragma unroll
            for (int m = 0; m < 4; ++m) { const size_t row = (size_t)(rl0 + ai * HALF + m * 16);
#pragma unroll
                for (int bj = 0; bj < 2; ++bj) { const u32x4 g = gb[m][bj];
                    const f32x4 g0 = {bf_lo(g[0]), bf_hi(g[0]), bf_lo(g[1]), bf_hi(g[1])}, g1 = {bf_lo(g[2]), bf_hi(g[2]), bf_lo(g[3]), bf_hi(g[3])};
                    *(u32x4*)(G + row * 2048 + c0 + bj * HALF) = pack8(acc[ai][bj][m][0] * g0, acc[ai][bj][m][1] * g1); } }
            asm volatile("" ::: "memory"); }
    }
};

template <class Epi, class Sched, bool ALIGN_EPI = false, bool SP2 = false>
__device__ __forceinline__ void gemm_phase(PG8_LAS unsigned char* lds, const Gemm g, const Sched& S, const Epi& E, const int wave_s) {
    int wid_ = wave_s; asm volatile("" : "+s"(wid_));
    const int lane = fresh_lane(), wid = wid_, tid = wid * 64 + lane, wr = wid >> 2, wc = wid & 3, fr = lane & 15, fq = lane >> 4;
    const int K = g.K, nt = K / BK, LDA = g.lda;
    unsigned voffA[2], voffB[2];
#pragma unroll
    for (int i = 0; i < 2; ++i) { int R, C; stage_rc(tid * 16 + i * 8192, R, C); const int Rb = Epi::PERM ? ((R & ~31) + perm32(R & 31)) : R;
        voffA[i] = (unsigned)(R * LDA + C) * 2u; voffB[i] = (unsigned)(Rb * K + C) * 2u; }
    const size_t kstep = (size_t)(BK * 2);
    const size_t hstepB = (size_t)HALF * K * 2, tstepB = 2 * hstepB;
    const size_t hstepA = (size_t)HALF * LDA * 2, tstepA = 2 * hstepA;
    const unsigned ldsw = (unsigned)wid * 1024u;
    const int aoff = lds_byte(wr * 64 + fr, fq * 8), boff = lds_byte(wc * 32 + fr, fq * 8);
#define PG8_SA(b, h) (((b) * 2 + (h)) * HTB)
#define PG8_SB(b, h) ((4 + (b) * 2 + (h)) * HTB)
#define PG8_STAGE(bufoff, gbase, voff) do { _Pragma("unroll") for (int _i = 0; _i < 2; ++_i) \
        __builtin_amdgcn_global_load_lds((const unsigned*)((const char*)(gbase) + (voff)[_i]), (PG8_LAS unsigned*)(lds + (bufoff) + ldsw + _i * 8192), 16, 0, 0); } while (0)
#define PG8_LDA(dst, b, h) do { _Pragma("unroll") for (int m = 0; m < 4; ++m) _Pragma("unroll") for (int k = 0; k < 2; ++k) dst[m][k] = *(const PG8_LAS bf16x8*)(lds + PG8_SA(b, h) + aoff + m * 2048 + k * 1024); } while (0)
#define PG8_LDB(dst, b, h) do { _Pragma("unroll") for (int n = 0; n < 2; ++n) _Pragma("unroll") for (int k = 0; k < 2; ++k) dst[n][k] = *(const PG8_LAS bf16x8*)(lds + PG8_SB(b, h) + boff + n * 2048 + k * 1024); } while (0)
#define PG8_MMA(ai, bj, At, Bt) do { __builtin_amdgcn_s_setprio(1); _Pragma("unroll") for (int m = 0; m < 4; ++m) _Pragma("unroll") for (int n = 0; n < 2; ++n) _Pragma("unroll") for (int k = 0; k < 2; ++k) \
        acc[ai][bj][m][n] = __builtin_amdgcn_mfma_f32_16x16x32_bf16(Bt[n][k], At[m][k], acc[ai][bj][m][n], 0, 0, 0); __builtin_amdgcn_s_setprio(0); } while (0)
#define PG8_WAIT_V(n) asm volatile("s_waitcnt vmcnt(" #n ")" ::: "memory")
#define PG8_WAIT_L(n) asm volatile("s_waitcnt lgkmcnt(" #n ")" ::: "memory")
#define PG8_BAR __builtin_amdgcn_s_barrier()
#define PG8_SCHED __builtin_amdgcn_sched_barrier(0)
    Unit cur, nxt; int ui = 0;
    if (!S.next(0, cur)) return;
    f32x4 acc[2][2][4][2];
#pragma unroll
    for (int a = 0; a < 2; ++a)
#pragma unroll
        for (int b = 0; b < 2; ++b)
#pragma unroll
            for (int m = 0; m < 4; ++m)
#pragma unroll
                for (int n = 0; n < 2; ++n) acc[a][b][m][n] = (f32x4){0.f, 0.f, 0.f, 0.f};
    bf16x8 At[4][2], B0[2][2], B1[2][2];
    const char* cA = (const char*)g.A + (size_t)cur.pm * tstepA; const char* cB = (const char*)g.Bt + (size_t)cur.pn * tstepB;
    S.a_ready(cur);
    if constexpr (SP2) {
        PG8_STAGE(PG8_SB(0, 0), cB, voffB); PG8_STAGE(PG8_SB(0, 1), cB + hstepB, voffB); PG8_STAGE(PG8_SA(0, 0), cA, voffA); PG8_STAGE(PG8_SA(0, 1), cA + hstepA, voffA);
        if (wr == 1) PG8_BAR;
        PG8_WAIT_V(2); PG8_BAR;
        PG8_STAGE(PG8_SB(1, 0), cB + kstep, voffB); PG8_STAGE(PG8_SA(1, 0), cA + kstep, voffA); PG8_STAGE(PG8_SB(1, 1), cB + hstepB + kstep, voffB);
        PG8_WAIT_V(6); PG8_BAR;
    } else {
        PG8_STAGE(PG8_SB(0, 0), cB, voffB); PG8_STAGE(PG8_SA(0, 0), cA, voffA); PG8_STAGE(PG8_SB(0, 1), cB + hstepB, voffB); PG8_STAGE(PG8_SA(0, 1), cA + hstepA, voffA);
        if (wr == 1) PG8_BAR;
        PG8_WAIT_V(4); PG8_BAR;
        PG8_STAGE(PG8_SB(1, 0), cB + kstep, voffB); PG8_STAGE(PG8_SA(1, 0), cA + kstep, voffA); PG8_STAGE(PG8_SB(1, 1), cB + hstepB + kstep, voffB);
        PG8_WAIT_V(6); PG8_BAR;
    }
    for (;;) {
        const bool has_next = S.next(ui + 1, nxt);
        const char* nA = has_next ? (const char*)g.A + (size_t)nxt.pm * tstepA : cA; const char* nB = has_next ? (const char*)g.Bt + (size_t)nxt.pn * tstepB : cB;
        const bool do0 = cur.half != 2, do1 = cur.half != 1;
#pragma unroll 1
        for (int t = 0; t < nt; t += 2) {
            if constexpr (Epi::MID) { if (__builtin_expect(t == (nt >> 1), 0)) { const int l2 = fresh_lane(); E.mid(acc, cur, wr, wc, l2 & 15, l2 >> 4); } }
            const bool last = (t == nt - 2);
            const char* a1 = cA + (size_t)(t + 1) * kstep;
            const char* a2 = last ? nA : cA + (size_t)(t + 2) * kstep; const char* b2 = last ? nB : cB + (size_t)(t + 2) * kstep;
            const char* a3 = a2 + kstep; const char* b3 = b2 + kstep;
            if (last && has_next) S.a_ready(nxt);
            if constexpr (SP2) {
            PG8_LDB(B0, 0, 0); PG8_LDB(B1, 0, 1); PG8_SCHED; if (do0) PG8_LDA(At, 0, 0); PG8_STAGE(PG8_SA(1, 1), a1 + hstepA, voffA);
            PG8_WAIT_V(8); PG8_WAIT_L(0); PG8_BAR; if (do0) { PG8_MMA(0, 0, At, B0); PG8_MMA(0, 1, At, B1); } PG8_BAR; PG8_SCHED;
            if (do1) PG8_LDA(At, 0, 1); PG8_STAGE(PG8_SB(0, 0), b2, voffB); PG8_STAGE(PG8_SB(0, 1), b2 + hstepB, voffB); PG8_STAGE(PG8_SA(0, 0), a2, voffA);
            PG8_WAIT_V(8); PG8_WAIT_L(0); PG8_BAR; if (do1) { PG8_MMA(1, 0, At, B0); PG8_MMA(1, 1, At, B1); } PG8_BAR; PG8_SCHED;
            PG8_LDB(B0, 1, 0); PG8_LDB(B1, 1, 1); PG8_SCHED; if (do0) PG8_LDA(At, 1, 0); PG8_STAGE(PG8_SA(0, 1), a2 + hstepA, voffA);
            PG8_WAIT_V(8); PG8_WAIT_L(0); PG8_BAR; if (do0) { PG8_MMA(0, 0, At, B0); PG8_MMA(0, 1, At, B1); } PG8_BAR; PG8_SCHED;
            if (do1) PG8_LDA(At, 1, 1); PG8_STAGE(PG8_SB(1, 0), b3, voffB); PG8_STAGE(PG8_SB(1, 1), b3 + hstepB, voffB); PG8_STAGE(PG8_SA(1, 0), a3, voffA);
            PG8_WAIT_V(8); PG8_WAIT_L(0); PG8_BAR; if (do1) { PG8_MMA(1, 0, At, B0); PG8_MMA(1, 1, At, B1); } PG8_BAR; PG8_SCHED;
            } else {
            PG8_LDB(B0, 0, 0); PG8_SCHED; PG8_LDA(At, 0, 0); PG8_STAGE(PG8_SA(1, 1), a1 + hstepA, voffA);
            PG8_WAIT_L(8); PG8_BAR; PG8_WAIT_L(0); PG8_MMA(0, 0, At, B0); PG8_BAR; PG8_SCHED;
            PG8_LDB(B1, 0, 1); PG8_STAGE(PG8_SB(0, 0), b2, voffB);
            PG8_BAR; PG8_WAIT_L(0); PG8_MMA(0, 1, At, B1); PG8_BAR;
            PG8_LDA(At, 0, 1); PG8_STAGE(PG8_SA(0, 0), a2, voffA);
            PG8_BAR; PG8_WAIT_L(0); PG8_MMA(1, 0, At, B0); PG8_BAR; PG8_SCHED;
            PG8_STAGE(PG8_SB(0, 1), b2 + hstepB, voffB);
            PG8_WAIT_V(6); PG8_BAR; PG8_MMA(1, 1, At, B1); PG8_BAR;
            PG8_LDB(B0, 1, 0); PG8_SCHED; PG8_LDA(At, 1, 0); PG8_STAGE(PG8_SA(0, 1), a2 + hstepA, voffA);
            PG8_WAIT_L(8); PG8_BAR; PG8_WAIT_L(0); PG8_MMA(0, 0, At, B0); PG8_BAR; PG8_SCHED;
            PG8_LDB(B1, 1, 1); PG8_STAGE(PG8_SB(1, 0), b3, voffB);
            PG8_BAR; PG8_WAIT_L(0); PG8_MMA(0, 1, At, B1); PG8_BAR;
            PG8_LDA(At, 1, 1); PG8_STAGE(PG8_SA(1, 0), a3, voffA);
            PG8_BAR; PG8_WAIT_L(0); PG8_MMA(1, 0, At, B0); PG8_BAR; PG8_SCHED;
            PG8_STAGE(PG8_SB(1, 1), b3 + hstepB, voffB);
            PG8_WAIT_V(6); PG8_BAR; PG8_MMA(1, 1, At, B1); PG8_BAR;
            }
        }
        if constexpr (ALIGN_EPI) { if (wr == 0) PG8_BAR; }
        if constexpr (!Epi::AFTER_DRAIN) { const int l2 = fresh_lane(); E(acc, cur, wr, wc, l2 & 15, l2 >> 4); S.done(cur); }
        if (!has_next) break;
#pragma unroll
        for (int a = 0; a < 2; ++a)
#pragma unroll
            for (int b = 0; b < 2; ++b)
#pragma unroll
                for (int m = 0; m < 4; ++m)
#pragma unroll
                    for (int n = 0; n < 2; ++n) acc[a][b][m][n] = (f32x4){0.f, 0.f, 0.f, 0.f};
        cur = nxt; cA = nA; cB = nB; ++ui;
        if constexpr (ALIGN_EPI) { if (wr == 1) PG8_BAR; }
    }
    PG8_WAIT_V(0);
    if constexpr (!ALIGN_EPI) { if (wr == 0) PG8_BAR; }
    PG8_BAR;
    if constexpr (Epi::AFTER_DRAIN) { E.fused(acc, cur, wr, wc, fr, fq, lds, wid, lane); S.done(cur); }
#undef PG8_SA
#undef PG8_SB
#undef PG8_STAGE
#undef PG8_LDA
#undef PG8_LDB
#undef PG8_MMA
#undef PG8_WAIT_V
#undef PG8_WAIT_L
#undef PG8_BAR
#undef PG8_SCHED
}
}
namespace att {
typedef unsigned short bf16_t;
using bf16x8 = __attribute__((ext_vector_type(8))) short;
using s16x4  = __attribute__((ext_vector_type(4))) short;
using f32x16 = __attribute__((ext_vector_type(16))) float;
using u32x4  = __attribute__((ext_vector_type(4))) unsigned;
constexpr int NW = 8, QBLK = 32, KVBLK = 64;
constexpr int LDQ = 1536, LDKN = 1024, LDKR = 64, LDV = 1024, LDO = 2048;
constexpr float SCALE = 0.072168783648703220f;
constexpr float THR = 8.f;
constexpr int SHM_V = KVBLK * 128 * 2, SHM_KN = KVBLK * 128 * 2, SHM_KR = KVBLK * 64 * 2;
constexpr int STG = SHM_V + SHM_KN + SHM_KR, OFF_V = 0, OFF_KN = SHM_V, OFF_KR = SHM_V + SHM_KN, OFF_WS = 3 * STG, SHM_ATTN = OFF_WS + NW * 64 * 4;
typedef __attribute__((address_space(3))) unsigned lds_u32;
#define KSWZ(row, colB) ((row) * 256 + ((colB) ^ (((row) & 15) << 4)))
#define KRSWZ(row, colB) ((row) * 128 + ((colB) ^ ((((row) >> 1) & 7) << 4)))
#define SBAR() __builtin_amdgcn_sched_barrier(0)
__device__ __forceinline__ int crow(int r, int hi) { return (r & 3) + 8 * (r >> 2) + 4 * hi; }
typedef float f32x2a_t __attribute__((ext_vector_type(2))); typedef __bf16 bf16x2a_t __attribute__((ext_vector_type(2)));
__device__ __forceinline__ unsigned cvtpk(float lo, float hi) { f32x2a_t v = {lo, hi}; bf16x2a_t b = __builtin_convertvector(v, bf16x2a_t); return __builtin_bit_cast(unsigned, b); }

constexpr float THRL = THR * 1.4426950408889634f;
#define MX3(a, b, c) fmaxf(fmaxf((a), (b)), (c))
__device__ __forceinline__ void partialSM(f32x16& p0, f32x16& p1, float& m_reg, float& alpha) {
  float a = MX3(p0[0], p0[1], p1[0]), b = MX3(p0[2], p0[3], p1[1]); a = MX3(a, p1[2], p1[3]);
#pragma unroll
  for (int r = 4; r < 16; r += 4) { a = MX3(a, p0[r], p0[r + 1]); b = MX3(b, p0[r + 2], p0[r + 3]); a = MX3(a, p1[r], p1[r + 1]); b = MX3(b, p1[r + 2], p1[r + 3]); }
  float pmax = fmaxf(a, b);
  { auto rr = __builtin_amdgcn_permlane32_swap(__float_as_uint(pmax), __float_as_uint(pmax), false, false);
    pmax = fmaxf(__uint_as_float(rr[0]), __uint_as_float(rr[1])); }
  if (__builtin_expect(__all(pmax <= THRL), 1)) { alpha = 1.f; }
  else { const float d = fmaxf(pmax, 0.f); for (int r = 0; r < 16; ++r) { p0[r] -= d; p1[r] -= d; } m_reg += d; alpha = __builtin_amdgcn_exp2f(-d); }
  for (int r = 0; r < 16; ++r) p0[r] = __builtin_amdgcn_exp2f(p0[r]);
}
#undef MX3
__device__ __forceinline__ void finishSM(f32x16& p0, f32x16& p1, float alpha, float& l_reg, bf16x8& pa0, bf16x8& pa1, bf16x8& pa2, bf16x8& pa3) {
  for (int r = 0; r < 16; ++r) p1[r] = __builtin_amdgcn_exp2f(p1[r]);
  float ps = 0; for (int r = 0; r < 16; ++r) ps += p0[r]; for (int r = 0; r < 16; ++r) ps += p1[r];
  { auto rr = __builtin_amdgcn_permlane32_swap(__float_as_uint(ps), __float_as_uint(ps), false, false);
    ps = __uint_as_float(rr[0]) + __uint_as_float(rr[1]); }
  l_reg = l_reg * alpha + ps;
#define PK4(P, BASE, OUT) do { unsigned a0 = cvtpk(P[BASE + 0], P[BASE + 1]), a1 = cvtpk(P[BASE + 2], P[BASE + 3]);   \
    unsigned b0 = cvtpk(P[BASE + 4], P[BASE + 5]), b1 = cvtpk(P[BASE + 6], P[BASE + 7]);                              \
    auto r0 = __builtin_amdgcn_permlane32_swap(a0, b0, false, false); auto r1 = __builtin_amdgcn_permlane32_swap(a1, b1, false, false); \
    u32x4 w = {r0[0], r1[0], r0[1], r1[1]}; OUT = *reinterpret_cast<bf16x8*>(&w); } while (0)
  PK4(p0, 0, pa0); PK4(p0, 8, pa1); PK4(p1, 0, pa2); PK4(p1, 8, pa3);
#undef PK4
}
__device__ __forceinline__ void qkt(f32x16& p0, f32x16& p1, const char* KNs, const char* KRs, const bf16x8* qr, int r32, int hi, float negm) {
#pragma unroll
  for (int r = 0; r < 16; ++r) { p0[r] = negm; p1[r] = negm; }
#pragma unroll
  for (int d0 = 0; d0 < 8; ++d0) { int cb = (d0 * 16 + hi * 8) * 2;
    bf16x8 b0 = *reinterpret_cast<const bf16x8*>(KNs + KSWZ(r32, cb));
    bf16x8 b1 = *reinterpret_cast<const bf16x8*>(KNs + KSWZ(32 + r32, cb));
    p0 = __builtin_amdgcn_mfma_f32_32x32x16_bf16(b0, qr[d0], p0, 0, 0, 0);
    p1 = __builtin_amdgcn_mfma_f32_32x32x16_bf16(b1, qr[d0], p1, 0, 0, 0); }
#pragma unroll
  for (int d0 = 0; d0 < 4; ++d0) { int cb = (d0 * 16 + hi * 8) * 2;
    bf16x8 b0 = *reinterpret_cast<const bf16x8*>(KRs + KRSWZ(r32, cb));
    bf16x8 b1 = *reinterpret_cast<const bf16x8*>(KRs + KRSWZ(32 + r32, cb));
    p0 = __builtin_amdgcn_mfma_f32_32x32x16_bf16(b0, qr[8 + d0], p0, 0, 0, 0);
    p1 = __builtin_amdgcn_mfma_f32_32x32x16_bf16(b1, qr[8 + d0], p1, 0, 0, 0); }
}
__device__ __forceinline__ int v_st(int k, int c) { const int kk = (k & ~0xC) | ((k & 4) << 1) | ((k & 8) >> 1); return ((kk >> 3) * 4 + (c >> 5)) * 512 + ((kk & 7) * 32 + (c & 31)) * 2; }
__device__ __forceinline__ int v_rd_base(int lane) { return ((lane & 3) << 3) | (((lane >> 2) & 3) << 6) | (((lane >> 4) & 1) << 5) | (((lane >> 5) & 1) << 8); }
constexpr int v_rd_off(int d0, int ks, int half) { return d0 * 512 + ks * 4096 + half * 2048; }
template <int OFF> __device__ __forceinline__ s16x4 tr_read(int vb) {
  s16x4 r; asm volatile("ds_read_b64_tr_b16 %0, %1 offset:%2" : "=&v"(r) : "v"(vb), "i"(OFF) : "memory"); return r;
}
template <int D0> __device__ __forceinline__ void pv_one(f32x16& od, int vb, bf16x8 pa0, bf16x8 pa1, bf16x8 pa2, bf16x8 pa3) {
  const s16x4 l0 = tr_read<v_rd_off(D0, 0, 0)>(vb), h0 = tr_read<v_rd_off(D0, 0, 1)>(vb), l1 = tr_read<v_rd_off(D0, 1, 0)>(vb), h1 = tr_read<v_rd_off(D0, 1, 1)>(vb);
  const s16x4 l2 = tr_read<v_rd_off(D0, 2, 0)>(vb), h2 = tr_read<v_rd_off(D0, 2, 1)>(vb), l3 = tr_read<v_rd_off(D0, 3, 0)>(vb), h3 = tr_read<v_rd_off(D0, 3, 1)>(vb);
  asm volatile("s_waitcnt lgkmcnt(0)" ::: "memory"); SBAR();
#define PK(L, H) (bf16x8){L[0], L[1], L[2], L[3], H[0], H[1], H[2], H[3]}
  od = __builtin_amdgcn_mfma_f32_32x32x16_bf16(pa0, PK(l0, h0), od, 0, 0, 0);
  od = __builtin_amdgcn_mfma_f32_32x32x16_bf16(pa1, PK(l1, h1), od, 0, 0, 0);
  od = __builtin_amdgcn_mfma_f32_32x32x16_bf16(pa2, PK(l2, h2), od, 0, 0, 0);
  od = __builtin_amdgcn_mfma_f32_32x32x16_bf16(pa3, PK(l3, h3), od, 0, 0, 0);
#undef PK
}
__device__ __forceinline__ void pv_d0(f32x16* o, int vb, bf16x8 pa0, bf16x8 pa1, bf16x8 pa2, bf16x8 pa3) {
  pv_one<0>(o[0], vb, pa0, pa1, pa2, pa3); pv_one<1>(o[1], vb, pa0, pa1, pa2, pa3); pv_one<2>(o[2], vb, pa0, pa1, pa2, pa3); pv_one<3>(o[3], vb, pa0, pa1, pa2, pa3);
}
__device__ __forceinline__ unsigned short f2bf(float f) { unsigned u = __builtin_bit_cast(unsigned, f); return (unsigned short)((u + 0x7fffu + ((u >> 16) & 1u)) >> 16); }

__device__ __forceinline__ void attn_unit(const bf16_t* __restrict__ Qb, const bf16_t* __restrict__ KNh, const bf16_t* __restrict__ KRb, const bf16_t* __restrict__ Vh,
                                          bf16_t* __restrict__ Ob, int seq, char* lds, const int wave_s) {
  int wid_ = wave_s; asm volatile("" : "+s"(wid_));
  const int lane = fresh_lane(), wid = wid_, tid = wid * 64 + lane, r32 = lane & 31, hi = lane >> 5;
  float* ws = (float*)(lds + OFF_WS) + wid * 64; float* li_l = ws; float* al_l = ws + 32;
  float m_reg = 0.f, l_reg = 0; f32x16 o[4] = {}; bf16x8 qr[12];
  const bf16_t* Qw = Qb + (long)(wid * QBLK + r32) * LDQ + hi * 8;
#pragma unroll
  for (int d0 = 0; d0 < 12; ++d0) qr[d0] = *reinterpret_cast<const bf16x8*>(Qw + d0 * 16);
  unsigned voV, voK, voR;
  { const int sub = tid >> 5, within = tid & 31, kk = (sub >> 2) * 8 + (within >> 2), c = (sub & 3) * 32 + (within & 3) * 8, k = (kk & ~0xC) | ((kk & 4) << 1) | ((kk & 8) >> 1);
    voV = (unsigned)(k * LDV + c) * 2u;
    const int row = tid >> 4, slot = tid & 15; voK = (unsigned)(row * LDKN * 2 + ((slot << 4) ^ ((row & 15) << 4)));
    const int rr = tid >> 3, sl = tid & 7; voR = (unsigned)(rr * LDKR * 2 + ((sl << 4) ^ (((rr >> 1) & 7) << 4))); }
  const lds_u32* ldsL_ = (const lds_u32*)(lds); (void)ldsL_;
  const int vb0 = (int)(uintptr_t)lds + OFF_V + v_rd_base(lane);
  const int ldsw = wid * 1024;
#define DMA1(src, dstoff) __builtin_amdgcn_global_load_lds((const unsigned*)(src), (lds_u32*)(lds + (dstoff)), 16, 0, 0)
#define ISSUE(st, k0) do { const char* vb_ = (const char*)Vh + (size_t)(k0) * (LDV * 2); const char* kb_ = (const char*)KNh + (size_t)(k0) * (LDKN * 2); const char* rb_ = (const char*)KRb + (size_t)(k0) * (LDKR * 2); \
    DMA1(kb_ + voK, (st) + OFF_KN + ldsw); DMA1(kb_ + 32 * LDKN * 2 + voK, (st) + OFF_KN + 8192 + ldsw); DMA1(rb_ + voR, (st) + OFF_KR + ldsw); \
    DMA1(vb_ + voV, (st) + OFF_V + ldsw); DMA1(vb_ + 32 * LDV * 2 + voV, (st) + OFF_V + 8192 + ldsw); } while (0)
#define TOP() do { asm volatile("s_waitcnt vmcnt(0) lgkmcnt(0)" ::: "memory"); __builtin_amdgcn_s_barrier(); SBAR(); } while (0)
#define RESC(a) do { if (__any((a) < 1.f)) { if (hi == 0) al_l[r32] = (a); asm volatile("s_waitcnt lgkmcnt(0)" ::: "memory"); \
    for (int d = 0; d < 4; ++d) for (int r = 0; r < 16; ++r) o[d][r] *= al_l[crow(r, hi)]; } } while (0)
#define ROT() do { sV = sK; sK = sN; sN = (sN == 2 * STG) ? 0 : sN + STG; } while (0)
  f32x16 pA0, pA1, pB0, pB1; float alA, alB; bf16x8 pa0, pa1, pa2, pa3; const int NT = seq / KVBLK;
  ISSUE(0, 0); ISSUE(STG, KVBLK);
  asm volatile("s_waitcnt vmcnt(5)" ::: "memory"); __builtin_amdgcn_s_barrier(); SBAR();
  qkt(pA0, pA1, lds + OFF_KN, lds + OFF_KR, qr, r32, hi, -m_reg); partialSM(pA0, pA1, m_reg, alA);
  int sV = 0, sK = STG, sN = 2 * STG;
  for (int j = 1; j + 1 < NT; j += 2) {
    TOP(); ISSUE(sN, (j + 1) * KVBLK); SBAR();
    qkt(pB0, pB1, lds + sK + OFF_KN, lds + sK + OFF_KR, qr, r32, hi, -m_reg);
    finishSM(pA0, pA1, alA, l_reg, pa0, pa1, pa2, pa3); SBAR();
    pv_d0(o, vb0 + sV, pa0, pa1, pa2, pa3); partialSM(pB0, pB1, m_reg, alB);
    RESC(alB); ROT();
    TOP(); if (j + 2 < NT) ISSUE(sN, (j + 2) * KVBLK); SBAR();
    qkt(pA0, pA1, lds + sK + OFF_KN, lds + sK + OFF_KR, qr, r32, hi, -m_reg);
    finishSM(pB0, pB1, alB, l_reg, pa0, pa1, pa2, pa3); SBAR();
    pv_d0(o, vb0 + sV, pa0, pa1, pa2, pa3); partialSM(pA0, pA1, m_reg, alA);
    RESC(alA); ROT();
  }
  TOP();
  qkt(pB0, pB1, lds + sK + OFF_KN, lds + sK + OFF_KR, qr, r32, hi, -m_reg);
  finishSM(pA0, pA1, alA, l_reg, pa0, pa1, pa2, pa3); SBAR();
  pv_d0(o, vb0 + sV, pa0, pa1, pa2, pa3); partialSM(pB0, pB1, m_reg, alB);
  RESC(alB);
  finishSM(pB0, pB1, alB, l_reg, pa0, pa1, pa2, pa3); SBAR();
  pv_d0(o, vb0 + sK, pa0, pa1, pa2, pa3);
  if (hi == 0) li_l[r32] = l_reg; asm volatile("s_waitcnt lgkmcnt(0)" ::: "memory");
  const int lane2 = fresh_lane(), r32e = lane2 & 31, hie = lane2 >> 5;
  float rli[16];
#pragma unroll
  for (int r = 0; r < 16; ++r) rli[r] = __builtin_amdgcn_rcpf(li_l[crow(r, hie)]);
  __syncthreads();
  bf16_t* stg = (bf16_t*)lds + wid * 4096;
#pragma unroll
  for (int r = 0; r < 16; ++r) { const int orow = crow(r, hie);
#pragma unroll
    for (int d0 = 0; d0 < 4; ++d0) stg[orow * 128 + d0 * 32 + r32e] = f2bf(o[d0][r] * rli[r]); }
  asm volatile("s_waitcnt lgkmcnt(0)" ::: "memory");
#pragma unroll
  for (int i = 0; i < 8; ++i) { const int row = i * 4 + (lane2 >> 4), ch = lane2 & 15; const u32x4 v = *(const u32x4*)(stg + row * 128 + ch * 8);
    *(u32x4*)(Ob + (long)(wid * QBLK + row) * LDO + ch * 8) = v; }
  __syncthreads();
#undef DMA1
#undef ISSUE
#undef TOP
#undef RESC
#undef ROT
}
#undef KSWZ
#undef KRSWZ
#undef SBAR
}

constexpr int NWAVES = 8;
constexpr size_t MiB = 1u << 20;
constexpr size_t WS_CTL = 0;
constexpr size_t WS_MODS  = 1 * MiB;
constexpr size_t WS_TAB   = WS_MODS + 256 * 1024;
constexpr size_t WS_BIAS1 = WS_TAB + 128 * 1024;
constexpr size_t WS_BIAS2 = WS_BIAS1 + 128 * 1024;
constexpr size_t WS_BIAS3 = WS_BIAS2 + 128 * 1024;
constexpr size_t WS_ROPE  = WS_BIAS3 + 128 * 1024;
constexpr size_t WS_SS1   = WS_ROPE + 64 * 1024;
constexpr size_t WS_SSP2  = 2 * MiB;
constexpr size_t WS_SSP3  = WS_SSP2 + (size_t)T_ALL * 64;
constexpr size_t WS_SSPF  = WS_SSP3 + (size_t)T_ALL * 64;
constexpr size_t WS_SSV   = WS_SSPF + (size_t)T_ALL * 64;
constexpr size_t WS_SSQ   = WS_SSV + (size_t)TC * 64;
constexpr size_t WS_SSC   = WS_SSQ + (size_t)TC * 16;
static_assert(WS_SS1 + (size_t)T_ALL * 4 <= WS_SSP2 && WS_SSC + (size_t)KEYROWS * 16 <= 8 * MiB, "small tables");
constexpr size_t WS_W     = 8 * MiB;
constexpr size_t W_1IN = 0, W_1OUT = W_1IN + (size_t)FF2 * DM * 2, W_IN = W_1OUT + (size_t)DM * FF * 2, W_Q = W_IN + (size_t)NIN * DM * 2, W_KV = W_Q + (size_t)NQ * 256 * 2,
                 W_AB = W_KV + (size_t)NKV * 256 * 2, W_O = W_AB + (size_t)DM * 2048 * 2, W_2IN = W_O + (size_t)DM * DM * 2, W_2OUT = W_2IN + (size_t)FF2 * DM * 2, W_S = W_2OUT + (size_t)DM * FF * 2,
                 W_END = W_S + (size_t)8 * 128 * 128 * 2;
constexpr size_t WS_XS    = 59 * MiB;
static_assert(WS_W + W_END <= WS_XS, "weights");
constexpr size_t WS_BIG   = 107 * MiB;
constexpr size_t B_OAB = 0  , B_OAB2 = 32 * MiB  , B_G = 64 * MiB  , B_Q = 64 * MiB, B_KN = 88 * MiB, B_V = 105 * MiB, B_QL = 122 * MiB, B_CKV = 126 * MiB, B_KR = B_CKV + (size_t)KEYROWS * 256 * 2;
constexpr size_t B_QL0 = 32 * MiB, B_CKV0 = 36 * MiB, B_KR0 = 143 * MiB;
constexpr size_t B_SET2 = 10 * MiB;
constexpr size_t B_SS2 = 142 * MiB;
constexpr size_t WS_END = WS_BIG + 144 * MiB;
static_assert(B_KR + B_SET2 + (size_t)KEYROWS * 64 * 2 <= B_SS2 && WS_END <= 256 * MiB && B_KR + (size_t)KEYROWS * 64 * 2 <= 132 * MiB && B_KN + (size_t)KEYROWS * DM * 2 <= B_V && B_V + (size_t)KEYROWS * DM * 2 <= B_QL && (size_t)T_ALL * FF * 2 <= 132 * MiB, "mixer map");
constexpr int RING_BYTES = 131072, LDSCTL_OFF = 146432  , MISC_OFF = LDSCTL_OFF + 320, LDS_BYTES = 147456;
static_assert(att::SHM_ATTN <= RING_BYTES, "attention scratch");

#define GAS __attribute__((address_space(1)))
#define LAS __attribute__((address_space(3)))
typedef unsigned short bf16;
typedef unsigned v4u __attribute__((ext_vector_type(4)));
typedef unsigned v2u __attribute__((ext_vector_type(2)));
typedef float f32x4 __attribute__((ext_vector_type(4)));
typedef short bf16x8 __attribute__((ext_vector_type(8)));
typedef float f32x16 __attribute__((ext_vector_type(16)));
#define LDS_WAIT() asm volatile("s_waitcnt lgkmcnt(0)" ::: "memory")
#define VM_WAIT() asm volatile("s_waitcnt vmcnt(0)" ::: "memory")
__device__ __forceinline__ unsigned f2bf(float f) { unsigned u = __builtin_bit_cast(unsigned, f); return (u + 0x7fffu + ((u >> 16) & 1u)) >> 16; }
__device__ __forceinline__ unsigned pk2(float lo, float hi) { return f2bf(lo) | (f2bf(hi) << 16); }
__device__ __forceinline__ float bflo(unsigned w) { return __builtin_bit_cast(float, w << 16); }
__device__ __forceinline__ float bfhi(unsigned w) { return __builtin_bit_cast(float, w & 0xffff0000u); }

#define XB_TMO      128
#define XB_XCNT(j)  (256  + 64 * (j))
#define XB_XSUB(j)  (1280 + 64 * (j))
#define XB_XGEN(j)  (2304 + 64 * (j))
#define XB_TOP      3328
#define XB_TOPGEN   3392
#define XCD_BAR_WORDS 3456
#define XB_SPIN_CAP (1u << 21)
__device__ unsigned mk_bar_words[XCD_BAR_WORDS];
__device__ __forceinline__ unsigned xb_ld(unsigned* p)              { return __hip_atomic_load(p, __ATOMIC_RELAXED, __HIP_MEMORY_SCOPE_AGENT); }
__device__ __forceinline__ unsigned xb_add(unsigned* p, unsigned v) { return __hip_atomic_fetch_add(p, v, __ATOMIC_RELAXED, __HIP_MEMORY_SCOPE_AGENT); }
__device__ __forceinline__ unsigned xb_xcc_id() { return (unsigned)__builtin_amdgcn_s_getreg((3 << 11) | 20) & 0xFu; }
#define XB_SPIN(cond, bar) do { unsigned _sp = 0; while (cond) { __builtin_amdgcn_s_sleep(1); \
    if ((++_sp & 255u) == 0u) { if (xb_ld(&(bar)[XB_TMO])) break; if (_sp > XB_SPIN_CAP) { atomicAdd(&(bar)[XB_TMO], 1u); break; } } } } while (0)
struct XcdBarrier { unsigned* bar; unsigned x; volatile LAS unsigned* st; };
__device__ __forceinline__ XcdBarrier xcd_barrier_post(unsigned* bar, volatile LAS unsigned* st) {
    XcdBarrier b; b.bar = bar; b.x = xb_xcc_id(); b.st = st;
    if (threadIdx.x == 0) { (void)xb_add(&bar[XB_XCNT(b.x)], 1u); st[0] = 0u; st[1] = 0u; st[2] = xb_ld(&bar[XB_XGEN(b.x)]); st[3] = xb_ld(&bar[XB_TOPGEN]); }
    return b;
}
__device__ __forceinline__ void xcd_barrier_complete(unsigned* bar, unsigned x, unsigned& nloc, unsigned& nx) {
    const unsigned G = gridDim.x * gridDim.y * gridDim.z;
    unsigned sum, cnt, mine, sp = 0u;
    for (;;) {
        sum = 0u; cnt = 0u; mine = 0u;
#pragma unroll
        for (unsigned j = 0; j < 16; ++j) { const unsigned c = xb_ld(&bar[XB_XCNT(j)]); sum += c; cnt += (c > 0u) ? 1u : 0u; mine = (j == x) ? c : mine; }
        if (sum == G) break;
        __builtin_amdgcn_s_sleep(1);
        if ((++sp & 255u) == 0u) { if (xb_ld(&bar[XB_TMO])) break; if (sp > XB_SPIN_CAP) { atomicAdd(&bar[XB_TMO], 1u); break; } }
    }
    nloc = mine > 0u ? mine : 1u; nx = cnt > 0u ? cnt : 1u;
}
__device__ __forceinline__ void xcd_barrier(const XcdBarrier& b, const int wave_s) {
    asm volatile("s_waitcnt vmcnt(0)" ::: "memory");
    __syncthreads();
    if (wave_s == 0 && fresh_lane() == 0) {
        unsigned* bar = b.bar; unsigned bx_ = b.x; asm volatile("" : "+s"(bar), "+s"(bx_));
        __builtin_amdgcn_s_waitcnt(0);
        unsigned nloc = b.st[0], nx = b.st[1]; const unsigned gx = b.st[2], gt = b.st[3]; bool first = false;
        if (nloc == 0u) { xcd_barrier_complete(bar, bx_, nloc, nx); b.st[0] = nloc; b.st[1] = nx; first = true; }
        b.st[2] = gx + 1u; b.st[3] = gt + 1u;
        const unsigned old = xb_add(&bar[XB_XSUB(bx_)], 1u);
        if (old + 1u == nloc) {
            (void)xb_add(&bar[XB_XSUB(bx_)], 0u - nloc);
            __builtin_amdgcn_fence(__ATOMIC_RELEASE, "agent");
            asm volatile("s_waitcnt vmcnt(0)" ::: "memory");
            const unsigned og = xb_add(&bar[XB_TOP], 1u);
            if (og + 1u == nx) { (void)xb_add(&bar[XB_TOPGEN], 1u); (void)xb_add(&bar[XB_TOP], 0u - nx); }
            else XB_SPIN(xb_ld(&bar[XB_TOPGEN]) == gt, bar);
            (void)xb_add(&bar[XB_XGEN(bx_)], 1u);
            if (first) (void)xb_add(&bar[XB_XCNT(bx_)], 0u - nloc);
            __builtin_amdgcn_fence(__ATOMIC_ACQUIRE, "agent");
            asm volatile("s_waitcnt vmcnt(0)" ::: "memory");
        } else {
            XB_SPIN(xb_ld(&bar[XB_XGEN(bx_)]) == gx, bar);
            __builtin_amdgcn_fence(__ATOMIC_ACQUIRE, "agent");
            asm volatile("s_waitcnt vmcnt(0)" ::: "memory");
        }
    }
    __syncthreads();
}

enum { MAP_PLAIN = 0, MAP_FFNIN = 1, MAP_WIN = 2, MAP_WQ = 3, MAP_WKV = 4 };
__device__ __forceinline__ int dst_row(int mode, int n) {
    if (mode == MAP_FFNIN) { const bool isu = n >= FF; const int j = isu ? n - FF : n; return 256 * (j >> 7) + (isu ? 128 : 0) + (j & 127); }
    if (mode == MAP_WIN) { if (n < 2560) return n; if (n < 2624) { const int d = n - 2560; return 2560 + (d & 32) + pg8::perm32(d & 31); } return 2816 + (n - 2624); }
    if (mode == MAP_WQ) { const int h = n / 192, d = n % 192; if (d < 128) return n; const int dd = d - 128; return h * 192 + 128 + (dd & 32) + pg8::perm32(dd & 31); }
    if (mode == MAP_WKV) { const int h = n >> 8, d = n & 255; return d < 128 ? h * 128 + d : 1024 + h * 128 + (d - 128); }
    return n;
}
__device__ __forceinline__ void tr_item(const float* W, int N, bf16* WT, int ldk, int kofs, int mode, const float* kscale, int item, LAS float* scr, int lane) {
    const int nblk = N / 64, kb = item / nblk, nb = item % nblk, k0 = 64 * kb, n0 = 64 * nb, r = lane >> 4, q = lane & 15;
    f32x4 wv[16];
#pragma unroll
    for (int i = 0; i < 16; ++i) wv[i] = __builtin_nontemporal_load((const f32x4*)(W + (size_t)(k0 + 4 * i + r) * N + n0 + 4 * q));
    if (kscale) {
#pragma unroll
        for (int i = 0; i < 16; ++i) wv[i] *= kscale[k0 + 4 * i + r]; }
#pragma unroll
    for (int i = 0; i < 16; ++i) { LAS float* p = scr + (4 * i + r) * 65 + 4 * q; p[0] = wv[i][0]; p[1] = wv[i][1]; p[2] = wv[i][2]; p[3] = wv[i][3]; }
    LDS_WAIT(); asm volatile("" ::: "memory");
    const int c = lane & 7;
#pragma unroll
    for (int j = 0; j < 8; ++j) { const int n = (lane >> 3) + 8 * j; const LAS float* s = scr + (8 * c) * 65 + n;
        v4u o; o.x = pk2(s[0 * 65], s[1 * 65]); o.y = pk2(s[2 * 65], s[3 * 65]); o.z = pk2(s[4 * 65], s[5 * 65]); o.w = pk2(s[6 * 65], s[7 * 65]);
        *(GAS v4u*)(WT + (size_t)dst_row(mode, n0 + n) * ldk + kofs + k0 + 8 * c) = o; }
    LDS_WAIT(); asm volatile("" ::: "memory");
}
constexpr int IT_FFNIN = 16 * (FF2 / 64), IT_FFNOUT = (FF / 64) * (DM / 64), IT_WIN = 16 * (4672 / 64), IT_WQ = 4 * (NQ / 64), IT_WKV = 4 * (NKV / 64), IT_SQ = 16 * (DM / 64);
constexpr int IT_TR = 2 * IT_FFNIN + 2 * IT_FFNOUT + IT_WIN + IT_WQ + IT_WKV + 3 * IT_SQ;
constexpr int IT_PAD = 192, IT_WS = 256, IT_ROPE = 1;
constexpr int IT_P0 = IT_TR + IT_PAD + IT_WS + IT_ROPE;
constexpr int IT_DEF = 3 * IT_SQ + IT_FFNIN + IT_FFNOUT;

struct KArgs { const float* in[27]; float* out; unsigned char* ws; int ph_lo, ph_hi; int rep_mask, pad; };

__constant__ int PH_KIND[NPH] = {0, 1, 2, 3,        4, 5, 6, 7, 8,           4,          6,       5, 6,     7, 8,         2, 3, 9};
__constant__ int PH_ARG[NPH]  = {0, 0, 0, 0,        0, 0, 0, 0, 0,           1,          1,       2, 2,     1, 1,         1, 1, 0};
__constant__ double ROPE_INV[16] = {1.0, 0.5623413251903491, 0.31622776601683794, 0.1778279410038923, 0.1, 0.05623413251903491, 0.03162277660168379, 0.01778279410038923,
                                    0.01, 0.005623413251903491, 0.0031622776601683794, 0.0017782794100389228, 0.001, 0.0005623413251903491, 0.00031622776601683794, 0.00017782794100389227};

__device__ __forceinline__ void gmlp_pair(int itemA, int itemB, bf16* OAB, const bf16* WSb, const float* SSV, const float* vnorm, const float* bs, LAS unsigned char* L, const int wave_s) {
    int wid_ = wave_s; asm volatile("" : "+s"(wid_));
    const int lane = fresh_lane(), wid = wid_, half = wid >> 2, w4 = wid & 3, t256 = w4 * 64 + lane;
    const int item = half ? itemB : itemA; const bool on = item >= 0;
    const int cq = item >> 3, g = item & 7, r0 = cq * 128, r32 = lane & 31, hi = lane >> 5;
    LAS unsigned short* A_l = (LAS unsigned short*)(L + half * 70144);
    LAS unsigned short* VT_l = (LAS unsigned short*)(L + half * 70144 + 34816);
    LAS float* rstd_l = (LAS float*)(L + half * 70144 + 69632);
    if (on && t256 < 128) { const float* p = SSV + (size_t)(r0 + t256) * 16; float s = 0.f;
#pragma unroll
        for (int q = 0; q < 4; ++q) { const f32x4 t = *(const f32x4*)(p + 4 * q); s += (t[0] + t[1]) + (t[2] + t[3]); }
        rstd_l[t256] = rsqrtf(s * (1.f / 1024.f) + EPS); }
    __syncthreads();
    if (on) {
#pragma unroll
        for (int i = 0; i < 8; ++i) { const int id = t256 + 256 * i, row = id >> 4, ch = id & 15;
            const v4u w = *(const v4u*)(WSb + (size_t)g * 16384 + row * 128 + ch * 8);
            *(LAS v4u*)(A_l + row * 136 + ch * 8) = w;
            const int rw = id & 127, cv = id >> 7;
            const v4u vv = *(const v4u*)(OAB + (size_t)(r0 + rw) * 2048 + 1024 + g * 128 + cv * 8);
            const float rq = rstd_l[rw]; const f32x4 n0 = *(const f32x4*)(vnorm + g * 128 + cv * 8), n1 = *(const f32x4*)(vnorm + g * 128 + cv * 8 + 4);
            LAS unsigned short* vt = VT_l + (cv * 8) * 136 + rw;
            vt[0 * 136] = (unsigned short)f2bf(bflo(vv[0]) * rq * n0[0]); vt[1 * 136] = (unsigned short)f2bf(bfhi(vv[0]) * rq * n0[1]);
            vt[2 * 136] = (unsigned short)f2bf(bflo(vv[1]) * rq * n0[2]); vt[3 * 136] = (unsigned short)f2bf(bfhi(vv[1]) * rq * n0[3]);
            vt[4 * 136] = (unsigned short)f2bf(bflo(vv[2]) * rq * n1[0]); vt[5 * 136] = (unsigned short)f2bf(bfhi(vv[2]) * rq * n1[1]);
            vt[6 * 136] = (unsigned short)f2bf(bflo(vv[3]) * rq * n1[2]); vt[7 * 136] = (unsigned short)f2bf(bfhi(vv[3]) * rq * n1[3]); }
    }
    __syncthreads();
    f32x16 acc[4] = {};
    if (on) {
#pragma unroll
        for (int ks = 0; ks < 8; ++ks) {
            const bf16x8 af = *(const LAS bf16x8*)(A_l + (w4 * 32 + r32) * 136 + ks * 16 + hi * 8);
#pragma unroll
            for (int db = 0; db < 4; ++db) { const bf16x8 bfr = *(const LAS bf16x8*)(VT_l + (db * 32 + r32) * 136 + ks * 16 + hi * 8);
                acc[db] = __builtin_amdgcn_mfma_f32_32x32x16_bf16(af, bfr, acc[db], 0, 0, 0); }
        }
    }
    __syncthreads();
    LAS float* M_l = (LAS float*)(L + half * 70144);
    if (on) {
#pragma unroll
        for (int r = 0; r < 16; ++r) { const int p = w4 * 32 + (r & 3) + 8 * (r >> 2) + 4 * hi; const float bb = bs[p * 8 + g];
#pragma unroll
            for (int db = 0; db < 4; ++db) M_l[p * 132 + db * 32 + r32] = acc[db][r] + bb; }
    }
    __syncthreads();
    if (on) {
#pragma unroll
        for (int i = 0; i < 8; ++i) { const int id = t256 + 256 * i, row = id >> 4, ch = id & 15;
            bf16* up = OAB + (size_t)(r0 + row) * 2048 + g * 128 + ch * 8; const v4u uv = *(const v4u*)up;
            const f32x4 m0 = *(const LAS f32x4*)(M_l + row * 132 + ch * 8), m1 = *(const LAS f32x4*)(M_l + row * 132 + ch * 8 + 4);
            v4u o; o.x = pk2(bflo(uv.x) * m0[0], bfhi(uv.x) * m0[1]); o.y = pk2(bflo(uv.y) * m0[2], bfhi(uv.y) * m0[3]); o.z = pk2(bflo(uv.z) * m1[0], bfhi(uv.z) * m1[1]); o.w = pk2(bflo(uv.w) * m1[2], bfhi(uv.w) * m1[3]);
            *(v4u*)up = o; }
    }
    __syncthreads();
}

__device__ __forceinline__ void bias_pass(int lo, int hi, int gw, int NGW, int lane, const float* mods_, const bf16* w1, const bf16* wi, const bf16* w2, float* b1, float* b2, float* b3) {
    int curmat = -1; float shv[NMOD][16];
#pragma unroll
    for (int mi = 0; mi < NMOD; ++mi)
#pragma unroll
        for (int i = 0; i < 16; ++i) shv[mi][i] = 0.f;
#define BP_ROW(IT) (((IT) < FF2 ? w1 + (size_t)(IT) * DM : (IT) < FF2 + NIN ? wi + (size_t)((IT) - FF2) * DM : w2 + (size_t)((IT) - FF2 - NIN) * DM))
    v4u pw0 = {0u, 0u, 0u, 0u}, pw1 = pw0;
    if (lo + gw < hi) { const bf16* r0 = BP_ROW(lo + gw); pw0 = *(const v4u*)(r0 + 8 * lane); pw1 = *(const v4u*)(r0 + 8 * (lane + 64)); }
    for (int it = lo + gw; it < hi; it += NGW) {
        int mat, n; if (it < FF2) { mat = 0; n = it; } else if (it < FF2 + NIN) { mat = 1; n = it - FF2; } else { mat = 2; n = it - FF2 - NIN; }
        const v4u w0 = pw0, w1v = pw1;
        if (it + NGW < hi) { const bf16* r1 = BP_ROW(it + NGW); pw0 = *(const v4u*)(r1 + 8 * lane); pw1 = *(const v4u*)(r1 + 8 * (lane + 64)); }
        if (mat != curmat) { curmat = mat;
#pragma unroll
            for (int mi = 0; mi < NMOD; ++mi)
#pragma unroll
                for (int j = 0; j < 2; ++j) { const float* sp = mods_ + mi * 9216 + 3 * mat * 1024 + 8 * (lane + 64 * j); const f32x4 s0 = *(const f32x4*)sp, s1 = *(const f32x4*)(sp + 4);
#pragma unroll
                    for (int i = 0; i < 4; ++i) { shv[mi][j * 8 + i] = s0[i]; shv[mi][j * 8 + 4 + i] = s1[i]; } } }
        float wv[16];
#pragma unroll
        for (int k = 0; k < 4; ++k) { wv[2 * k] = bflo(w0[k]); wv[2 * k + 1] = bfhi(w0[k]); wv[8 + 2 * k] = bflo(w1v[k]); wv[8 + 2 * k + 1] = bfhi(w1v[k]); }
        float* bo = (mat == 0 ? b1 : mat == 1 ? b2 : b3); const int nrow = (mat == 1 ? NIN : FF2);
#pragma unroll
        for (int mi = 0; mi < NMOD; ++mi) { float s = 0.f;
#pragma unroll
            for (int i = 0; i < 16; ++i) s += wv[i] * shv[mi][i];
            s = wave_sum(s); if (lane == 0) bo[mi * nrow + n] = s; }
    }
#undef BP_ROW
}

#ifndef MK_ONLY
#define MK_EN(k) true
#else
#define MK_EN(k) ((k) == MK_ONLY)
#endif
#define SS2_DELTA (WS_BIG + B_SS2 - WS_SSV)
#define mods ((float*)(ws + WS_MODS))
#define tab ((float*)(ws + WS_TAB))
#define bias1 ((float*)(ws + WS_BIAS1))
#define bias2 ((float*)(ws + WS_BIAS2))
#define bias3 ((float*)(ws + WS_BIAS3))
#define rope ((float*)(ws + WS_ROPE))
#define ss1 ((float*)(ws + WS_SS1))
#define ssp2 ((float*)(ws + WS_SSP2))
#define ssp3 ((float*)(ws + WS_SSP3))
#define sspf ((float*)(ws + WS_SSPF))
#define SSV ((float*)(ws + WS_SSV + (chunk == 2 ? SS2_DELTA : 0)))
#define SSQ ((float*)(ws + WS_SSQ + (chunk == 2 ? SS2_DELTA : 0)))
#define SSC ((float*)(ws + WS_SSC + (chunk == 2 ? SS2_DELTA : 0)))
#define W1IN ((bf16*)(ws + WS_W + W_1IN))
#define W1OUT ((bf16*)(ws + WS_W + W_1OUT))
#define WIN ((bf16*)(ws + WS_W + W_IN))
#define WQ ((bf16*)(ws + WS_W + W_Q))
#define WKV ((bf16*)(ws + WS_W + W_KV))
#define WAB ((bf16*)(ws + WS_W + W_AB))
#define WO ((bf16*)(ws + WS_W + W_O))
#define W2IN ((bf16*)(ws + WS_W + W_2IN))
#define W2OUT ((bf16*)(ws + WS_W + W_2OUT))
#define WSb ((bf16*)(ws + WS_W + W_S))
#define XS ((bf16*)(ws + WS_XS))
#define ACT ((bf16*)(ws + WS_BIG))
#define OAB ((bf16*)(ws + WS_BIG + B_OAB))
#define OABC ((bf16*)(ws + WS_BIG + (chunk == 2 ? B_OAB2 : B_OAB)))
#define GT ((bf16*)(ws + WS_BIG + (chunk ? B_G : B_OAB2)))
#define Qb ((bf16*)(ws + WS_BIG + B_Q))
#define KN ((bf16*)(ws + WS_BIG + B_KN))
#define Vb ((bf16*)(ws + WS_BIG + B_V))
#define QL ((bf16*)(ws + WS_BIG + (chunk == 0 ? B_QL0 : B_QL + (chunk == 2 ? B_SET2 : 0))))
#define CKV ((bf16*)(ws + WS_BIG + (chunk == 0 ? B_CKV0 : B_CKV + (chunk == 2 ? B_SET2 : 0))))
#define KR ((bf16*)(ws + WS_BIG + (chunk == 0 ? B_KR0 : B_KR + (chunk == 2 ? B_SET2 : 0))))
#define INP(k) ((const float*)(const GAS float*)ap->in[k])
#define OUTP ((float*)(GAS float*)ap->out)
#define X (OUTP)
#define nckv (OUTP + (size_t)T_ALL * DM)
#define rawkr ((float*)(ws + WS_BIG + B_QL + B_SET2 + 8 * MiB))
#define rawckv ((float*)(ws + WS_BIG + B_QL + B_SET2))
#define nkr (OUTP + (size_t)T_ALL * DM + (size_t)T_CTX * 256)
__global__ void __launch_bounds__(NWAVES * 64, 2) mk_fwd(KArgs a) {
    extern __shared__ __attribute__((aligned(16))) unsigned char lds[];
    LAS unsigned char* L = (LAS unsigned char*)lds;
    const int wave_s = __builtin_amdgcn_readfirstlane(threadIdx.x >> 6);
    volatile LAS unsigned* MISC = (volatile LAS unsigned*)(L + MISC_OFF);
    const bool fused = (a.ph_hi - a.ph_lo) > 1;
    XcdBarrier bar; bar.bar = mk_bar_words; bar.x = 0; bar.st = MISC + 8;
    if (fused) bar = xcd_barrier_post(mk_bar_words, MISC + 8);

    for (int ph = a.ph_lo; ph < a.ph_hi; ++ph)
    for (int rep = 0; rep <= ((a.rep_mask >> ph) & 1); ++rep) {
        if (ph != a.ph_lo || rep != 0) xcd_barrier(bar, wave_s);
        int NG = gridDim.x, bx = blockIdx.x; asm volatile("" : "+s"(NG), "+s"(bx));
        const int vcu = (NG % 8 == 0) ? (bx % 8) * (NG / 8) + bx / 8 : bx, NGW = NG * NWAVES;
        int wave = wave_s; asm volatile("" : "+s"(wave));
        const int gw = vcu * NWAVES + wave;
        const __attribute__((address_space(4))) KArgs* ap = (const __attribute__((address_space(4))) KArgs*)__builtin_amdgcn_kernarg_segment_ptr(); asm volatile("" : "+s"(ap));
        GAS unsigned char* ws0 = (GAS unsigned char*)ap->ws; asm volatile("" : "+s"(ws0)); unsigned char* ws = (unsigned char*)ws0;

        const int kind0 = PH_KIND[ph], chunk0 = PH_ARG[ph];
        const bool split = (kind0 == 4 && chunk0 == 0), tailw = split && bx >= NG / 2;
        const bool split7 = (kind0 == 7 && chunk0 == 0), tail7 = split7 && bx >= NG / 2;
        const int chunk = tail7 ? 1 : chunk0;
        const int kind = tailw ? 3 : tail7 ? 4 : kind0, Gx = (split || split7) ? NG / 2 : NG, cx = (tailw || tail7) ? bx - NG / 2 : bx;

        if (kind == 0 && MK_EN(0)) {
            const int lane = fresh_lane(), tid = wave * 64 + lane; (void)tid;
            LAS float* stab = (LAS float*)(L + 67584);
            for (int i = tid; i < NMOD * 1024; i += NWAVES * 64) { const int mi = i >> 10, k = i & 1023; const float cv = mi == 0 ? INP(5)[k] : INP(2)[(mi - 1) * 1024 + k]; stab[k * 8 + mi] = cv / (1.f + __expf(-cv)); }
            __syncthreads();
            LAS float* red = (LAS float*)(L + 100352);
            for (int cgp = vcu; cgp < 576; cgp += NG) {
                const int j0 = 16 * cgp, kq = lane >> 2, cg = lane & 3; const float* wp = INP(6) + j0 + 4 * cg;
                f32x4 ac0 = {0.f, 0.f, 0.f, 0.f}, ac1 = ac0, ac2 = ac0, ac3 = ac0, ac4 = ac0;
#pragma unroll
                for (int i = 0; i < 8; ++i) { const int k = wave * 128 + kq + 16 * i; const f32x4 w = __builtin_nontemporal_load((const f32x4*)(wp + (size_t)k * 9216));
                    const f32x4 s03 = *(const LAS f32x4*)(stab + k * 8); const float s4 = stab[k * 8 + 4];
                    ac0 += w * s03[0]; ac1 += w * s03[1]; ac2 += w * s03[2]; ac3 += w * s03[3]; ac4 += w * s4; }
#pragma unroll
                for (int c = 0; c < 4; ++c) {
#define RED5(OP) ac0[c] = OP(ac0[c]); ac1[c] = OP(ac1[c]); ac2[c] = OP(ac2[c]); ac3[c] = OP(ac3[c]); ac4[c] = OP(ac4[c]);
#define R4(v) ((v) + dpp_get<0x124>(v))
#define R8(v) ((v) + dpp_get<0x128>(v))
#define R16(v) add_xor16(v)
                    RED5(R4) RED5(R8) RED5(R16) RED5(add_xor32)
#undef RED5
#undef R4
#undef R8
#undef R16
                }
                if (lane < 4) { LAS float* rp = red + (wave * 4 + lane) * 20; *(LAS f32x4*)(rp) = ac0; *(LAS f32x4*)(rp + 4) = ac1; *(LAS f32x4*)(rp + 8) = ac2; *(LAS f32x4*)(rp + 12) = ac3; *(LAS f32x4*)(rp + 16) = ac4; }
                __syncthreads();
                if (tid < 80) { const int l4 = tid / 20, e = tid % 20; float t = 0.f;
#pragma unroll
                    for (int w8 = 0; w8 < 8; ++w8) t += red[(w8 * 4 + l4) * 20 + e];
                    const int mi = e >> 2, col = j0 + 4 * l4 + (e & 3); mods[mi * 9216 + col] = t + INP(7)[col]; }
                __syncthreads();
            }
            LAS float* scr = (LAS float*)(L + wave * 16640);
            for (int it = NGW - 1 - gw; it < IT_P0 - IT_DEF; it += NGW) {
                int r = it;
                if (r < IT_FFNIN)  { tr_item(INP(9),  FF2, W1IN, DM, 0, MAP_FFNIN, nullptr, r, scr, lane); continue; } r -= IT_FFNIN;
                if (r < IT_FFNOUT) { tr_item(INP(10), DM, W1OUT, FF, 0, MAP_PLAIN, nullptr, r, scr, lane); continue; } r -= IT_FFNOUT;
                if (r < IT_WIN)    { tr_item(INP(12), 4672, WIN, DM, 0, MAP_WIN, nullptr, r, scr, lane); continue; } r -= IT_WIN;
                if (r < IT_WQ)     { tr_item(INP(17), NQ, WQ, 256, 0, MAP_WQ, INP(16), r, scr, lane); continue; } r -= IT_WQ;
                if (r < IT_WKV)    { tr_item(INP(19), NKV, WKV, 256, 0, MAP_WKV, INP(18), r, scr, lane); continue; } r -= IT_WKV;
                if (r < IT_PAD)    { const v4u z = {0u, 0u, 0u, 0u}; bf16* p = WIN + (size_t)(2624 + r) * DM + lane * 16; *(v4u*)p = z; *(v4u*)(p + 8) = z; continue; } r -= IT_PAD;
                if (r < IT_WS)     { const float* s = INP(14) + (size_t)r * 512 + lane * 8; const f32x4 x0 = *(const f32x4*)s, x1 = *(const f32x4*)(s + 4);
                                     v4u o; o.x = pk2(x0[0], x0[1]); o.y = pk2(x0[2], x0[3]); o.z = pk2(x1[0], x1[1]); o.w = pk2(x1[2], x1[3]); *(v4u*)(WSb + (size_t)r * 512 + lane * 8) = o; continue; } r -= IT_WS;
                if (lane < 16) {
                    const double th = ROPE_INV[lane], t2 = th * th;
                    const double s1 = th * (1.0 - t2 * (1.0 / 6.0) * (1.0 - t2 * (1.0 / 20.0) * (1.0 - t2 * (1.0 / 42.0) * (1.0 - t2 * (1.0 / 72.0) * (1.0 - t2 * (1.0 / 110.0) * (1.0 - t2 * (1.0 / 156.0) * (1.0 - t2 * (1.0 / 210.0))))))));
                    const double c1 = 1.0 - t2 * (1.0 / 2.0) * (1.0 - t2 * (1.0 / 12.0) * (1.0 - t2 * (1.0 / 30.0) * (1.0 - t2 * (1.0 / 56.0) * (1.0 - t2 * (1.0 / 90.0) * (1.0 - t2 * (1.0 / 132.0) * (1.0 - t2 * (1.0 / 182.0)))))));
                    double cp = 1.0, sp = 0.0;
                    for (int pos = 0; pos < 64; ++pos) { rope[pos * 16 + lane] = (float)cp; rope[1024 + pos * 16 + lane] = (float)sp; const double cn = cp * c1 - sp * s1, sn = sp * c1 + cp * s1; cp = cn; sp = sn; }
                }
            }
        } else if (kind == 1 && MK_EN(1)) {
            const int lane = fresh_lane(), tid = wave * 64 + lane; (void)tid;
            for (int it = gw; it < 480; it += NGW) { const int idx = it * 64 + lane, k = idx / 5120, rem = idx % 5120, mi = rem >> 10, c = rem & 1023; const float* mm = mods + mi * 9216; float v;
                if (k == 0) v = INP(8)[c] * (1.f + mm[1024 + c]); else if (k == 1) v = INP(11)[c] * (1.f + mm[4 * 1024 + c]); else if (k == 2) v = INP(23)[c] * (1.f + mm[7 * 1024 + c]);
                else if (k == 3) v = 0.5f * mm[2 * 1024 + c]; else if (k == 4) v = mm[5 * 1024 + c]; else v = 0.5f * mm[8 * 1024 + c];
                tab[idx] = v; }
            bias_pass(0, FF2 + NIN, gw, NGW, lane, mods, W1IN, WIN, W2IN, bias1, bias2, bias3);
            for (int m0 = gw; m0 < T_ALL; m0 += 2 * NGW) {
                const int m1 = m0 + NGW, mi = m0 < T_CTX ? 0 : 1 + ((m0 - T_CTX) >> 12);
                const float* s0 = m0 < T_CTX ? INP(0) + (size_t)m0 * DM : INP(1) + (size_t)(m0 - T_CTX) * DM; const float* s1 = m1 < T_CTX ? INP(0) + (size_t)m1 * DM : INP(1) + (size_t)(m1 - T_CTX) * DM;
                const float* sc = mods + mi * 9216 + 1024; f32x4 xa[4], xb[4], cs[4]; float ssa = 0.f, ssb = 0.f;
#pragma unroll
                for (int j = 0; j < 4; ++j) { const int c = 4 * lane + 256 * j; xa[j] = __builtin_nontemporal_load((const f32x4*)(s0 + c)); xb[j] = __builtin_nontemporal_load((const f32x4*)(s1 + c));     cs[j] = *(const f32x4*)(INP(8) + c) * (1.f + *(const f32x4*)(sc + c)); }
#pragma unroll
                for (int j = 0; j < 4; ++j) { const int c = 4 * lane + 256 * j; ssa += (xa[j][0] * xa[j][0] + xa[j][1] * xa[j][1]) + (xa[j][2] * xa[j][2] + xa[j][3] * xa[j][3]); ssb += (xb[j][0] * xb[j][0] + xb[j][1] * xb[j][1]) + (xb[j][2] * xb[j][2] + xb[j][3] * xb[j][3]);
                    const f32x4 ya = xa[j] * cs[j], yb = xb[j] * cs[j]; v2u o; o.x = pk2(ya[0], ya[1]); o.y = pk2(ya[2], ya[3]); *(v2u*)(XS + (size_t)m0 * DM + c) = o; o.x = pk2(yb[0], yb[1]); o.y = pk2(yb[2], yb[3]); *(v2u*)(XS + (size_t)m1 * DM + c) = o; }
                ssa = wave_sum(ssa); ssb = wave_sum(ssb); if (lane == 0) { ss1[m0] = ssa; ss1[m1] = ssb; }
            }
        } else if (kind == 2 && MK_EN(2)) {
            const bool second = (chunk == 1);
            pg8::Gemm g{XS, second ? W2IN : W1IN, T_ALL, FF2, DM, DM}; pg8::StaticOrder S; S.init(T_ALL, FF2, NG, bx);
            pg8::EpiSwiGLU E{ACT, second ? ssp3 : ss1, second ? 16 : 1, second ? bias3 : bias1};
            pg8::gemm_phase<pg8::EpiSwiGLU, pg8::StaticOrder, true, true>(L, g, S, E, wave_s);
            if (!second && bx >= 128) {
                const int lane = fresh_lane(); LAS float* scr = (LAS float*)(L + wave * 16640);
                for (int it = (bx - 128) * NWAVES + wave; it < IT_DEF - IT_FFNOUT; it += (NG - 128) * NWAVES) {
                    int r = it;
                    if (r < IT_SQ)     { tr_item(INP(20), DM, WAB, 2048, 0, MAP_PLAIN, nullptr, r, scr, lane); continue; } r -= IT_SQ;
                    if (r < IT_SQ)     { tr_item(INP(21), DM, WAB, 2048, 1024, MAP_PLAIN, nullptr, r, scr, lane); continue; } r -= IT_SQ;
                    if (r < IT_SQ)     { tr_item(INP(22), DM, WO, DM, 0, MAP_PLAIN, nullptr, r, scr, lane); continue; } r -= IT_SQ;
                    tr_item(INP(24), FF2, W2IN, DM, 0, MAP_FFNIN, nullptr, r, scr, lane);
                }
            }
        } else if ((kind == 3 || kind == 8) && MK_EN(3)) {
            pg8::Gemm g; pg8::EpiResid E; pg8::StaticOrder S;
            if (kind == 3) { const bool second = (chunk == 1);
                g = pg8::Gemm{ACT + (tailw ? (size_t)16384 * FF : 0), second ? W2OUT : W1OUT, second ? T_ALL : (tailw ? 8192 : 16384), DM, FF, FF};
                E = second ? pg8::EpiResid{tab + 2 * 5120, tab + 5 * 5120, INP(26), 0, XS, sspf, 0}
                           : pg8::EpiResid{tab + 0 * 5120, tab + 3 * 5120, tab + 1 * 5120, DM, XS, ssp2, tailw ? 64 : 0};
            } else {
                g = pg8::Gemm{GT, WO, chunk ? 2 * TC : TC, DM, DM, 2048};
                E = pg8::EpiResid{tab + 1 * 5120, tab + 4 * 5120, tab + 2 * 5120, DM, XS, ssp3, chunk * 32};
            }
            S.init(g.M, g.N, Gx, cx);
            pg8::gemm_phase<pg8::EpiResid, pg8::StaticOrder, true, true>(L, g, S, E, wave_s);
            if (tailw) bias_pass(FF2 + NIN, FF2 + NIN + FF2, cx * NWAVES + wave, Gx * NWAVES, fresh_lane(), mods, W1IN, WIN, W2IN, bias1, bias2, bias3);
        } else if (kind == 4 && MK_EN(4)) {
            const int lane = fresh_lane(), tid = wave * 64 + lane; (void)tid;
            const int Mw = chunk ? 2 * TC : TC;
            const int pn0 = tail7 ? 8 : 0, Nw = chunk == 0 ? 2816 : (tail7 ? 768 : 2048);
            pg8::Gemm g{XS + (size_t)chunk * TC * DM, WIN + (size_t)pn0 * 256 * DM, Mw, Nw, DM, DM}; pg8::StaticOrder S; S.init(Mw, Nw, Gx, cx);
            pg8::EpiWin E{ssp2, bias2, OAB, QL, CKV, KR, SSV, SSQ, SSC, rawckv, rawkr, rope, chunk, (long)B_SET2, (long)SS2_DELTA, pn0};
            pg8::gemm_phase<pg8::EpiWin, pg8::StaticOrder, true, true>(L, g, S, E, wave_s);
            if (tail7) {
                const int lane2 = fresh_lane(); LAS float* scr = (LAS float*)(L + wave * 16640);
                for (int it = cx * NWAVES + wave; it < IT_FFNOUT; it += Gx * NWAVES) tr_item(INP(25), DM, W2OUT, FF, 0, MAP_PLAIN, nullptr, it, scr, lane2);
                for (int it = cx * NWAVES + wave; it < 1024; it += Gx * NWAVES) { const int b = it >> 8, t = it & 255; const size_t kr = (size_t)(b & 1) * 4352 + t; const size_t d2 = (b >> 1) ? B_SET2 : 0;
                const f32x4 x = *(const f32x4*)(INP(3) + ((size_t)b * 256 + t) * 256 + 4 * lane2), kn = *(const f32x4*)(INP(18) + 4 * lane2);
                v2u o; o.x = pk2(x[0] / kn[0], x[1] / kn[1]); o.y = pk2(x[2] / kn[2], x[3] / kn[3]); *(v2u*)((char*)(CKV + kr * 256 + 4 * lane2) + d2) = o;
                const int s = lane2 & 31, dim = (lane2 & 32) + 16 * ((s >> 2) & 1) + 4 * (s >> 3) + (s & 3);
                *(bf16*)((char*)(KR + kr * 64 + lane2) + d2) = (bf16)f2bf(INP(4)[((size_t)b * 256 + t) * 64 + dim]); }
            }
        }
        if ((kind == 5 || (kind0 == 4 && chunk0 == 1)) && MK_EN(5)) {
            const int lane = fresh_lane(), tid = wave * 64 + lane; (void)tid;
#if !defined(MK_SUB) || MK_SUB == 0
            { pg8::Gemm g{QL, WQ, TC, NQ, 256, 256}; pg8::StaticOrder S; S.init(TC, NQ, NG, bx); pg8::EpiQ E{Qb, SSQ, rope, chunk};
              pg8::gemm_phase<pg8::EpiQ, pg8::StaticOrder, true, true>(L, g, S, E, wave_s); }
#endif
#if !defined(MK_SUB) || MK_SUB == 1
            { const int Mk = chunk == 0 ? TC : KEYROWS; pg8::Gemm g{CKV, WKV, Mk, NKV, 256, 256}; pg8::StaticOrder S; S.init(Mk, NKV, NG, (bx + 64) % NG);   pg8::EpiKV E{KN, Vb, SSC, chunk};
              pg8::gemm_phase<pg8::EpiKV, pg8::StaticOrder, true, true>(L, g, S, E, wave_s); }
#endif
#if !defined(MK_SUB) || MK_SUB == 2
#endif
            if (chunk == 0) for (int m = gw; m < T_CTX; m += NGW) { const f32x4 p = *(const f32x4*)(SSC + (size_t)m * 4); const float rstd = rsqrtf(((p[0] + p[1]) + (p[2] + p[3])) * (1.f / 256.f) + EPS);
                const f32x4 v = *(const f32x4*)(rawckv + (size_t)m * 256 + 4 * lane), kn = *(const f32x4*)(INP(18) + 4 * lane); __builtin_nontemporal_store(v * rstd * kn, (f32x4*)(nckv + (size_t)m * 256 + 4 * lane)); }
            if (chunk == 0) for (int i = gw; i < T_CTX * 64 / 256; i += NGW) __builtin_nontemporal_store(*(const f32x4*)(rawkr + (size_t)i * 256 + 4 * lane), (f32x4*)(nkr + (size_t)i * 256 + 4 * lane));
        } else if (kind == 6 && MK_EN(6)) {
            if (chunk == 0) {
                pg8::Gemm g{XS, WIN + (size_t)2816 * DM, TC, 2048, DM, DM}; pg8::StaticOrder S; S.init(TC, 2048, NG, bx);
                pg8::EpiGate E{ssp2, bias2, GT, 0};
                pg8::gemm_phase<pg8::EpiGate, pg8::StaticOrder, true, true>(L, g, S, E, wave_s);
            }
            for (int u = vcu; u < 256; u += NG) {
                const int b0 = u >> 3, h0 = u & 7, bh = u >> 4, qb = u & 15, j = bh >> 3, h1 = bh & 7;
                const int cq0 = chunk == 0 ? 2 * b0 : j * 32 + qb * 2, hh = chunk == 0 ? h0 : h1;
                gmlp_pair(cq0 * 8 + hh, (cq0 + 1) * 8 + hh, OABC, WSb, SSV, INP(13), INP(15), L, wave_s);
                const size_t q0 = chunk == 0 ? (size_t)b0 * 256 : (size_t)j * 4096 + qb * 256, k0 = chunk == 0 ? (size_t)b0 * 256 : (size_t)j * 4352; const int seq = chunk == 0 ? 256 : 4352;
                att::attn_unit(Qb + q0 * NQ + hh * 192, KN + k0 * DM + hh * 128, KR + k0 * 64, Vb + k0 * DM + hh * 128, OABC + q0 * 2048 + 1024 + hh * 128, seq, (char*)lds, wave_s);
            }
        } else if (kind == 7 && MK_EN(7)) {
            const int Mg = chunk ? 2 * TC : TC; pg8::Gemm g{OAB, WAB, Mg, DM, 2048, 2048}; pg8::StaticOrder S; S.init(Mg, DM, Gx, cx); pg8::EpiMerge E{GT};
            if (chunk == 1) {
                pg8::Unit um; if (S.next(0, um)) { pg8::Gemm gg{XS + (size_t)T_CTX * DM, WIN + (size_t)2816 * DM, Mg, 2048, DM, DM}; pg8::StaticOrder Sg; Sg.init(Mg, 2048, NG, bx); Sg.pair = 1; Sg.pm0 = um.pm; Sg.pn0 = um.pn;
                    pg8::EpiGate Eg{ssp2, bias2, GT, 32}; pg8::gemm_phase<pg8::EpiGate, pg8::StaticOrder, true, true>(L, gg, Sg, Eg, wave_s); } }
            pg8::gemm_phase<pg8::EpiMerge, pg8::StaticOrder, true, true>(L, g, S, E, wave_s);
        } else if (kind == 9 && MK_EN(9)) {
            const int lane = fresh_lane(), tid = wave * 64 + lane; (void)tid;
            for (int m0 = 2 * gw; m0 < T_ALL; m0 += 2 * NGW) { const int m1 = m0 + 1;
                const float pa = lane < 16 ? sspf[(size_t)m0 * 16 + lane] : 0.f, pb = lane < 16 ? sspf[(size_t)m1 * 16 + lane] : 0.f; v2u xa[4], xb[4];
#pragma unroll
                for (int j = 0; j < 4; ++j) { const int c = 4 * lane + 256 * j; xa[j] = *(const v2u*)(XS + (size_t)m0 * DM + c); xb[j] = *(const v2u*)(XS + (size_t)m1 * DM + c); }
                const float ra = rsqrtf(wave_sum(pa) * (1.f / DM) + EPS), rb = rsqrtf(wave_sum(pb) * (1.f / DM) + EPS);
#pragma unroll
                for (int j = 0; j < 4; ++j) { const int c = 4 * lane + 256 * j;
                    __builtin_nontemporal_store((f32x4){bflo(xa[j].x), bfhi(xa[j].x), bflo(xa[j].y), bfhi(xa[j].y)} * ra, (f32x4*)(X + (size_t)m0 * DM + c)); }
#pragma unroll
                for (int j = 0; j < 4; ++j) { const int c = 4 * lane + 256 * j;
                    __builtin_nontemporal_store((f32x4){bflo(xb[j].x), bfhi(xb[j].x), bflo(xb[j].y), bfhi(xb[j].y)} * rb, (f32x4*)(X + (size_t)m1 * DM + c)); } }
        }
    }
}

#undef INP
#undef SS2_DELTA
#undef OABC
#undef OUTP
#undef mods
#undef tab
#undef bias1
#undef bias2
#undef bias3
#undef rope
#undef ss1
#undef ssp2
#undef ssp3
#undef sspf
#undef SSV
#undef SSQ
#undef SSC
#undef W1IN
#undef W1OUT
#undef WIN
#undef WQ
#undef WKV
#undef WAB
#undef WO
#undef W2IN
#undef W2OUT
#undef WSb
#undef XS
#undef ACT
#undef OAB
#undef GT
#undef Qb
#undef KN
#undef Vb
#undef QL
#undef CKV
#undef KR
#undef X
#undef nckv
#undef rawckv
#undef rawkr
#undef nkr
#ifndef MK_SPLIT
#define MK_SPLIT 0
#endif
extern "C" void kernel_launch(void* const* d_in, const int* in_sizes, int n_in, void* d_out, int out_size, void* d_ws, size_t ws_size, hipStream_t stream) {
    static int grid = 0;
    if (grid == 0) {
        if (n_in != 27 || ws_size < WS_END || out_size != T_ALL * DM + T_CTX * 256 + T_CTX * 64) { fprintf(stderr, "kernel_launch: unexpected shapes: n_in %d out %d ws %zu (need %zu)\n", n_in, out_size, ws_size, (size_t)WS_END); grid = -1; return; }
        int dev = 0, cus = 0, per_cu = 0;
        if (hipGetDevice(&dev) != hipSuccess || hipDeviceGetAttribute(&cus, hipDeviceAttributeMultiprocessorCount, dev) != hipSuccess) { grid = -1; return; }
        if (hipFuncSetAttribute((const void*)mk_fwd, hipFuncAttributeMaxDynamicSharedMemorySize, LDS_BYTES) != hipSuccess) { fprintf(stderr, "kernel_launch: hipFuncSetAttribute failed\n"); grid = -1; return; }
        if (hipOccupancyMaxActiveBlocksPerMultiprocessor(&per_cu, (const void*)mk_fwd, NWAVES * 64, LDS_BYTES) != hipSuccess || per_cu < 1) { fprintf(stderr, "kernel_launch: occupancy query says %d\n", per_cu); per_cu = 1; }
        (void)hipGetLastError();
        if (cus < 256) { fprintf(stderr, "kernel_launch: built for a 256-CU device (got %d CUs)\n", cus); grid = -1; return; }
        grid = 256;
    }
    if (grid < 0) return;
    KArgs a{};
    for (int i = 0; i < 27; ++i) a.in[i] = (const float*)d_in[i];
    a.out = (float*)d_out; a.ws = (unsigned char*)d_ws;
#if MK_SPLIT
#ifndef MK_SKIP_MASK
#define MK_SKIP_MASK 0u
#endif
    for (int p = 0; p < NPH; ++p) { if ((MK_SKIP_MASK >> p) & 1u) continue; a.ph_lo = p; a.ph_hi = p + 1; hipLaunchKernelGGL(mk_fwd, dim3(grid), dim3(NWAVES * 64), LDS_BYTES, stream, a); }
#else
#ifndef MK_REPEAT_MASK
#define MK_REPEAT_MASK 0
#endif
    a.ph_lo = 0; a.ph_hi = NPH; a.rep_mask = MK_REPEAT_MASK;
    void* args[] = {&a};
    hipError_t e = hipLaunchCooperativeKernel((const void*)mk_fwd, dim3(grid), dim3(NWAVES * 64), args, LDS_BYTES, stream);
    if (e != hipSuccess) fprintf(stderr, "kernel_launch: cooperative launch failed: %s (grid %d)\n", hipGetErrorString(e), grid);
#endif
}
```

```cpp
#include <hip/hip_runtime.h>
#include <cstdio>
#include <cstdint>

constexpr int DM = 1024;
constexpr int T_CTX = 8192, T_LAT = 16384, T_ALL = 24576;
constexpr int TC = 8192, NCHUNK = 3;
constexpr int FF = 2816, FF2 = 5632;
constexpr int NIN = 4864;
constexpr int NQ = 1536, NKV = 2048;
constexpr int KEYROWS = 8704;
constexpr float EPS = 1e-6f;
constexpr int NMOD = 5;
constexpr int NPH = 18;

template <int O> __device__ __forceinline__ float xor_swz(float v) {
    return __builtin_bit_cast(float, __builtin_amdgcn_ds_swizzle(__builtin_bit_cast(int, v), (O << 10) | 0x1f)); }
__device__ __forceinline__ float add_xor32(float v) {
    auto r = __builtin_amdgcn_permlane32_swap(__builtin_bit_cast(unsigned, v), __builtin_bit_cast(unsigned, v), false, false);
    const unsigned r0 = r[0], r1 = r[1];
    return __builtin_bit_cast(float, r0) + __builtin_bit_cast(float, r1); }
__device__ __forceinline__ float add_xor16(float v) {
    auto r = __builtin_amdgcn_permlane16_swap(__builtin_bit_cast(unsigned, v), __builtin_bit_cast(unsigned, v), false, false);
    const unsigned r0 = r[0], r1 = r[1];
    return __builtin_bit_cast(float, r0) + __builtin_bit_cast(float, r1); }
template <int CTRL> __device__ __forceinline__ float dpp_get(float v) {
    return __builtin_bit_cast(float, __builtin_amdgcn_update_dpp(0, __builtin_bit_cast(int, v), CTRL, 0xF, 0xF, true)); }
__device__ __forceinline__ float wave_sum(float v) {
    v += dpp_get<0xB1>(v); v += dpp_get<0x4E>(v); v += dpp_get<0x141>(v); v += dpp_get<0x140>(v); v = add_xor16(v); return add_xor32(v); }
__device__ __forceinline__ float lane_bcast(float v, int srclane) {
    return __builtin_bit_cast(float, __builtin_amdgcn_ds_bpermute(srclane << 2, __builtin_bit_cast(int, v))); }

__device__ __forceinline__ int fresh_lane() { int l; asm volatile("v_mbcnt_lo_u32_b32 %0, -1, 0\n\tv_mbcnt_hi_u32_b32 %0, -1, %0" : "=v"(l)); return l; }

namespace pg8 {
#define PG8_LAS __attribute__((address_space(3)))
typedef unsigned short bf16_t;
typedef short bf16x8 __attribute__((ext_vector_type(8)));
typedef float f32x4 __attribute__((ext_vector_type(4)));
typedef unsigned u32x4 __attribute__((ext_vector_type(4)));
constexpr int BM = 256, BK = 64, HALF = 128, HTB = HALF * BK * 2  , STAGE_BYTES = 8 * HTB, NXCD = 8, WGM = 8;

__host__ __device__ __forceinline__ int lds_byte(int r, int c) { const int st = (r >> 4) * 2 + (c >> 5), rr = r & 15, cc = c & 31, ob = rr * 64 + cc * 2; return st * 1024 + (ob ^ (((ob >> 9) & 1) << 5)); }
__host__ __device__ __forceinline__ void stage_rc(int b, int& R, int& C) { const int st = b / 1024, sb = b % 1024, swz = sb ^ (((sb >> 9) & 1) << 5); R = (st >> 1) * 16 + swz / 64; C = (st & 1) * 32 + (swz % 64) / 2; }
__host__ __device__ __forceinline__ int perm32(int rho) { const int n = rho >> 4, i = rho & 15; return 8 * (i >> 2) + 4 * n + (i & 3); }

struct Unit { int pm, pn, half; };
struct Gemm { const bf16_t* A; const bf16_t* Bt; int M, N, K, lda; };

struct StaticOrder {
    int nM, nN, nwg, G, c, pair, pm0, pn0;
    __host__ __device__ void init(int M, int N, int G_, int c_) { nM = M / BM; nN = N / BM; nwg = nM * nN; G = G_; c = c_; pair = 0; pm0 = 0; pn0 = 0; }
    __host__ __device__ __forceinline__ bool next(int i, Unit& u) const {
        if (pair) { if (i > 1) return false; u.pm = pm0; u.pn = pn0 + 4 * i; u.half = 0; return true; }
        const int rfull = nwg / G, R = nwg - rfull * G;
        if (i == rfull && R > 0 && 2 * R <= G) { if (c >= 2 * R) return false;
            const bool ok = at((long)rfull * G + (((c >> 4) << 3) | (c & 7)), u); u.half = 1 + ((c >> 3) & 1); return ok; }
        return at((long)i * G + c, u);
    }
    __host__ __device__ __forceinline__ bool at(const long L, Unit& u) const {
        if (L >= nwg) return false;
        int wgid = (int)L; { const int q = nwg / NXCD, r = nwg % NXCD, xcd = wgid % NXCD, off = wgid / NXCD; wgid = (xcd < r ? xcd * (q + 1) : r * (q + 1) + (xcd - r) * q) + off; }
        const int nig = WGM * nN, gid = wgid / nig, fm = gid * WGM, gsz = (nM - fm) < WGM ? (nM - fm) : WGM;
        u.pm = fm + ((wgid % nig) % gsz); u.pn = (wgid % nig) / gsz; u.half = 0; return true;
    }
    __device__ __forceinline__ void a_ready(const Unit&) const {}
    __device__ __forceinline__ void done(const Unit&) const {}
};

typedef float f32x2c_t __attribute__((ext_vector_type(2))); typedef __bf16 bf16x2c_t __attribute__((ext_vector_type(2)));
__device__ __forceinline__ unsigned cvt_pk_bf16(float lo, float hi) { f32x2c_t v = {lo, hi}; bf16x2c_t b = __builtin_convertvector(v, bf16x2c_t); return __builtin_bit_cast(unsigned, b); }
typedef float f32x2 __attribute__((ext_vector_type(2)));
typedef unsigned u32x2 __attribute__((ext_vector_type(2)));
__device__ __forceinline__ float silu_f(float x) { return x * __builtin_amdgcn_rcpf(1.f + __expf(-x)); }
__device__ __forceinline__ float sigm_f(float x) { return __builtin_amdgcn_rcpf(1.f + __expf(-x)); }
__device__ __forceinline__ u32x4 pack8(const f32x4 a, const f32x4 b) { u32x4 w; w.x = cvt_pk_bf16(a[0], a[1]); w.y = cvt_pk_bf16(a[2], a[3]); w.z = cvt_pk_bf16(b[0], b[1]); w.w = cvt_pk_bf16(b[2], b[3]); return w; }
__device__ __forceinline__ float bf_lo(unsigned w) { return __builtin_bit_cast(float, w << 16); }
__device__ __forceinline__ float bf_hi(unsigned w) { return __builtin_bit_cast(float, w & 0xffff0000u); }
__device__ __forceinline__ float dot4(const f32x4 x) { return (x[0] * x[0] + x[1] * x[1]) + (x[2] * x[2] + x[3] * x[3]); }
__device__ __forceinline__ int mod_index(int gpm) { return gpm < 32 ? 0 : 1 + ((gpm - 32) >> 4); }

template <int NP>
__device__ __forceinline__ void row_rstd(const float* ssp, int rbase, float invn, int fq, int lane, float (&rs)[2][4]) {
    float v[2];
#pragma unroll
    for (int ai = 0; ai < 2; ++ai) {
        const float* p = ssp + (size_t)(rbase + ai * 128 + fq * 16) * NP; float s;
        if constexpr (NP == 1) { s = p[0]; }
        else { s = 0.f;
#pragma unroll
            for (int q = 0; q < NP / 4; ++q) { const f32x4 t = *(const f32x4*)(p + 4 * q); s += (t[0] + t[1]) + (t[2] + t[3]); } }
        v[ai] = rsqrtf(s * invn + EPS);
    }
#pragma unroll
    for (int ai = 0; ai < 2; ++ai) {
        const unsigned x = __builtin_bit_cast(unsigned, v[ai]);
        auto s16 = __builtin_amdgcn_permlane16_swap(x, x, false, false); const unsigned e = s16[0], o = s16[1];
        auto se = __builtin_amdgcn_permlane32_swap(e, e, false, false); const unsigned e0 = se[0], e2 = se[1];
        auto so = __builtin_amdgcn_permlane32_swap(o, o, false, false); const unsigned o1 = so[0], o3 = so[1];
        rs[ai][0] = __builtin_bit_cast(float, e0); rs[ai][1] = __builtin_bit_cast(float, o1); rs[ai][2] = __builtin_bit_cast(float, e2); rs[ai][3] = __builtin_bit_cast(float, o3); }
    (void)lane;
}

struct EpiSwiGLU {
    static constexpr bool PERM = true, AFTER_DRAIN = false, MID = false;
    bf16_t* ACT; const float* ssp; int np; const float* bias;
    __device__ __forceinline__ void operator()(const f32x4 (&acc)[2][2][4][2], const Unit& u, int wr, int wc, int fr, int fq) const {
        const int lane = fr + 16 * fq, rl0 = u.pm * BM + wr * 64 + fr, mi = mod_index(u.pm);
        float rs[2][4];
        if (np == 1) row_rstd<1>(ssp, rl0, 1.f / DM, fq, lane, rs); else row_rstd<16>(ssp, rl0, 1.f / DM, fq, lane, rs);
        const float* bp = bias + (size_t)mi * FF2 + u.pn * BM + wc * 32 + 8 * fq;
        f32x4 bg[2], bu[2];
#pragma unroll
        for (int n = 0; n < 2; ++n) { bg[n] = *(const f32x4*)(bp + 4 * n); bu[n] = *(const f32x4*)(bp + HALF + 4 * n); }
#pragma unroll
        for (int ai = 0; ai < 2; ++ai) if (u.half != 2 - ai)
#pragma unroll
            for (int m = 0; m < 4; ++m) { const float r = rs[ai][m]; bf16_t* op = ACT + (unsigned)((rl0 + ai * HALF + m * 16) * FF + u.pn * HALF + wc * 32 + 8 * fq);
                f32x4 a[2];
#pragma unroll
                for (int n = 0; n < 2; ++n) { const f32x4 zg = acc[ai][0][m][n] * r + bg[n], zu = acc[ai][1][m][n] * r + bu[n];
#pragma unroll
                    for (int i = 0; i < 4; ++i) a[n][i] = silu_f(zg[i]) * zu[i]; }
                *(u32x4*)op = pack8(a[0], a[1]); }
    }
};

struct EpiResid {
    static constexpr bool PERM = true, AFTER_DRAIN = false, MID = false;
    const float* csb;
    const float* gate; const float* cs; int cs_stride; bf16_t* XS; float* ssp; int prow0;
    __device__ __forceinline__ void operator()(const f32x4 (&acc)[2][2][4][2], const Unit& u, int wr, int wc, int fr, int fq) const {
        const int gpm = prow0 + u.pm, mi = mod_index(gpm), grow0 = gpm * BM + wr * 64 + fr, c0 = u.pn * BM + wc * 32 + 8 * fq;
#pragma unroll
        for (int ai = 0; ai < 2; ++ai) if (u.half != 2 - ai) { float s[4] = {0.f, 0.f, 0.f, 0.f};
#pragma unroll
            for (int bj = 0; bj < 2; ++bj) {
                u32x4 w[4]; f32x4 gvb[2], cvb[2], ivb[2];
#pragma unroll
                for (int m = 0; m < 4; ++m) w[m] = *(const u32x4*)(XS + (unsigned)((grow0 + ai * HALF + m * 16) * DM + c0 + bj * HALF));
#pragma unroll
                for (int n = 0; n < 2; ++n) { gvb[n] = *(const f32x4*)(gate + mi * DM + c0 + bj * HALF + 4 * n); cvb[n] = *(const f32x4*)(cs + mi * cs_stride + c0 + bj * HALF + 4 * n);
                    ivb[n] = *(const f32x4*)(csb + mi * DM + c0 + bj * HALF + 4 * n);
#pragma unroll
                    for (int i = 0; i < 4; ++i) ivb[n][i] = ivb[n][i] == 0.f ? 0.f : __builtin_amdgcn_rcpf(ivb[n][i]); }
#pragma unroll
                for (int m = 0; m < 4; ++m) { const unsigned off = (unsigned)((grow0 + ai * HALF + m * 16) * DM + c0 + bj * HALF);
                    const f32x4 x0 = (f32x4){bf_lo(w[m][0]), bf_hi(w[m][0]), bf_lo(w[m][1]), bf_hi(w[m][1])} * ivb[0] + gvb[0] * acc[ai][bj][m][0];
                    const f32x4 x1 = (f32x4){bf_lo(w[m][2]), bf_hi(w[m][2]), bf_lo(w[m][3]), bf_hi(w[m][3])} * ivb[1] + gvb[1] * acc[ai][bj][m][1];
                    s[m] += dot4(x0) + dot4(x1);
                    *(u32x4*)(XS + off) = pack8(x0 * cvb[0], x1 * cvb[1]); }
                asm volatile("" ::: "memory");
            }
#pragma unroll
            for (int m = 0; m < 4; ++m) { float t = s[m]; t = add_xor16(t); t = add_xor32(t);
                if (fq == 0) ssp[(unsigned)((grow0 + ai * HALF + m * 16) * 16 + 4 * u.pn + wc)] = t; }
        }
    }
};

struct EpiWin {
    static constexpr bool PERM = true, AFTER_DRAIN = false, MID = false;
    const float* ssp2; const float* bias; bf16_t* OAB; bf16_t* QL_; bf16_t* CKV_; bf16_t* KR_; float* SSV_; float* SSQ_; float* SSC_; float* nckv; float* nkr; const float* rope; int chunk; long set2_bytes, ss2_bytes; int pn0;
    __device__ __forceinline__ void operator()(const f32x4 (&acc)[2][2][4][2], const Unit& u, int wr, int wc, int fr, int fq) const {
        const bool set2 = u.pm >= 32; const int pml = u.pm & 31;
        const int lane = fr + 16 * fq, rlo0 = u.pm * BM + wr * 64 + fr, rl0 = pml * BM + wr * 64 + fr, gpm = chunk * 32 + u.pm, mi = mod_index(gpm), pn = u.pn + pn0, c0 = wc * 32 + 8 * fq;
        const int kr0 = (chunk == 0 ? pml : 17 * (pml >> 4) + 1 + (pml & 15)) * BM + wr * 64 + fr;
        bf16_t* QL = (bf16_t*)((char*)QL_ + (set2 ? set2_bytes : 0)); bf16_t* CKV = (bf16_t*)((char*)CKV_ + (set2 ? set2_bytes : 0)); bf16_t* KR = (bf16_t*)((char*)KR_ + (set2 ? set2_bytes : 0));
        float* SSV = (float*)((char*)SSV_ + (set2 ? ss2_bytes : 0)); float* SSQ = (float*)((char*)SSQ_ + (set2 ? ss2_bytes : 0)); float* SSC = (float*)((char*)SSC_ + (set2 ? ss2_bytes : 0));
        float rs[2][4]; row_rstd<16>(ssp2, gpm * BM + wr * 64 + fr, 1.f / DM, fq, lane, rs);
        const float* bp = bias + (size_t)mi * NIN + pn * BM + c0;
        f32x4 bv[2][2];
#pragma unroll
        for (int bj = 0; bj < 2; ++bj)
#pragma unroll
            for (int n = 0; n < 2; ++n) bv[bj][n] = *(const f32x4*)(bp + bj * HALF + 4 * n);
        if (pn < 8) {
            bf16_t* dst = OAB + (pn < 4 ? pn * BM : DM + (pn - 4) * BM) + c0;
#pragma unroll
            for (int ai = 0; ai < 2; ++ai) if (u.half != 2 - ai)
#pragma unroll
                for (int m = 0; m < 4; ++m) { const int row = rl0 + ai * HALF + m * 16, rowo = rlo0 + ai * HALF + m * 16; const float r = rs[ai][m]; float s = 0.f;
#pragma unroll
                    for (int bj = 0; bj < 2; ++bj) { const f32x4 z0 = acc[ai][bj][m][0] * r + bv[bj][0], z1 = acc[ai][bj][m][1] * r + bv[bj][1]; s += dot4(z0) + dot4(z1);
                        *(u32x4*)(dst + (unsigned)(rowo * 2048 + bj * HALF)) = pack8(z0, z1); }
                    if (pn >= 4) { s = add_xor16(s); s = add_xor32(s); if (fq == 0) SSV[(size_t)row * 16 + 4 * (pn - 4) + wc] = s; } }
        } else if (pn == 8) {
#pragma unroll
            for (int ai = 0; ai < 2; ++ai) if (u.half != 2 - ai)
#pragma unroll
                for (int m = 0; m < 4; ++m) { const int row = rl0 + ai * HALF + m * 16; const float r = rs[ai][m]; float s = 0.f;
#pragma unroll
                    for (int bj = 0; bj < 2; ++bj) { const f32x4 z0 = acc[ai][bj][m][0] * r + bv[bj][0], z1 = acc[ai][bj][m][1] * r + bv[bj][1]; s += dot4(z0) + dot4(z1);
                        *(u32x4*)(QL + (size_t)row * 256 + bj * HALF + c0) = pack8(z0, z1); }
                    s = add_xor16(s); s = add_xor32(s); if (fq == 0) SSQ[(size_t)row * 4 + wc] = s; }
        } else if (pn == 9) {
#pragma unroll
            for (int ai = 0; ai < 2; ++ai) if (u.half != 2 - ai)
#pragma unroll
                for (int m = 0; m < 4; ++m) { const int row = rl0 + ai * HALF + m * 16, krow = kr0 + ai * HALF + m * 16; const float r = rs[ai][m]; float s = 0.f;
#pragma unroll
                    for (int bj = 0; bj < 2; ++bj) { const f32x4 z0 = acc[ai][bj][m][0] * r + bv[bj][0], z1 = acc[ai][bj][m][1] * r + bv[bj][1]; s += dot4(z0) + dot4(z1);
                        *(u32x4*)(CKV + (size_t)krow * 256 + bj * HALF + c0) = pack8(z0, z1);
                        if (chunk == 0) { *(f32x4*)(nckv + (size_t)row * 256 + bj * HALF + c0) = z0; *(f32x4*)(nckv + (size_t)row * 256 + bj * HALF + c0 + 4) = z1; } }
                    s = add_xor16(s); s = add_xor32(s); if (fq == 0) SSC[(size_t)krow * 4 + wc] = s; }
        } else if (wc < 2) {
#pragma unroll
            for (int ai = 0; ai < 2; ++ai) if (u.half != 2 - ai)
#pragma unroll
                for (int m = 0; m < 4; ++m) { const int row = rl0 + ai * HALF + m * 16, krow = kr0 + ai * HALF + m * 16; const float r = rs[ai][m];
                    const f32x4 z0 = acc[ai][0][m][0] * r + bv[0][0], z1 = acc[ai][0][m][1] * r + bv[0][1]; f32x4 o0 = z0, o1 = z1;
                    if (chunk == 0) { *(f32x4*)(nkr + (size_t)row * 64 + 32 * wc + 4 * fq) = z0; *(f32x4*)(nkr + (size_t)row * 64 + 32 * wc + 16 + 4 * fq) = z1; }
                    else { const int t = row & 4095, pos = wc == 0 ? (t >> 6) : (t & 63); const f32x4 cs_ = *(const f32x4*)(rope + pos * 16 + 4 * fq), sn_ = *(const f32x4*)(rope + 1024 + pos * 16 + 4 * fq);
                        o0 = z0 * cs_ - z1 * sn_; o1 = z1 * cs_ + z0 * sn_; }
                    *(u32x4*)(KR + (size_t)krow * 64 + 32 * wc + 8 * fq) = pack8(o0, o1); }
        }
    }
};

struct EpiQ {
    static constexpr bool PERM = true, AFTER_DRAIN = false, MID = false;
    bf16_t* Q; const float* SSQ; const float* rope; int chunk;
    __device__ __forceinline__ void operator()(const f32x4 (&acc)[2][2][4][2], const Unit& u, int wr, int wc, int fr, int fq) const {
        const int lane = fr + 16 * fq, rl0 = u.pm * BM + wr * 64 + fr;
        float rs[2][4]; row_rstd<4>(SSQ, rl0, 1.f / 256.f, fq, lane, rs);
#pragma unroll
        for (int ai = 0; ai < 2; ++ai) if (u.half != 2 - ai)
#pragma unroll
            for (int m = 0; m < 4; ++m) rs[ai][m] *= 0.10411754584f;
#pragma unroll
        for (int bj = 0; bj < 2; ++bj) { const int C32 = u.pn * BM + bj * HALF + wc * 32, w = C32 % 192; const bool rot = (w >= 128) && (chunk > 0); const bool colang = (w >= 160);
#pragma unroll
            for (int ai = 0; ai < 2; ++ai) if (u.half != 2 - ai)
#pragma unroll
                for (int m = 0; m < 4; ++m) { const int row = rl0 + ai * HALF + m * 16; const float r = rs[ai][m];
                    f32x4 z0 = acc[ai][bj][m][0] * r, z1 = acc[ai][bj][m][1] * r;
                    if (rot) { const int t = row & 4095, pos = colang ? (t & 63) : (t >> 6); const f32x4 cs_ = *(const f32x4*)(rope + pos * 16 + 4 * fq), sn_ = *(const f32x4*)(rope + 1024 + pos * 16 + 4 * fq);
                        const f32x4 o0 = z0 * cs_ - z1 * sn_, o1 = z1 * cs_ + z0 * sn_; z0 = o0; z1 = o1; }
                    *(u32x4*)(Q + (unsigned)(row * NQ + C32 + 8 * fq)) = pack8(z0, z1); } }
    }
};

struct EpiKV {
    static constexpr bool PERM = true, AFTER_DRAIN = false, MID = false;
    bf16_t* KN; bf16_t* V; const float* SSC; int chunk;
    __device__ __forceinline__ void operator()(const f32x4 (&acc)[2][2][4][2], const Unit& u, int wr, int wc, int fr, int fq) const {
        const int lane = fr + 16 * fq, rl0 = u.pm * BM + wr * 64 + fr, c0 = wc * 32 + 8 * fq;
        float rs[2][4]; row_rstd<4>(SSC, rl0, 1.f / 256.f, fq, lane, rs);
        const bool cache = (chunk > 0) && (u.pm % 17 == 0);
        bf16_t* dst = (u.pn < 4 ? KN + u.pn * BM : V + (u.pn - 4) * BM) + c0;
#pragma unroll
        for (int ai = 0; ai < 2; ++ai) if (u.half != 2 - ai)
#pragma unroll
            for (int m = 0; m < 4; ++m) { const int row = rl0 + ai * HALF + m * 16; const float r = cache ? 1.f : rs[ai][m];
#pragma unroll
                for (int bj = 0; bj < 2; ++bj) *(u32x4*)(dst + (unsigned)(row * DM + bj * HALF)) = pack8(acc[ai][bj][m][0] * r, acc[ai][bj][m][1] * r); }
    }
};

struct EpiGate {
    static constexpr bool PERM = true, AFTER_DRAIN = false, MID = false;
    const float* ssp2; const float* bias; bf16_t* G; int prow0;
    __device__ __forceinline__ void operator()(const f32x4 (&acc)[2][2][4][2], const Unit& u, int wr, int wc, int fr, int fq) const {
        const int lane = fr + 16 * fq, rl0 = u.pm * BM + wr * 64 + fr, gpm = prow0 + u.pm, mi = mod_index(gpm), c0 = u.pn * BM + wc * 32 + 8 * fq;
        float rs[2][4]; row_rstd<16>(ssp2, gpm * BM + wr * 64 + fr, 1.f / DM, fq, lane, rs);
        const float* bp = bias + (size_t)mi * NIN + 2816 + c0;
        f32x4 bv[2][2];
#pragma unroll
        for (int bj = 0; bj < 2; ++bj)
#pragma unroll
            for (int n = 0; n < 2; ++n) bv[bj][n] = *(const f32x4*)(bp + bj * HALF + 4 * n);
#pragma unroll
        for (int ai = 0; ai < 2; ++ai) if (u.half != 2 - ai)
#pragma unroll
            for (int m = 0; m < 4; ++m) { const int row = rl0 + ai * HALF + m * 16; const float r = rs[ai][m];
#pragma unroll
                for (int bj = 0; bj < 2; ++bj) { f32x4 z0 = acc[ai][bj][m][0] * r + bv[bj][0], z1 = acc[ai][bj][m][1] * r + bv[bj][1];
#pragma unroll
                    for (int i = 0; i < 4; ++i) { z0[i] = sigm_f(z0[i]); z1[i] = sigm_f(z1[i]); }
                    *(u32x4*)(G + (unsigned)(row * 2048 + bj * HALF + c0)) = pack8(z0, z1); } }
    }
};

struct EpiMerge {
    static constexpr bool PERM = true, AFTER_DRAIN = false, MID = true;
    bf16_t* G;
    __device__ __forceinline__ void mid(f32x4 (&acc)[2][2][4][2], const Unit& u, int wr, int wc, int fr, int fq) const {
        const int rl0 = u.pm * BM + wr * 64 + fr, c0 = u.pn * BM + wc * 32 + 8 * fq;
#pragma unroll
        for (int ai = 0; ai < 2; ++ai) if (u.half != 2 - ai)
#pragma unroll
            for (int mh = 0; mh < 2; ++mh) { u32x4 ga[2][2], gb[2][2];
#pragma unroll
                for (int m2 = 0; m2 < 2; ++m2) { const bf16_t* gp = G + (unsigned)((rl0 + ai * HALF + (2 * mh + m2) * 16) * 2048 + c0);
#pragma unroll
                    for (int bj = 0; bj < 2; ++bj) { ga[m2][bj] = *(const u32x4*)(gp + bj * HALF); gb[m2][bj] = *(const u32x4*)(gp + DM + bj * HALF); } }
#pragma unroll
                for (int m2 = 0; m2 < 2; ++m2)
#pragma unroll
                    for (int bj = 0; bj < 2; ++bj)
#pragma unroll
                        for (int k = 0; k < 4; ++k) { const int m = 2 * mh + m2;
                            const float r0 = bf_lo(ga[m2][bj][k]) * __builtin_amdgcn_rcpf(fmaxf(bf_lo(gb[m2][bj][k]), 1e-30f)), r1 = bf_hi(ga[m2][bj][k]) * __builtin_amdgcn_rcpf(fmaxf(bf_hi(gb[m2][bj][k]), 1e-30f));
                            acc[ai][bj][m][k >> 1][(k & 1) * 2] *= r0; acc[ai][bj][m][k >> 1][(k & 1) * 2 + 1] *= r1; }
                asm volatile("" ::: "memory"); }
    }
    __device__ __forceinline__ void operator()(const f32x4 (&acc)[2][2][4][2], const Unit& u, int wr, int wc, int fr, int fq) const {
        const int rl0 = u.pm * BM + wr * 64 + fr, c0 = u.pn * BM + wc * 32 + 8 * fq;
#pragma unroll
        for (int ai = 0; ai < 2; ++ai) if (u.half != 2 - ai) { u32x4 gb[4][2];
#pragma unroll
            for (int m = 0; m < 4; ++m)
#pragma unroll
                for (int bj = 0; bj < 2; ++bj) gb[m][bj] = *(const u32x4*)(G + (size_t)(rl0 + ai * HALF + m * 16) * 2048 + DM + c0 + bj * HALF);
#pragma unroll
            for (int m = 0; m < 4; ++m) { const size_t row = (size_t)(rl0 + ai * HALF + m * 16);
#pragma unroll
                for (int bj = 0; bj < 2; ++bj) { const u32x4 g = gb[m][bj];
                    const f32x4 g0 = {bf_lo(g[0]), bf_hi(g[0]), bf_lo(g[1]), bf_hi(g[1])}, g1 = {bf_lo(g[2]), bf_hi(g[2]), bf_lo(g[3]), bf_hi(g[3])};
                    *(u32x4*)(G + row * 2048 + c0 + bj * HALF) = pack8(acc[ai][bj][m][0] * g0, acc[ai][bj][m][1] * g1); } }
            asm volatile("" ::: "memory"); }
    }
};

template <class Epi, class Sched, bool ALIGN_EPI = false, bool SP2 = false>
__device__ __forceinline__ void gemm_phase(PG8_LAS unsigned char* lds, const Gemm g, const Sched& S, const Epi& E, const int wave_s) {
    int wid_ = wave_s; asm volatile("" : "+s"(wid_));
    const int lane = fresh_lane(), wid = wid_, tid = wid * 64 + lane, wr = wid >> 2, wc = wid & 3, fr = lane & 15, fq = lane >> 4;
    const int K = g.K, nt = K / BK, LDA = g.lda;
    unsigned voffA[2], voffB[2];
#pragma unroll
    for (int i = 0; i < 2; ++i) { int R, C; stage_rc(tid * 16 + i * 8192, R, C); const int Rb = Epi::PERM ? ((R & ~31) + perm32(R & 31)) : R;
        voffA[i] = (unsigned)(R * LDA + C) * 2u; voffB[i] = (unsigned)(Rb * K + C) * 2u; }
    const size_t kstep = (size_t)(BK * 2);
    const size_t hstepB = (size_t)HALF * K * 2, tstepB = 2 * hstepB;
    const size_t hstepA = (size_t)HALF * LDA * 2, tstepA = 2 * hstepA;
    const unsigned ldsw = (unsigned)wid * 1024u;
    const int aoff = lds_byte(wr * 64 + fr, fq * 8), boff = lds_byte(wc * 32 + fr, fq * 8);
#define PG8_SA(b, h) (((b) * 2 + (h)) * HTB)
#define PG8_SB(b, h) ((4 + (b) * 2 + (h)) * HTB)
#define PG8_STAGE(bufoff, gbase, voff) do { _Pragma("unroll") for (int _i = 0; _i < 2; ++_i) \
        __builtin_amdgcn_global_load_lds((const unsigned*)((const char*)(gbase) + (voff)[_i]), (PG8_LAS unsigned*)(lds + (bufoff) + ldsw + _i * 8192), 16, 0, 0); } while (0)
#define PG8_LDA(dst, b, h) do { _Pragma("unroll") for (int m = 0; m < 4; ++m) _Pragma("unroll") for (int k = 0; k < 2; ++k) dst[m][k] = *(const PG8_LAS bf16x8*)(lds + PG8_SA(b, h) + aoff + m * 2048 + k * 1024); } while (0)
#define PG8_LDB(dst, b, h) do { _Pragma("unroll") for (int n = 0; n < 2; ++n) _Pragma("unroll") for (int k = 0; k < 2; ++k) dst[n][k] = *(const PG8_LAS bf16x8*)(lds + PG8_SB(b, h) + boff + n * 2048 + k * 1024); } while (0)
#define PG8_MMA(ai, bj, At, Bt) do { __builtin_amdgcn_s_setprio(1); _Pragma("unroll") for (int m = 0; m < 4; ++m) _Pragma("unroll") for (int n = 0; n < 2; ++n) _Pragma("unroll") for (int k = 0; k < 2; ++k) \
        acc[ai][bj][m][n] = __builtin_amdgcn_mfma_f32_16x16x32_bf16(Bt[n][k], At[m][k], acc[ai][bj][m][n], 0, 0, 0); __builtin_amdgcn_s_setprio(0); } while (0)
#define PG8_WAIT_V(n) asm volatile("s_waitcnt vmcnt(" #n ")" ::: "memory")
#define PG8_WAIT_L(n) asm volatile("s_waitcnt lgkmcnt(" #n ")" ::: "memory")
#define PG8_BAR __builtin_amdgcn_s_barrier()
#define PG8_SCHED __builtin_amdgcn_sched_barrier(0)
    Unit cur, nxt; int ui = 0;
    if (!S.next(0, cur)) return;
    f32x4 acc[2][2][4][2];
#pragma unroll
    for (int a = 0; a < 2; ++a)
#pragma unroll
        for (int b = 0; b < 2; ++b)
#pragma unroll
            for (int m = 0; m < 4; ++m)
#pragma unroll
                for (int n = 0; n < 2; ++n) acc[a][b][m][n] = (f32x4){0.f, 0.f, 0.f, 0.f};
    bf16x8 At[4][2], B0[2][2], B1[2][2];
    const char* cA = (const char*)g.A + (size_t)cur.pm * tstepA; const char* cB = (const char*)g.Bt + (size_t)cur.pn * tstepB;
    S.a_ready(cur);
    if constexpr (SP2) {
        PG8_STAGE(PG8_SB(0, 0), cB, voffB); PG8_STAGE(PG8_SB(0, 1), cB + hstepB, voffB); PG8_STAGE(PG8_SA(0, 0), cA, voffA); PG8_STAGE(PG8_SA(0, 1), cA + hstepA, voffA);
        if (wr == 1) PG8_BAR;
        PG8_WAIT_V(2); PG8_BAR;
        PG8_STAGE(PG8_SB(1, 0), cB + kstep, voffB); PG8_STAGE(PG8_SA(1, 0), cA + kstep, voffA); PG8_STAGE(PG8_SB(1, 1), cB + hstepB + kstep, voffB);
        PG8_WAIT_V(6); PG8_BAR;
    } else {
        PG8_STAGE(PG8_SB(0, 0), cB, voffB); PG8_STAGE(PG8_SA(0, 0), cA, voffA); PG8_STAGE(PG8_SB(0, 1), cB + hstepB, voffB); PG8_STAGE(PG8_SA(0, 1), cA + hstepA, voffA);
        if (wr == 1) PG8_BAR;
        PG8_WAIT_V(4); PG8_BAR;
        PG8_STAGE(PG8_SB(1, 0), cB + kstep, voffB); PG8_STAGE(PG8_SA(1, 0), cA + kstep, voffA); PG8_STAGE(PG8_SB(1, 1), cB + hstepB + kstep, voffB);
        PG8_WAIT_V(6); PG8_BAR;
    }
    for (;;) {
        const bool has_next = S.next(ui + 1, nxt);
        const char* nA = has_next ? (const char*)g.A + (size_t)nxt.pm * tstepA : cA; const char* nB = has_next ? (const char*)g.Bt + (size_t)nxt.pn * tstepB : cB;
        const bool do0 = cur.half != 2, do1 = cur.half != 1;
#pragma unroll 1
        for (int t = 0; t < nt; t += 2) {
            if constexpr (Epi::MID) { if (__builtin_expect(t == (nt >> 1), 0)) { const int l2 = fresh_lane(); E.mid(acc, cur, wr, wc, l2 & 15, l2 >> 4); } }
            const bool last = (t == nt - 2);
            const char* a1 = cA + (size_t)(t + 1) * kstep;
            const char* a2 = last ? nA : cA + (size_t)(t + 2) * kstep; const char* b2 = last ? nB : cB + (size_t)(t + 2) * kstep;
            const char* a3 = a2 + kstep; const char* b3 = b2 + kstep;
            if (last && has_next) S.a_ready(nxt);
            if constexpr (SP2) {
            PG8_LDB(B0, 0, 0); PG8_LDB(B1, 0, 1); PG8_SCHED; if (do0) PG8_LDA(At, 0, 0); PG8_STAGE(PG8_SA(1, 1), a1 + hstepA, voffA);
            PG8_WAIT_V(8); PG8_WAIT_L(0); PG8_BAR; if (do0) { PG8_MMA(0, 0, At, B0); PG8_MMA(0, 1, At, B1); } PG8_BAR; PG8_SCHED;
            if (do1) PG8_LDA(At, 0, 1); PG8_STAGE(PG8_SB(0, 0), b2, voffB); PG8_STAGE(PG8_SB(0, 1), b2 + hstepB, voffB); PG8_STAGE(PG8_SA(0, 0), a2, voffA);
            PG8_WAIT_V(8); PG8_WAIT_L(0); PG8_BAR; if (do1) { PG8_MMA(1, 0, At, B0); PG8_MMA(1, 1, At, B1); } PG8_BAR; PG8_SCHED;
            PG8_LDB(B0, 1, 0); PG8_LDB(B1, 1, 1); PG8_SCHED; if (do0) PG8_LDA(At, 1, 0); PG8_STAGE(PG8_SA(0, 1), a2 + hstepA, voffA);
            PG8_WAIT_V(8); PG8_WAIT_L(0); PG8_BAR; if (do0) { PG8_MMA(0, 0, At, B0); PG8_MMA(0, 1, At, B1); } PG8_BAR; PG8_SCHED;
            if (do1) PG8_LDA(At, 1, 1); PG8_STAGE(PG8_SB(1, 0), b3, voffB); PG8_STAGE(PG8_SB(1, 1), b3 + hstepB, voffB); PG8_STAGE(PG8_SA(1, 0), a3, voffA);
            PG8_WAIT_V(8); PG8_WAIT_L(0); PG8_BAR; if (do1) { PG8_MMA(1, 0, At, B0); PG8_MMA(1, 1, At, B1); } PG8_BAR; PG8_SCHED;
            } else {
            PG8_LDB(B0, 0, 0); PG8_SCHED; PG8_LDA(At, 0, 0); PG8_STAGE(PG8_SA(1, 1), a1 + hstepA, voffA);
            PG8_WAIT_L(8); PG8_BAR; PG8_WAIT_L(0); PG8_MMA(0, 0, At, B0); PG8_BAR; PG8_SCHED;
            PG8_LDB(B1, 0, 1); PG8_STAGE(PG8_SB(0, 0), b2, voffB);
            PG8_BAR; PG8_WAIT_L(0); PG8_MMA(0, 1, At, B1); PG8_BAR;
            PG8_LDA(At, 0, 1); PG8_STAGE(PG8_SA(0, 0), a2, voffA);
            PG8_BAR; PG8_WAIT_L(0); PG8_MMA(1, 0, At, B0); PG8_BAR; PG8_SCHED;
            PG8_STAGE(PG8_SB(0, 1), b2 + hstepB, voffB);
            PG8_WAIT_V(6); PG8_BAR; PG8_MMA(1, 1, At, B1); PG8_BAR;
            PG8_LDB(B0, 1, 0); PG8_SCHED; PG8_LDA(At, 1, 0); PG8_STAGE(PG8_SA(0, 1), a2 + hstepA, voffA);
            PG8_WAIT_L(8); PG8_BAR; PG8_WAIT_L(0); PG8_MMA(0, 0, At, B0); PG8_BAR; PG8_SCHED;
            PG8_LDB(B1, 1, 1); PG8_STAGE(PG8_SB(1, 0), b3, voffB);
            PG8_BAR; PG8_WAIT_L(0); PG8_MMA(0, 1, At, B1); PG8_BAR;
            PG8_LDA(At, 1, 1); PG8_STAGE(PG8_SA(1, 0), a3, voffA);
            PG8_BAR; PG8_WAIT_L(0); PG8_MMA(1, 0, At, B0); PG8_BAR; PG8_SCHED;
            PG8_STAGE(PG8_SB(1, 1), b3 + hstepB, voffB);
            PG8_WAIT_V(6); PG8_BAR; PG8_MMA(1, 1, At, B1); PG8_BAR;
            }
        }
        if constexpr (ALIGN_EPI) { if (wr == 0) PG8_BAR; }
        if constexpr (!Epi::AFTER_DRAIN) { const int l2 = fresh_lane(); E(acc, cur, wr, wc, l2 & 15, l2 >> 4); S.done(cur); }
        if (!has_next) break;
#pragma unroll
        for (int a = 0; a < 2; ++a)
#pragma unroll
            for (int b = 0; b < 2; ++b)
#pragma unroll
                for (int m = 0; m < 4; ++m)
#pragma unroll
                    for (int n = 0; n < 2; ++n) acc[a][b][m][n] = (f32x4){0.f, 0.f, 0.f, 0.f};
        cur = nxt; cA = nA; cB = nB; ++ui;
        if constexpr (ALIGN_EPI) { if (wr == 1) PG8_BAR; }
    }
    PG8_WAIT_V(0);
    if constexpr (!ALIGN_EPI) { if (wr == 0) PG8_BAR; }
    PG8_BAR;
    if constexpr (Epi::AFTER_DRAIN) { E.fused(acc, cur, wr, wc, fr, fq, lds, wid, lane); S.done(cur); }
#undef PG8_SA
#undef PG8_SB
#undef PG8_STAGE
#undef PG8_LDA
#undef PG8_LDB
#undef PG8_MMA
#undef PG8_WAIT_V
#undef PG8_WAIT_L
#undef PG8_BAR
#undef PG8_SCHED
}
}
namespace att {
typedef unsigned short bf16_t;
using bf16x8 = __attribute__((ext_vector_type(8))) short;
using s16x4  = __attribute__((ext_vector_type(4))) short;
using f32x16 = __attribute__((ext_vector_type(16))) float;
using u32x4  = __attribute__((ext_vector_type(4))) unsigned;
constexpr int NW = 8, QBLK = 32, KVBLK = 64;
constexpr int LDQ = 1536, LDKN = 1024, LDKR = 64, LDV = 1024, LDO = 2048;
constexpr float SCALE = 0.072168783648703220f;
constexpr float THR = 8.f;
constexpr int SHM_V = KVBLK * 128 * 2, SHM_KN = KVBLK * 128 * 2, SHM_KR = KVBLK * 64 * 2;
constexpr int STG = SHM_V + SHM_KN + SHM_KR, OFF_V = 0, OFF_KN = SHM_V, OFF_KR = SHM_V + SHM_KN, OFF_WS = 3 * STG, SHM_ATTN = OFF_WS + NW * 64 * 4;
typedef __attribute__((address_space(3))) unsigned lds_u32;
#define KSWZ(row, colB) ((row) * 256 + ((colB) ^ (((row) & 15) << 4)))
#define KRSWZ(row, colB) ((row) * 128 + ((colB) ^ ((((row) >> 1) & 7) << 4)))
#define SBAR() __builtin_amdgcn_sched_barrier(0)
__device__ __forceinline__ int crow(int r, int hi) { return (r & 3) + 8 * (r >> 2) + 4 * hi; }
typedef float f32x2a_t __attribute__((ext_vector_type(2))); typedef __bf16 bf16x2a_t __attribute__((ext_vector_type(2)));
__device__ __forceinline__ unsigned cvtpk(float lo, float hi) { f32x2a_t v = {lo, hi}; bf16x2a_t b = __builtin_convertvector(v, bf16x2a_t); return __builtin_bit_cast(unsigned, b); }

constexpr float THRL = THR * 1.4426950408889634f;
#define MX3(a, b, c) fmaxf(fmaxf((a), (b)), (c))
__device__ __forceinline__ void partialSM(f32x16& p0, f32x16& p1, float& m_reg, float& alpha) {
  float a = MX3(p0[0], p0[1], p1[0]), b = MX3(p0[2], p0[3], p1[1]); a = MX3(a, p1[2], p1[3]);
#pragma unroll
  for (int r = 4; r < 16; r += 4) { a = MX3(a, p0[r], p0[r + 1]); b = MX3(b, p0[r + 2], p0[r + 3]); a = MX3(a, p1[r], p1[r + 1]); b = MX3(b, p1[r + 2], p1[r + 3]); }
  float pmax = fmaxf(a, b);
  { auto rr = __builtin_amdgcn_permlane32_swap(__float_as_uint(pmax), __float_as_uint(pmax), false, false);
    pmax = fmaxf(__uint_as_float(rr[0]), __uint_as_float(rr[1])); }
  if (__builtin_expect(__all(pmax <= THRL), 1)) { alpha = 1.f; }
  else { const float d = fmaxf(pmax, 0.f); for (int r = 0; r < 16; ++r) { p0[r] -= d; p1[r] -= d; } m_reg += d; alpha = __builtin_amdgcn_exp2f(-d); }
  for (int r = 0; r < 16; ++r) p0[r] = __builtin_amdgcn_exp2f(p0[r]);
}
#undef MX3
__device__ __forceinline__ void finishSM(f32x16& p0, f32x16& p1, float alpha, float& l_reg, bf16x8& pa0, bf16x8& pa1, bf16x8& pa2, bf16x8& pa3) {
  for (int r = 0; r < 16; ++r) p1[r] = __builtin_amdgcn_exp2f(p1[r]);
  float ps = 0; for (int r = 0; r < 16; ++r) ps += p0[r]; for (int r = 0; r < 16; ++r) ps += p1[r];
  { auto rr = __builtin_amdgcn_permlane32_swap(__float_as_uint(ps), __float_as_uint(ps), false, false);
    ps = __uint_as_float(rr[0]) + __uint_as_float(rr[1]); }
  l_reg = l_reg * alpha + ps;
#define PK4(P, BASE, OUT) do { unsigned a0 = cvtpk(P[BASE + 0], P[BASE + 1]), a1 = cvtpk(P[BASE + 2], P[BASE + 3]);   \
    unsigned b0 = cvtpk(P[BASE + 4], P[BASE + 5]), b1 = cvtpk(P[BASE + 6], P[BASE + 7]);                              \
    auto r0 = __builtin_amdgcn_permlane32_swap(a0, b0, false, false); auto r1 = __builtin_amdgcn_permlane32_swap(a1, b1, false, false); \
    u32x4 w = {r0[0], r1[0], r0[1], r1[1]}; OUT = *reinterpret_cast<bf16x8*>(&w); } while (0)
  PK4(p0, 0, pa0); PK4(p0, 8, pa1); PK4(p1, 0, pa2); PK4(p1, 8, pa3);
#undef PK4
}
__device__ __forceinline__ void qkt(f32x16& p0, f32x16& p1, const char* KNs, const char* KRs, const bf16x8* qr, int r32, int hi, float negm) {
#pragma unroll
  for (int r = 0; r < 16; ++r) { p0[r] = negm; p1[r] = negm; }
#pragma unroll
  for (int d0 = 0; d0 < 8; ++d0) { int cb = (d0 * 16 + hi * 8) * 2;
    bf16x8 b0 = *reinterpret_cast<const bf16x8*>(KNs + KSWZ(r32, cb));
    bf16x8 b1 = *reinterpret_cast<const bf16x8*>(KNs + KSWZ(32 + r32, cb));
    p0 = __builtin_amdgcn_mfma_f32_32x32x16_bf16(b0, qr[d0], p0, 0, 0, 0);
    p1 = __builtin_amdgcn_mfma_f32_32x32x16_bf16(b1, qr[d0], p1, 0, 0, 0); }
#pragma unroll
  for (int d0 = 0; d0 < 4; ++d0) { int cb = (d0 * 16 + hi * 8) * 2;
    bf16x8 b0 = *reinterpret_cast<const bf16x8*>(KRs + KRSWZ(r32, cb));
    bf16x8 b1 = *reinterpret_cast<const bf16x8*>(KRs + KRSWZ(32 + r32, cb));
    p0 = __builtin_amdgcn_mfma_f32_32x32x16_bf16(b0, qr[8 + d0], p0, 0, 0, 0);
    p1 = __builtin_amdgcn_mfma_f32_32x32x16_bf16(b1, qr[8 + d0], p1, 0, 0, 0); }
}
__device__ __forceinline__ int v_st(int k, int c) { const int kk = (k & ~0xC) | ((k & 4) << 1) | ((k & 8) >> 1); return ((kk >> 3) * 4 + (c >> 5)) * 512 + ((kk & 7) * 32 + (c & 31)) * 2; }
__device__ __forceinline__ int v_rd_base(int lane) { return ((lane & 3) << 3) | (((lane >> 2) & 3) << 6) | (((lane >> 4) & 1) << 5) | (((lane >> 5) & 1) << 8); }
constexpr int v_rd_off(int d0, int ks, int half) { return d0 * 512 + ks * 4096 + half * 2048; }
template <int OFF> __device__ __forceinline__ s16x4 tr_read(int vb) {
  s16x4 r; asm volatile("ds_read_b64_tr_b16 %0, %1 offset:%2" : "=&v"(r) : "v"(vb), "i"(OFF) : "memory"); return r;
}
template <int D0> __device__ __forceinline__ void pv_one(f32x16& od, int vb, bf16x8 pa0, bf16x8 pa1, bf16x8 pa2, bf16x8 pa3) {
  const s16x4 l0 = tr_read<v_rd_off(D0, 0, 0)>(vb), h0 = tr_read<v_rd_off(D0, 0, 1)>(vb), l1 = tr_read<v_rd_off(D0, 1, 0)>(vb), h1 = tr_read<v_rd_off(D0, 1, 1)>(vb);
  const s16x4 l2 = tr_read<v_rd_off(D0, 2, 0)>(vb), h2 = tr_read<v_rd_off(D0, 2, 1)>(vb), l3 = tr_read<v_rd_off(D0, 3, 0)>(vb), h3 = tr_read<v_rd_off(D0, 3, 1)>(vb);
  asm volatile("s_waitcnt lgkmcnt(0)" ::: "memory"); SBAR();
#define PK(L, H) (bf16x8){L[0], L[1], L[2], L[3], H[0], H[1], H[2], H[3]}
  od = __builtin_amdgcn_mfma_f32_32x32x16_bf16(pa0, PK(l0, h0), od, 0, 0, 0);
  od = __builtin_amdgcn_mfma_f32_32x32x16_bf16(pa1, PK(l1, h1), od, 0, 0, 0);
  od = __builtin_amdgcn_mfma_f32_32x32x16_bf16(pa2, PK(l2, h2), od, 0, 0, 0);
  od = __builtin_amdgcn_mfma_f32_32x32x16_bf16(pa3, PK(l3, h3), od, 0, 0, 0);
#undef PK
}
__device__ __forceinline__ void pv_d0(f32x16* o, int vb, bf16x8 pa0, bf16x8 pa1, bf16x8 pa2, bf16x8 pa3) {
  pv_one<0>(o[0], vb, pa0, pa1, pa2, pa3); pv_one<1>(o[1], vb, pa0, pa1, pa2, pa3); pv_one<2>(o[2], vb, pa0, pa1, pa2, pa3); pv_one<3>(o[3], vb, pa0, pa1, pa2, pa3);
}
__device__ __forceinline__ unsigned short f2bf(float f) { unsigned u = __builtin_bit_cast(unsigned, f); return (unsigned short)((u + 0x7fffu + ((u >> 16) & 1u)) >> 16); }

__device__ __forceinline__ void attn_unit(const bf16_t* __restrict__ Qb, const bf16_t* __restrict__ KNh, const bf16_t* __restrict__ KRb, const bf16_t* __restrict__ Vh,
                                          bf16_t* __restrict__ Ob, int seq, char* lds, const int wave_s) {
  int wid_ = wave_s; asm volatile("" : "+s"(wid_));
  const int lane = fresh_lane(), wid = wid_, tid = wid * 64 + lane, r32 = lane & 31, hi = lane >> 5;
  float* ws = (float*)(lds + OFF_WS) + wid * 64; float* li_l = ws; float* al_l = ws + 32;
  float m_reg = 0.f, l_reg = 0; f32x16 o[4] = {}; bf16x8 qr[12];
  const bf16_t* Qw = Qb + (long)(wid * QBLK + r32) * LDQ + hi * 8;
#pragma unroll
  for (int d0 = 0; d0 < 12; ++d0) qr[d0] = *reinterpret_cast<const bf16x8*>(Qw + d0 * 16);
  unsigned voV, voK, voR;
  { const int sub = tid >> 5, within = tid & 31, kk = (sub >> 2) * 8 + (within >> 2), c = (sub & 3) * 32 + (within & 3) * 8, k = (kk & ~0xC) | ((kk & 4) << 1) | ((kk & 8) >> 1);
    voV = (unsigned)(k * LDV + c) * 2u;
    const int row = tid >> 4, slot = tid & 15; voK = (unsigned)(row * LDKN * 2 + ((slot << 4) ^ ((row & 15) << 4)));
    const int rr = tid >> 3, sl = tid & 7; voR = (unsigned)(rr * LDKR * 2 + ((sl << 4) ^ (((rr >> 1) & 7) << 4))); }
  const lds_u32* ldsL_ = (const lds_u32*)(lds); (void)ldsL_;
  const int vb0 = (int)(uintptr_t)lds + OFF_V + v_rd_base(lane);
  const int ldsw = wid * 1024;
#define DMA1(src, dstoff) __builtin_amdgcn_global_load_lds((const unsigned*)(src), (lds_u32*)(lds + (dstoff)), 16, 0, 0)
#define ISSUE(st, k0) do { const char* vb_ = (const char*)Vh + (size_t)(k0) * (LDV * 2); const char* kb_ = (const char*)KNh + (size_t)(k0) * (LDKN * 2); const char* rb_ = (const char*)KRb + (size_t)(k0) * (LDKR * 2); \
    DMA1(kb_ + voK, (st) + OFF_KN + ldsw); DMA1(kb_ + 32 * LDKN * 2 + voK, (st) + OFF_KN + 8192 + ldsw); DMA1(rb_ + voR, (st) + OFF_KR + ldsw); \
    DMA1(vb_ + voV, (st) + OFF_V + ldsw); DMA1(vb_ + 32 * LDV * 2 + voV, (st) + OFF_V + 8192 + ldsw); } while (0)
#define TOP() do { asm volatile("s_waitcnt vmcnt(0) lgkmcnt(0)" ::: "memory"); __builtin_amdgcn_s_barrier(); SBAR(); } while (0)
#define RESC(a) do { if (__any((a) < 1.f)) { if (hi == 0) al_l[r32] = (a); asm volatile("s_waitcnt lgkmcnt(0)" ::: "memory"); \
    for (int d = 0; d < 4; ++d) for (int r = 0; r < 16; ++r) o[d][r] *= al_l[crow(r, hi)]; } } while (0)
#define ROT() do { sV = sK; sK = sN; sN = (sN == 2 * STG) ? 0 : sN + STG; } while (0)
  f32x16 pA0, pA1, pB0, pB1; float alA, alB; bf16x8 pa0, pa1, pa2, pa3; const int NT = seq / KVBLK;
  ISSUE(0, 0); ISSUE(STG, KVBLK);
  asm volatile("s_waitcnt vmcnt(5)" ::: "memory"); __builtin_amdgcn_s_barrier(); SBAR();
  qkt(pA0, pA1, lds + OFF_KN, lds + OFF_KR, qr, r32, hi, -m_reg); partialSM(pA0, pA1, m_reg, alA);
  int sV = 0, sK = STG, sN = 2 * STG;
  for (int j = 1; j + 1 < NT; j += 2) {
    TOP(); ISSUE(sN, (j + 1) * KVBLK); SBAR();
    qkt(pB0, pB1, lds + sK + OFF_KN, lds + sK + OFF_KR, qr, r32, hi, -m_reg);
    finishSM(pA0, pA1, alA, l_reg, pa0, pa1, pa2, pa3); SBAR();
    pv_d0(o, vb0 + sV, pa0, pa1, pa2, pa3); partialSM(pB0, pB1, m_reg, alB);
    RESC(alB); ROT();
    TOP(); if (j + 2 < NT) ISSUE(sN, (j + 2) * KVBLK); SBAR();
    qkt(pA0, pA1, lds + sK + OFF_KN, lds + sK + OFF_KR, qr, r32, hi, -m_reg);
    finishSM(pB0, pB1, alB, l_reg, pa0, pa1, pa2, pa3); SBAR();
    pv_d0(o, vb0 + sV, pa0, pa1, pa2, pa3); partialSM(pA0, pA1, m_reg, alA);
    RESC(alA); ROT();
  }
  TOP();
  qkt(pB0, pB1, lds + sK + OFF_KN, lds + sK + OFF_KR, qr, r32, hi, -m_reg);
  finishSM(pA0, pA1, alA, l_reg, pa0, pa1, pa2, pa3); SBAR();
  pv_d0(o, vb0 + sV, pa0, pa1, pa2, pa3); partialSM(pB0, pB1, m_reg, alB);
  RESC(alB);
  finishSM(pB0, pB1, alB, l_reg, pa0, pa1, pa2, pa3); SBAR();
  pv_d0(o, vb0 + sK, pa0, pa1, pa2, pa3);
  if (hi == 0) li_l[r32] = l_reg; asm volatile("s_waitcnt lgkmcnt(0)" ::: "memory");
  const int lane2 = fresh_lane(), r32e = lane2 & 31, hie = lane2 >> 5;
  float rli[16];
#pragma unroll
  for (int r = 0; r < 16; ++r) rli[r] = __builtin_amdgcn_rcpf(li_l[crow(r, hie)]);
  __syncthreads();
  bf16_t* stg = (bf16_t*)lds + wid * 4096;
#pragma unroll
  for (int r = 0; r < 16; ++r) { const int orow = crow(r, hie);
#pragma unroll
    for (int d0 = 0; d0 < 4; ++d0) stg[orow * 128 + d0 * 32 + r32e] = f2bf(o[d0][r] * rli[r]); }
  asm volatile("s_waitcnt lgkmcnt(0)" ::: "memory");
#pragma unroll
  for (int i = 0; i < 8; ++i) { const int row = i * 4 + (lane2 >> 4), ch = lane2 & 15; const u32x4 v = *(const u32x4*)(stg + row * 128 + ch * 8);
    *(u32x4*)(Ob + (long)(wid * QBLK + row) * LDO + ch * 8) = v; }
  __syncthreads();
#undef DMA1
#undef ISSUE
#undef TOP
#undef RESC
#undef ROT
}
#undef KSWZ
#undef KRSWZ
#undef SBAR
}

constexpr int NWAVES = 8;
constexpr size_t MiB = 1u << 20;
constexpr size_t WS_CTL = 0;
constexpr size_t WS_MODS  = 1 * MiB;
constexpr size_t WS_TAB   = WS_MODS + 256 * 1024;
constexpr size_t WS_BIAS1 = WS_TAB + 128 * 1024;
constexpr size_t WS_BIAS2 = WS_BIAS1 + 128 * 1024;
constexpr size_t WS_BIAS3 = WS_BIAS2 + 128 * 1024;
constexpr size_t WS_ROPE  = WS_BIAS3 + 128 * 1024;
constexpr size_t WS_SS1   = WS_ROPE + 64 * 1024;
constexpr size_t WS_SSP2  = 2 * MiB;
constexpr size_t WS_SSP3  = WS_SSP2 + (size_t)T_ALL * 64;
constexpr size_t WS_SSPF  = WS_SSP3 + (size_t)T_ALL * 64;
constexpr size_t WS_SSV   = WS_SSPF + (size_t)T_ALL * 64;
constexpr size_t WS_SSQ   = WS_SSV + (size_t)TC * 64;
constexpr size_t WS_SSC   = WS_SSQ + (size_t)TC * 16;
static_assert(WS_SS1 + (size_t)T_ALL * 4 <= WS_SSP2 && WS_SSC + (size_t)KEYROWS * 16 <= 8 * MiB, "small tables");
constexpr size_t WS_W     = 8 * MiB;
constexpr size_t W_1IN = 0, W_1OUT = W_1IN + (size_t)FF2 * DM * 2, W_IN = W_1OUT + (size_t)DM * FF * 2, W_Q = W_IN + (size_t)NIN * DM * 2, W_KV = W_Q + (size_t)NQ * 256 * 2,
                 W_AB = W_KV + (size_t)NKV * 256 * 2, W_O = W_AB + (size_t)DM * 2048 * 2, W_2IN = W_O + (size_t)DM * DM * 2, W_2OUT = W_2IN + (size_t)FF2 * DM * 2, W_S = W_2OUT + (size_t)DM * FF * 2,
                 W_END = W_S + (size_t)8 * 128 * 128 * 2;
constexpr size_t WS_XS    = 59 * MiB;
static_assert(WS_W + W_END <= WS_XS, "weights");
constexpr size_t WS_BIG   = 107 * MiB;
constexpr size_t B_OAB = 0  , B_OAB2 = 32 * MiB  , B_G = 64 * MiB  , B_Q = 64 * MiB, B_KN = 88 * MiB, B_V = 105 * MiB, B_QL = 122 * MiB, B_CKV = 126 * MiB, B_KR = B_CKV + (size_t)KEYROWS * 256 * 2;
constexpr size_t B_QL0 = 32 * MiB, B_CKV0 = 36 * MiB, B_KR0 = 143 * MiB;
constexpr size_t B_SET2 = 10 * MiB;
constexpr size_t B_SS2 = 142 * MiB;
constexpr size_t WS_END = WS_BIG + 144 * MiB;
static_assert(B_KR + B_SET2 + (size_t)KEYROWS * 64 * 2 <= B_SS2 && WS_END <= 256 * MiB && B_KR + (size_t)KEYROWS * 64 * 2 <= 132 * MiB && B_KN + (size_t)KEYROWS * DM * 2 <= B_V && B_V + (size_t)KEYROWS * DM * 2 <= B_QL && (size_t)T_ALL * FF * 2 <= 132 * MiB, "mixer map");
constexpr int RING_BYTES = 131072, LDSCTL_OFF = 146432  , MISC_OFF = LDSCTL_OFF + 320, LDS_BYTES = 147456;
static_assert(att::SHM_ATTN <= RING_BYTES, "attention scratch");

#define GAS __attribute__((address_space(1)))
#define LAS __attribute__((address_space(3)))
typedef unsigned short bf16;
typedef unsigned v4u __attribute__((ext_vector_type(4)));
typedef unsigned v2u __attribute__((ext_vector_type(2)));
typedef float f32x4 __attribute__((ext_vector_type(4)));
typedef short bf16x8 __attribute__((ext_vector_type(8)));
typedef float f32x16 __attribute__((ext_vector_type(16)));
#define LDS_WAIT() asm volatile("s_waitcnt lgkmcnt(0)" ::: "memory")
#define VM_WAIT() asm volatile("s_waitcnt vmcnt(0)" ::: "memory")
__device__ __forceinline__ unsigned f2bf(float f) { unsigned u = __builtin_bit_cast(unsigned, f); return (u + 0x7fffu + ((u >> 16) & 1u)) >> 16; }
__device__ __forceinline__ unsigned pk2(float lo, float hi) { return f2bf(lo) | (f2bf(hi) << 16); }
__device__ __forceinline__ float bflo(unsigned w) { return __builtin_bit_cast(float, w << 16); }
__device__ __forceinline__ float bfhi(unsigned w) { return __builtin_bit_cast(float, w & 0xffff0000u); }

#define XB_TMO      128
#define XB_XCNT(j)  (256  + 64 * (j))
#define XB_XSUB(j)  (1280 + 64 * (j))
#define XB_XGEN(j)  (2304 + 64 * (j))
#define XB_TOP      3328
#define XB_TOPGEN   3392
#define XCD_BAR_WORDS 3456
#define XB_SPIN_CAP (1u << 21)
__device__ unsigned mk_bar_words[XCD_BAR_WORDS];
__device__ __forceinline__ unsigned xb_ld(unsigned* p)              { return __hip_atomic_load(p, __ATOMIC_RELAXED, __HIP_MEMORY_SCOPE_AGENT); }
__device__ __forceinline__ unsigned xb_add(unsigned* p, unsigned v) { return __hip_atomic_fetch_add(p, v, __ATOMIC_RELAXED, __HIP_MEMORY_SCOPE_AGENT); }
__device__ __forceinline__ unsigned xb_xcc_id() { return (unsigned)__builtin_amdgcn_s_getreg((3 << 11) | 20) & 0xFu; }
#define XB_SPIN(cond, bar) do { unsigned _sp = 0; while (cond) { __builtin_amdgcn_s_sleep(1); \
    if ((++_sp & 255u) == 0u) { if (xb_ld(&(bar)[XB_TMO])) break; if (_sp > XB_SPIN_CAP) { atomicAdd(&(bar)[XB_TMO], 1u); break; } } } } while (0)
struct XcdBarrier { unsigned* bar; unsigned x; volatile LAS unsigned* st; };
__device__ __forceinline__ XcdBarrier xcd_barrier_post(unsigned* bar, volatile LAS unsigned* st) {
    XcdBarrier b; b.bar = bar; b.x = xb_xcc_id(); b.st = st;
    if (threadIdx.x == 0) { (void)xb_add(&bar[XB_XCNT(b.x)], 1u); st[0] = 0u; st[1] = 0u; st[2] = xb_ld(&bar[XB_XGEN(b.x)]); st[3] = xb_ld(&bar[XB_TOPGEN]); }
    return b;
}
__device__ __forceinline__ void xcd_barrier_complete(unsigned* bar, unsigned x, unsigned& nloc, unsigned& nx) {
    const unsigned G = gridDim.x * gridDim.y * gridDim.z;
    unsigned sum, cnt, mine, sp = 0u;
    for (;;) {
        sum = 0u; cnt = 0u; mine = 0u;
#pragma unroll
        for (unsigned j = 0; j < 16; ++j) { const unsigned c = xb_ld(&bar[XB_XCNT(j)]); sum += c; cnt += (c > 0u) ? 1u : 0u; mine = (j == x) ? c : mine; }
        if (sum == G) break;
        __builtin_amdgcn_s_sleep(1);
        if ((++sp & 255u) == 0u) { if (xb_ld(&bar[XB_TMO])) break; if (sp > XB_SPIN_CAP) { atomicAdd(&bar[XB_TMO], 1u); break; } }
    }
    nloc = mine > 0u ? mine : 1u; nx = cnt > 0u ? cnt : 1u;
}
__device__ __forceinline__ void xcd_barrier(const XcdBarrier& b, const int wave_s) {
    asm volatile("s_waitcnt vmcnt(0)" ::: "memory");
    __syncthreads();
    if (wave_s == 0 && fresh_lane() == 0) {
        unsigned* bar = b.bar; unsigned bx_ = b.x; asm volatile("" : "+s"(bar), "+s"(bx_));
        __builtin_amdgcn_s_waitcnt(0);
        unsigned nloc = b.st[0], nx = b.st[1]; const unsigned gx = b.st[2], gt = b.st[3]; bool first = false;
        if (nloc == 0u) { xcd_barrier_complete(bar, bx_, nloc, nx); b.st[0] = nloc; b.st[1] = nx; first = true; }
        b.st[2] = gx + 1u; b.st[3] = gt + 1u;
        const unsigned old = xb_add(&bar[XB_XSUB(bx_)], 1u);
        if (old + 1u == nloc) {
            (void)xb_add(&bar[XB_XSUB(bx_)], 0u - nloc);
            __builtin_amdgcn_fence(__ATOMIC_RELEASE, "agent");
            asm volatile("s_waitcnt vmcnt(0)" ::: "memory");
            const unsigned og = xb_add(&bar[XB_TOP], 1u);
            if (og + 1u == nx) { (void)xb_add(&bar[XB_TOPGEN], 1u); (void)xb_add(&bar[XB_TOP], 0u - nx); }
            else XB_SPIN(xb_ld(&bar[XB_TOPGEN]) == gt, bar);
            (void)xb_add(&bar[XB_XGEN(bx_)], 1u);
            if (first) (void)xb_add(&bar[XB_XCNT(bx_)], 0u - nloc);
            __builtin_amdgcn_fence(__ATOMIC_ACQUIRE, "agent");
            asm volatile("s_waitcnt vmcnt(0)" ::: "memory");
        } else {
            XB_SPIN(xb_ld(&bar[XB_XGEN(bx_)]) == gx, bar);
            __builtin_amdgcn_fence(__ATOMIC_ACQUIRE, "agent");
            asm volatile("s_waitcnt vmcnt(0)" ::: "memory");
        }
    }
    __syncthreads();
}

enum { MAP_PLAIN = 0, MAP_FFNIN = 1, MAP_WIN = 2, MAP_WQ = 3, MAP_WKV = 4 };
__device__ __forceinline__ int dst_row(int mode, int n) {
    if (mode == MAP_FFNIN) { const bool isu = n >= FF; const int j = isu ? n - FF : n; return 256 * (j >> 7) + (isu ? 128 : 0) + (j & 127); }
    if (mode == MAP_WIN) { if (n < 2560) return n; if (n < 2624) { const int d = n - 2560; return 2560 + (d & 32) + pg8::perm32(d & 31); } return 2816 + (n - 2624); }
    if (mode == MAP_WQ) { const int h = n / 192, d = n % 192; if (d < 128) return n; const int dd = d - 128; return h * 192 + 128 + (dd & 32) + pg8::perm32(dd & 31); }
    if (mode == MAP_WKV) { const int h = n >> 8, d = n & 255; return d < 128 ? h * 128 + d : 1024 + h * 128 + (d - 128); }
    return n;
}
__device__ __forceinline__ void tr_item(const float* W, int N, bf16* WT, int ldk, int kofs, int mode, const float* kscale, int item, LAS float* scr, int lane) {
    const int nblk = N / 64, kb = item / nblk, nb = item % nblk, k0 = 64 * kb, n0 = 64 * nb, r = lane >> 4, q = lane & 15;
    f32x4 wv[16];
#pragma unroll
    for (int i = 0; i < 16; ++i) wv[i] = __builtin_nontemporal_load((const f32x4*)(W + (size_t)(k0 + 4 * i + r) * N + n0 + 4 * q));
    if (kscale) {
#pragma unroll
        for (int i = 0; i < 16; ++i) wv[i] *= kscale[k0 + 4 * i + r]; }
#pragma unroll
    for (int i = 0; i < 16; ++i) { LAS float* p = scr + (4 * i + r) * 65 + 4 * q; p[0] = wv[i][0]; p[1] = wv[i][1]; p[2] = wv[i][2]; p[3] = wv[i][3]; }
    LDS_WAIT(); asm volatile("" ::: "memory");
    const int c = lane & 7;
#pragma unroll
    for (int j = 0; j < 8; ++j) { const int n = (lane >> 3) + 8 * j; const LAS float* s = scr + (8 * c) * 65 + n;
        v4u o; o.x = pk2(s[0 * 65], s[1 * 65]); o.y = pk2(s[2 * 65], s[3 * 65]); o.z = pk2(s[4 * 65], s[5 * 65]); o.w = pk2(s[6 * 65], s[7 * 65]);
        *(GAS v4u*)(WT + (size_t)dst_row(mode, n0 + n) * ldk + kofs + k0 + 8 * c) = o; }
    LDS_WAIT(); asm volatile("" ::: "memory");
}
constexpr int IT_FFNIN = 16 * (FF2 / 64), IT_FFNOUT = (FF / 64) * (DM / 64), IT_WIN = 16 * (4672 / 64), IT_WQ = 4 * (NQ / 64), IT_WKV = 4 * (NKV / 64), IT_SQ = 16 * (DM / 64);
constexpr int IT_TR = 2 * IT_FFNIN + 2 * IT_FFNOUT + IT_WIN + IT_WQ + IT_WKV + 3 * IT_SQ;
constexpr int IT_PAD = 192, IT_WS = 256, IT_ROPE = 1;
constexpr int IT_P0 = IT_TR + IT_PAD + IT_WS + IT_ROPE;
constexpr int IT_DEF = 3 * IT_SQ + IT_FFNIN + IT_FFNOUT;

struct KArgs { const float* in[27]; float* out; unsigned char* ws; int ph_lo, ph_hi; int rep_mask, pad; };

__constant__ int PH_KIND[NPH] = {0, 1, 2, 3,        4, 5, 6, 7, 8,           4,          6,       5, 6,     7, 8,         2, 3, 9};
__constant__ int PH_ARG[NPH]  = {0, 0, 0, 0,        0, 0, 0, 0, 0,           1,          1,       2, 2,     1, 1,         1, 1, 0};
__constant__ double ROPE_INV[16] = {1.0, 0.5623413251903491, 0.31622776601683794, 0.1778279410038923, 0.1, 0.05623413251903491, 0.03162277660168379, 0.01778279410038923,
                                    0.01, 0.005623413251903491, 0.0031622776601683794, 0.0017782794100389228, 0.001, 0.0005623413251903491, 0.00031622776601683794, 0.00017782794100389227};

__device__ __forceinline__ void gmlp_pair(int itemA, int itemB, bf16* OAB, const bf16* WSb, const float* SSV, const float* vnorm, const float* bs, LAS unsigned char* L, const int wave_s) {
    int wid_ = wave_s; asm volatile("" : "+s"(wid_));
    const int lane = fresh_lane(), wid = wid_, half = wid >> 2, w4 = wid & 3, t256 = w4 * 64 + lane;
    const int item = half ? itemB : itemA; const bool on = item >= 0;
    const int cq = item >> 3, g = item & 7, r0 = cq * 128, r32 = lane & 31, hi = lane >> 5;
    LAS unsigned short* A_l = (LAS unsigned short*)(L + half * 70144);
    LAS unsigned short* VT_l = (LAS unsigned short*)(L + half * 70144 + 34816);
    LAS float* rstd_l = (LAS float*)(L + half * 70144 + 69632);
    if (on && t256 < 128) { const float* p = SSV + (size_t)(r0 + t256) * 16; float s = 0.f;
#pragma unroll
        for (int q = 0; q < 4; ++q) { const f32x4 t = *(const f32x4*)(p + 4 * q); s += (t[0] + t[1]) + (t[2] + t[3]); }
        rstd_l[t256] = rsqrtf(s * (1.f / 1024.f) + EPS); }
    __syncthreads();
    if (on) {
#pragma unroll
        for (int i = 0; i < 8; ++i) { const int id = t256 + 256 * i, row = id >> 4, ch = id & 15;
            const v4u w = *(const v4u*)(WSb + (size_t)g * 16384 + row * 128 + ch * 8);
            *(LAS v4u*)(A_l + row * 136 + ch * 8) = w;
            const int rw = id & 127, cv = id >> 7;
            const v4u vv = *(const v4u*)(OAB + (size_t)(r0 + rw) * 2048 + 1024 + g * 128 + cv * 8);
            const float rq = rstd_l[rw]; const f32x4 n0 = *(const f32x4*)(vnorm + g * 128 + cv * 8), n1 = *(const f32x4*)(vnorm + g * 128 + cv * 8 + 4);
            LAS unsigned short* vt = VT_l + (cv * 8) * 136 + rw;
            vt[0 * 136] = (unsigned short)f2bf(bflo(vv[0]) * rq * n0[0]); vt[1 * 136] = (unsigned short)f2bf(bfhi(vv[0]) * rq * n0[1]);
            vt[2 * 136] = (unsigned short)f2bf(bflo(vv[1]) * rq * n0[2]); vt[3 * 136] = (unsigned short)f2bf(bfhi(vv[1]) * rq * n0[3]);
            vt[4 * 136] = (unsigned short)f2bf(bflo(vv[2]) * rq * n1[0]); vt[5 * 136] = (unsigned short)f2bf(bfhi(vv[2]) * rq * n1[1]);
            vt[6 * 136] = (unsigned short)f2bf(bflo(vv[3]) * rq * n1[2]); vt[7 * 136] = (unsigned short)f2bf(bfhi(vv[3]) * rq * n1[3]); }
    }
    __syncthreads();
    f32x16 acc[4] = {};
    if (on) {
#pragma unroll
        for (int ks = 0; ks < 8; ++ks) {
            const bf16x8 af = *(const LAS bf16x8*)(A_l + (w4 * 32 + r32) * 136 + ks * 16 + hi * 8);
#pragma unroll
            for (int db = 0; db < 4; ++db) { const bf16x8 bfr = *(const LAS bf16x8*)(VT_l + (db * 32 + r32) * 136 + ks * 16 + hi * 8);
                acc[db] = __builtin_amdgcn_mfma_f32_32x32x16_bf16(af, bfr, acc[db], 0, 0, 0); }
        }
    }
    __syncthreads();
    LAS float* M_l = (LAS float*)(L + half * 70144);
    if (on) {
#pragma unroll
        for (int r = 0; r < 16; ++r) { const int p = w4 * 32 + (r & 3) + 8 * (r >> 2) + 4 * hi; const float bb = bs[p * 8 + g];
#pragma unroll
            for (int db = 0; db < 4; ++db) M_l[p * 132 + db * 32 + r32] = acc[db][r] + bb; }
    }
    __syncthreads();
    if (on) {
#pragma unroll
        for (int i = 0; i < 8; ++i) { const int id = t256 + 256 * i, row = id >> 4, ch = id & 15;
            bf16* up = OAB + (size_t)(r0 + row) * 2048 + g * 128 + ch * 8; const v4u uv = *(const v4u*)up;
            const f32x4 m0 = *(const LAS f32x4*)(M_l + row * 132 + ch * 8), m1 = *(const LAS f32x4*)(M_l + row * 132 + ch * 8 + 4);
            v4u o; o.x = pk2(bflo(uv.x) * m0[0], bfhi(uv.x) * m0[1]); o.y = pk2(bflo(uv.y) * m0[2], bfhi(uv.y) * m0[3]); o.z = pk2(bflo(uv.z) * m1[0], bfhi(uv.z) * m1[1]); o.w = pk2(bflo(uv.w) * m1[2], bfhi(uv.w) * m1[3]);
            *(v4u*)up = o; }
    }
    __syncthreads();
}

__device__ __forceinline__ void bias_pass(int lo, int hi, int gw, int NGW, int lane, const float* mods_, const bf16* w1, const bf16* wi, const bf16* w2, float* b1, float* b2, float* b3) {
    int curmat = -1; float shv[NMOD][16];
#pragma unroll
    for (int mi = 0; mi < NMOD; ++mi)
#pragma unroll
        for (int i = 0; i < 16; ++i) shv[mi][i] = 0.f;
#define BP_ROW(IT) (((IT) < FF2 ? w1 + (size_t)(IT) * DM : (IT) < FF2 + NIN ? wi + (size_t)((IT) - FF2) * DM : w2 + (size_t)((IT) - FF2 - NIN) * DM))
    v4u pw0 = {0u, 0u, 0u, 0u}, pw1 = pw0;
    if (lo + gw < hi) { const bf16* r0 = BP_ROW(lo + gw); pw0 = *(const v4u*)(r0 + 8 * lane); pw1 = *(const v4u*)(r0 + 8 * (lane + 64)); }
    for (int it = lo + gw; it < hi; it += NGW) {
        int mat, n; if (it < FF2) { mat = 0; n = it; } else if (it < FF2 + NIN) { mat = 1; n = it - FF2; } else { mat = 2; n = it - FF2 - NIN; }
        const v4u w0 = pw0, w1v = pw1;
        if (it + NGW < hi) { const bf16* r1 = BP_ROW(it + NGW); pw0 = *(const v4u*)(r1 + 8 * lane); pw1 = *(const v4u*)(r1 + 8 * (lane + 64)); }
        if (mat != curmat) { curmat = mat;
#pragma unroll
            for (int mi = 0; mi < NMOD; ++mi)
#pragma unroll
                for (int j = 0; j < 2; ++j) { const float* sp = mods_ + mi * 9216 + 3 * mat * 1024 + 8 * (lane + 64 * j); const f32x4 s0 = *(const f32x4*)sp, s1 = *(const f32x4*)(sp + 4);
#pragma unroll
                    for (int i = 0; i < 4; ++i) { shv[mi][j * 8 + i] = s0[i]; shv[mi][j * 8 + 4 + i] = s1[i]; } } }
        float wv[16];
#pragma unroll
        for (int k = 0; k < 4; ++k) { wv[2 * k] = bflo(w0[k]); wv[2 * k + 1] = bfhi(w0[k]); wv[8 + 2 * k] = bflo(w1v[k]); wv[8 + 2 * k + 1] = bfhi(w1v[k]); }
        float* bo = (mat == 0 ? b1 : mat == 1 ? b2 : b3); const int nrow = (mat == 1 ? NIN : FF2);
#pragma unroll
        for (int mi = 0; mi < NMOD; ++mi) { float s = 0.f;
#pragma unroll
            for (int i = 0; i < 16; ++i) s += wv[i] * shv[mi][i];
            s = wave_sum(s); if (lane == 0) bo[mi * nrow + n] = s; }
    }
#undef BP_ROW
}

#ifndef MK_ONLY
#define MK_EN(k) true
#else
#define MK_EN(k) ((k) == MK_ONLY)
#endif
#define SS2_DELTA (WS_BIG + B_SS2 - WS_SSV)
#define mods ((float*)(ws + WS_MODS))
#define tab ((float*)(ws + WS_TAB))
#define bias1 ((float*)(ws + WS_BIAS1))
#define bias2 ((float*)(ws + WS_BIAS2))
#define bias3 ((float*)(ws + WS_BIAS3))
#define rope ((float*)(ws + WS_ROPE))
#define ss1 ((float*)(ws + WS_SS1))
#define ssp2 ((float*)(ws + WS_SSP2))
#define ssp3 ((float*)(ws + WS_SSP3))
#define sspf ((float*)(ws + WS_SSPF))
#define SSV ((float*)(ws + WS_SSV + (chunk == 2 ? SS2_DELTA : 0)))
#define SSQ ((float*)(ws + WS_SSQ + (chunk == 2 ? SS2_DELTA : 0)))
#define SSC ((float*)(ws + WS_SSC + (chunk == 2 ? SS2_DELTA : 0)))
#define W1IN ((bf16*)(ws + WS_W + W_1IN))
#define W1OUT ((bf16*)(ws + WS_W + W_1OUT))
#define WIN ((bf16*)(ws + WS_W + W_IN))
#define WQ ((bf16*)(ws + WS_W + W_Q))
#define WKV ((bf16*)(ws + WS_W + W_KV))
#define WAB ((bf16*)(ws + WS_W + W_AB))
#define WO ((bf16*)(ws + WS_W + W_O))
#define W2IN ((bf16*)(ws + WS_W + W_2IN))
#define W2OUT ((bf16*)(ws + WS_W + W_2OUT))
#define WSb ((bf16*)(ws + WS_W + W_S))
#define XS ((bf16*)(ws + WS_XS))
#define ACT ((bf16*)(ws + WS_BIG))
#define OAB ((bf16*)(ws + WS_BIG + B_OAB))
#define OABC ((bf16*)(ws + WS_BIG + (chunk == 2 ? B_OAB2 : B_OAB)))
#define GT ((bf16*)(ws + WS_BIG + (chunk ? B_G : B_OAB2)))
#define Qb ((bf16*)(ws + WS_BIG + B_Q))
#define KN ((bf16*)(ws + WS_BIG + B_KN))
#define Vb ((bf16*)(ws + WS_BIG + B_V))
#define QL ((bf16*)(ws + WS_BIG + (chunk == 0 ? B_QL0 : B_QL + (chunk == 2 ? B_SET2 : 0))))
#define CKV ((bf16*)(ws + WS_BIG + (chunk == 0 ? B_CKV0 : B_CKV + (chunk == 2 ? B_SET2 : 0))))
#define KR ((bf16*)(ws + WS_BIG + (chunk == 0 ? B_KR0 : B_KR + (chunk == 2 ? B_SET2 : 0))))
#define INP(k) ((const float*)(const GAS float*)ap->in[k])
#define OUTP ((float*)(GAS float*)ap->out)
#define X (OUTP)
#define nckv (OUTP + (size_t)T_ALL * DM)
#define rawkr ((float*)(ws + WS_BIG + B_QL + B_SET2 + 8 * MiB))
#define rawckv ((float*)(ws + WS_BIG + B_QL + B_SET2))
#define nkr (OUTP + (size_t)T_ALL * DM + (size_t)T_CTX * 256)
__global__ void __launch_bounds__(NWAVES * 64, 2) mk_fwd(KArgs a) {
    extern __shared__ __attribute__((aligned(16))) unsigned char lds[];
    LAS unsigned char* L = (LAS unsigned char*)lds;
    const int wave_s = __builtin_amdgcn_readfirstlane(threadIdx.x >> 6);
    volatile LAS unsigned* MISC = (volatile LAS unsigned*)(L + MISC_OFF);
    const bool fused = (a.ph_hi - a.ph_lo) > 1;
    XcdBarrier bar; bar.bar = mk_bar_words; bar.x = 0; bar.st = MISC + 8;
    if (fused) bar = xcd_barrier_post(mk_bar_words, MISC + 8);

    for (int ph = a.ph_lo; ph < a.ph_hi; ++ph)
    for (int rep = 0; rep <= ((a.rep_mask >> ph) & 1); ++rep) {
        if (ph != a.ph_lo || rep != 0) xcd_barrier(bar, wave_s);
        int NG = gridDim.x, bx = blockIdx.x; asm volatile("" : "+s"(NG), "+s"(bx));
        const int vcu = (NG % 8 == 0) ? (bx % 8) * (NG / 8) + bx / 8 : bx, NGW = NG * NWAVES;
        int wave = wave_s; asm volatile("" : "+s"(wave));
        const int gw = vcu * NWAVES + wave;
        const __attribute__((address_space(4))) KArgs* ap = (const __attribute__((address_space(4))) KArgs*)__builtin_amdgcn_kernarg_segment_ptr(); asm volatile("" : "+s"(ap));
        GAS unsigned char* ws0 = (GAS unsigned char*)ap->ws; asm volatile("" : "+s"(ws0)); unsigned char* ws = (unsigned char*)ws0;

        const int kind0 = PH_KIND[ph], chunk0 = PH_ARG[ph];
        const bool split = (kind0 == 4 && chunk0 == 0), tailw = split && bx >= NG / 2;
        const bool split7 = (kind0 == 7 && chunk0 == 0), tail7 = split7 && bx >= NG / 2;
        const int chunk = tail7 ? 1 : chunk0;
        const int kind = tailw ? 3 : tail7 ? 4 : kind0, Gx = (split || split7) ? NG / 2 : NG, cx = (tailw || tail7) ? bx - NG / 2 : bx;

        if (kind == 0 && MK_EN(0)) {
            const int lane = fresh_lane(), tid = wave * 64 + lane; (void)tid;
            LAS float* stab = (LAS float*)(L + 67584);
            for (int i = tid; i < NMOD * 1024; i += NWAVES * 64) { const int mi = i >> 10, k = i & 1023; const float cv = mi == 0 ? INP(5)[k] : INP(2)[(mi - 1) * 1024 + k]; stab[k * 8 + mi] = cv / (1.f + __expf(-cv)); }
            __syncthreads();
            LAS float* red = (LAS float*)(L + 100352);
            for (int cgp = vcu; cgp < 576; cgp += NG) {
                const int j0 = 16 * cgp, kq = lane >> 2, cg = lane & 3; const float* wp = INP(6) + j0 + 4 * cg;
                f32x4 ac0 = {0.f, 0.f, 0.f, 0.f}, ac1 = ac0, ac2 = ac0, ac3 = ac0, ac4 = ac0;
#pragma unroll
                for (int i = 0; i < 8; ++i) { const int k = wave * 128 + kq + 16 * i; const f32x4 w = __builtin_nontemporal_load((const f32x4*)(wp + (size_t)k * 9216));
                    const f32x4 s03 = *(const LAS f32x4*)(stab + k * 8); const float s4 = stab[k * 8 + 4];
                    ac0 += w * s03[0]; ac1 += w * s03[1]; ac2 += w * s03[2]; ac3 += w * s03[3]; ac4 += w * s4; }
#pragma unroll
                for (int c = 0; c < 4; ++c) {
#define RED5(OP) ac0[c] = OP(ac0[c]); ac1[c] = OP(ac1[c]); ac2[c] = OP(ac2[c]); ac3[c] = OP(ac3[c]); ac4[c] = OP(ac4[c]);
#define R4(v) ((v) + dpp_get<0x124>(v))
#define R8(v) ((v) + dpp_get<0x128>(v))
#define R16(v) add_xor16(v)
                    RED5(R4) RED5(R8) RED5(R16) RED5(add_xor32)
#undef RED5
#undef R4
#undef R8
#undef R16
                }
                if (lane < 4) { LAS float* rp = red + (wave * 4 + lane) * 20; *(LAS f32x4*)(rp) = ac0; *(LAS f32x4*)(rp + 4) = ac1; *(LAS f32x4*)(rp + 8) = ac2; *(LAS f32x4*)(rp + 12) = ac3; *(LAS f32x4*)(rp + 16) = ac4; }
                __syncthreads();
                if (tid < 80) { const int l4 = tid / 20, e = tid % 20; float t = 0.f;
#pragma unroll
                    for (int w8 = 0; w8 < 8; ++w8) t += red[(w8 * 4 + l4) * 20 + e];
                    const int mi = e >> 2, col = j0 + 4 * l4 + (e & 3); mods[mi * 9216 + col] = t + INP(7)[col]; }
                __syncthreads();
            }
            LAS float* scr = (LAS float*)(L + wave * 16640);
            for (int it = NGW - 1 - gw; it < IT_P0 - IT_DEF; it += NGW) {
                int r = it;
                if (r < IT_FFNIN)  { tr_item(INP(9),  FF2, W1IN, DM, 0, MAP_FFNIN, nullptr, r, scr, lane); continue; } r -= IT_FFNIN;
                if (r < IT_FFNOUT) { tr_item(INP(10), DM, W1OUT, FF, 0, MAP_PLAIN, nullptr, r, scr, lane); continue; } r -= IT_FFNOUT;
                if (r < IT_WIN)    { tr_item(INP(12), 4672, WIN, DM, 0, MAP_WIN, nullptr, r, scr, lane); continue; } r -= IT_WIN;
                if (r < IT_WQ)     { tr_item(INP(17), NQ, WQ, 256, 0, MAP_WQ, INP(16), r, scr, lane); continue; } r -= IT_WQ;
                if (r < IT_WKV)    { tr_item(INP(19), NKV, WKV, 256, 0, MAP_WKV, INP(18), r, scr, lane); continue; } r -= IT_WKV;
                if (r < IT_PAD)    { const v4u z = {0u, 0u, 0u, 0u}; bf16* p = WIN + (size_t)(2624 + r) * DM + lane * 16; *(v4u*)p = z; *(v4u*)(p + 8) = z; continue; } r -= IT_PAD;
                if (r < IT_WS)     { const float* s = INP(14) + (size_t)r * 512 + lane * 8; const f32x4 x0 = *(const f32x4*)s, x1 = *(const f32x4*)(s + 4);
                                     v4u o; o.x = pk2(x0[0], x0[1]); o.y = pk2(x0[2], x0[3]); o.z = pk2(x1[0], x1[1]); o.w = pk2(x1[2], x1[3]); *(v4u*)(WSb + (size_t)r * 512 + lane * 8) = o; continue; } r -= IT_WS;
                if (lane < 16) {
                    const double th = ROPE_INV[lane], t2 = th * th;
                    const double s1 = th * (1.0 - t2 * (1.0 / 6.0) * (1.0 - t2 * (1.0 / 20.0) * (1.0 - t2 * (1.0 / 42.0) * (1.0 - t2 * (1.0 / 72.0) * (1.0 - t2 * (1.0 / 110.0) * (1.0 - t2 * (1.0 / 156.0) * (1.0 - t2 * (1.0 / 210.0))))))));
                    const double c1 = 1.0 - t2 * (1.0 / 2.0) * (1.0 - t2 * (1.0 / 12.0) * (1.0 - t2 * (1.0 / 30.0) * (1.0 - t2 * (1.0 / 56.0) * (1.0 - t2 * (1.0 / 90.0) * (1.0 - t2 * (1.0 / 132.0) * (1.0 - t2 * (1.0 / 182.0)))))));
                    double cp = 1.0, sp = 0.0;
                    for (int pos = 0; pos < 64; ++pos) { rope[pos * 16 + lane] = (float)cp; rope[1024 + pos * 16 + lane] = (float)sp; const double cn = cp * c1 - sp * s1, sn = sp * c1 + cp * s1; cp = cn; sp = sn; }
                }
            }
        } else if (kind == 1 && MK_EN(1)) {
            const int lane = fresh_lane(), tid = wave * 64 + lane; (void)tid;
            for (int it = gw; it < 480; it += NGW) { const int idx = it * 64 + lane, k = idx / 5120, rem = idx % 5120, mi = rem >> 10, c = rem & 1023; const float* mm = mods + mi * 9216; float v;
                if (k == 0) v = INP(8)[c] * (1.f + mm[1024 + c]); else if (k == 1) v = INP(11)[c] * (1.f + mm[4 * 1024 + c]); else if (k == 2) v = INP(23)[c] * (1.f + mm[7 * 1024 + c]);
                else if (k == 3) v = 0.5f * mm[2 * 1024 + c]; else if (k == 4) v = mm[5 * 1024 + c]; else v = 0.5f * mm[8 * 1024 + c];
                tab[idx] = v; }
            bias_pass(0, FF2 + NIN, gw, NGW, lane, mods, W1IN, WIN, W2IN, bias1, bias2, bias3);
            for (int m0 = gw; m0 < T_ALL; m0 += 2 * NGW) {
                const int m1 = m0 + NGW, mi = m0 < T_CTX ? 0 : 1 + ((m0 - T_CTX) >> 12);
                const float* s0 = m0 < T_CTX ? INP(0) + (size_t)m0 * DM : INP(1) + (size_t)(m0 - T_CTX) * DM; const float* s1 = m1 < T_CTX ? INP(0) + (size_t)m1 * DM : INP(1) + (size_t)(m1 - T_CTX) * DM;
                const float* sc = mods + mi * 9216 + 1024; f32x4 xa[4], xb[4], cs[4]; float ssa = 0.f, ssb = 0.f;
#pragma unroll
                for (int j = 0; j < 4; ++j) { const int c = 4 * lane + 256 * j; xa[j] = __builtin_nontemporal_load((const f32x4*)(s0 + c)); xb[j] = __builtin_nontemporal_load((const f32x4*)(s1 + c));     cs[j] = *(const f32x4*)(INP(8) + c) * (1.f + *(const f32x4*)(sc + c)); }
#pragma unroll
                for (int j = 0; j < 4; ++j) { const int c = 4 * lane + 256 * j; ssa += (xa[j][0] * xa[j][0] + xa[j][1] * xa[j][1]) + (xa[j][2] * xa[j][2] + xa[j][3] * xa[j][3]); ssb += (xb[j][0] * xb[j][0] + xb[j][1] * xb[j][1]) + (xb[j][2] * xb[j][2] + xb[j][3] * xb[j][3]);
                    const f32x4 ya = xa[j] * cs[j], yb = xb[j] * cs[j]; v2u o; o.x = pk2(ya[0], ya[1]); o.y = pk2(ya[2], ya[3]); *(v2u*)(XS + (size_t)m0 * DM + c) = o; o.x = pk2(yb[0], yb[1]); o.y = pk2(yb[2], yb[3]); *(v2u*)(XS + (size_t)m1 * DM + c) = o; }
                ssa = wave_sum(ssa); ssb = wave_sum(ssb); if (lane == 0) { ss1[m0] = ssa; ss1[m1] = ssb; }
            }
        } else if (kind == 2 && MK_EN(2)) {
            const bool second = (chunk == 1);
            pg8::Gemm g{XS, second ? W2IN : W1IN, T_ALL, FF2, DM, DM}; pg8::StaticOrder S; S.init(T_ALL, FF2, NG, bx);
            pg8::EpiSwiGLU E{ACT, second ? ssp3 : ss1, second ? 16 : 1, second ? bias3 : bias1};
            pg8::gemm_phase<pg8::EpiSwiGLU, pg8::StaticOrder, true, true>(L, g, S, E, wave_s);
            if (!second && bx >= 128) {
                const int lane = fresh_lane(); LAS float* scr = (LAS float*)(L + wave * 16640);
                for (int it = (bx - 128) * NWAVES + wave; it < IT_DEF - IT_FFNOUT; it += (NG - 128) * NWAVES) {
                    int r = it;
                    if (r < IT_SQ)     { tr_item(INP(20), DM, WAB, 2048, 0, MAP_PLAIN, nullptr, r, scr, lane); continue; } r -= IT_SQ;
                    if (r < IT_SQ)     { tr_item(INP(21), DM, WAB, 2048, 1024, MAP_PLAIN, nullptr, r, scr, lane); continue; } r -= IT_SQ;
                    if (r < IT_SQ)     { tr_item(INP(22), DM, WO, DM, 0, MAP_PLAIN, nullptr, r, scr, lane); continue; } r -= IT_SQ;
                    tr_item(INP(24), FF2, W2IN, DM, 0, MAP_FFNIN, nullptr, r, scr, lane);
                }
            }
        } else if ((kind == 3 || kind == 8) && MK_EN(3)) {
            pg8::Gemm g; pg8::EpiResid E; pg8::StaticOrder S;
            if (kind == 3) { const bool second = (chunk == 1);
                g = pg8::Gemm{ACT + (tailw ? (size_t)16384 * FF : 0), second ? W2OUT : W1OUT, second ? T_ALL : (tailw ? 8192 : 16384), DM, FF, FF};
                E = second ? pg8::EpiResid{tab + 2 * 5120, tab + 5 * 5120, INP(26), 0, XS, sspf, 0}
                           : pg8::EpiResid{tab + 0 * 5120, tab + 3 * 5120, tab + 1 * 5120, DM, XS, ssp2, tailw ? 64 : 0};
            } else {
                g = pg8::Gemm{GT, WO, chunk ? 2 * TC : TC, DM, DM, 2048};
                E = pg8::EpiResid{tab + 1 * 5120, tab + 4 * 5120, tab + 2 * 5120, DM, XS, ssp3, chunk * 32};
            }
            S.init(g.M, g.N, Gx, cx);
            if (kind == 3) { g.K = FF; g.lda = FF; pg8::gemm_phase<pg8::EpiResid, pg8::StaticOrder, true, true>(L, g, S, E, wave_s); }
            else           { g.K = DM; g.lda = 2048; pg8::gemm_phase<pg8::EpiResid, pg8::StaticOrder, true, true>(L, g, S, E, wave_s); }
            if (tailw) bias_pass(FF2 + NIN, FF2 + NIN + FF2, cx * NWAVES + wave, Gx * NWAVES, fresh_lane(), mods, W1IN, WIN, W2IN, bias1, bias2, bias3);
        } else if (kind == 4 && MK_EN(4)) {
            const int lane = fresh_lane(), tid = wave * 64 + lane; (void)tid;
            const int Mw = chunk ? 2 * TC : TC;
            const int pn0 = tail7 ? 8 : 0, Nw = chunk == 0 ? 2816 : (tail7 ? 768 : 2048);
            pg8::Gemm g{XS + (size_t)chunk * TC * DM, WIN + (size_t)pn0 * 256 * DM, Mw, Nw, DM, DM}; pg8::StaticOrder S; S.init(Mw, Nw, Gx, cx);
            pg8::EpiWin E{ssp2, bias2, OAB, QL, CKV, KR, SSV, SSQ, SSC, rawckv, rawkr, rope, chunk, (long)B_SET2, (long)SS2_DELTA, pn0};
            pg8::gemm_phase<pg8::EpiWin, pg8::StaticOrder, true, true>(L, g, S, E, wave_s);
            if (tail7) {
                const int lane2 = fresh_lane(); LAS float* scr = (LAS float*)(L + wave * 16640);
                for (int it = cx * NWAVES + wave; it < IT_FFNOUT; it += Gx * NWAVES) tr_item(INP(25), DM, W2OUT, FF, 0, MAP_PLAIN, nullptr, it, scr, lane2);
                for (int it = cx * NWAVES + wave; it < 1024; it += Gx * NWAVES) { const int b = it >> 8, t = it & 255; const size_t kr = (size_t)(b & 1) * 4352 + t; const size_t d2 = (b >> 1) ? B_SET2 : 0;
                const f32x4 x = *(const f32x4*)(INP(3) + ((size_t)b * 256 + t) * 256 + 4 * lane2), kn = *(const f32x4*)(INP(18) + 4 * lane2);
                v2u o; o.x = pk2(x[0] / kn[0], x[1] / kn[1]); o.y = pk2(x[2] / kn[2], x[3] / kn[3]); *(v2u*)((char*)(CKV + kr * 256 + 4 * lane2) + d2) = o;
                const int s = lane2 & 31, dim = (lane2 & 32) + 16 * ((s >> 2) & 1) + 4 * (s >> 3) + (s & 3);
                *(bf16*)((char*)(KR + kr * 64 + lane2) + d2) = (bf16)f2bf(INP(4)[((size_t)b * 256 + t) * 64 + dim]); }
            }
        }
        if ((kind == 5 || (kind0 == 4 && chunk0 == 1)) && MK_EN(5)) {
            const int lane = fresh_lane(), tid = wave * 64 + lane; (void)tid;
#if !defined(MK_SUB) || MK_SUB == 0
            { pg8::Gemm g{QL, WQ, TC, NQ, 256, 256}; pg8::StaticOrder S; S.init(TC, NQ, NG, bx); pg8::EpiQ E{Qb, SSQ, rope, chunk};
              pg8::gemm_phase<pg8::EpiQ, pg8::StaticOrder, true, true>(L, g, S, E, wave_s); }
#endif
#if !defined(MK_SUB) || MK_SUB == 1
            { const int Mk = chunk == 0 ? TC : KEYROWS; pg8::Gemm g{CKV, WKV, Mk, NKV, 256, 256}; pg8::StaticOrder S; S.init(Mk, NKV, NG, (bx + 64) % NG);   pg8::EpiKV E{KN, Vb, SSC, chunk};
              pg8::gemm_phase<pg8::EpiKV, pg8::StaticOrder, true, true>(L, g, S, E, wave_s); }
#endif
#if !defined(MK_SUB) || MK_SUB == 2
#endif
            if (chunk == 0) for (int m = gw; m < T_CTX; m += NGW) { const f32x4 p = *(const f32x4*)(SSC + (size_t)m * 4); const float rstd = rsqrtf(((p[0] + p[1]) + (p[2] + p[3])) * (1.f / 256.f) + EPS);
                const f32x4 v = *(const f32x4*)(rawckv + (size_t)m * 256 + 4 * lane), kn = *(const f32x4*)(INP(18) + 4 * lane); __builtin_nontemporal_store(v * rstd * kn, (f32x4*)(nckv + (size_t)m * 256 + 4 * lane)); }
            if (chunk == 0) for (int i = gw; i < T_CTX * 64 / 256; i += NGW) __builtin_nontemporal_store(*(const f32x4*)(rawkr + (size_t)i * 256 + 4 * lane), (f32x4*)(nkr + (size_t)i * 256 + 4 * lane));
        } else if (kind == 6 && MK_EN(6)) {
            if (chunk == 0) {
                pg8::Gemm g{XS, WIN + (size_t)2816 * DM, TC, 2048, DM, DM}; pg8::StaticOrder S; S.init(TC, 2048, NG, bx);
                pg8::EpiGate E{ssp2, bias2, GT, 0};
                pg8::gemm_phase<pg8::EpiGate, pg8::StaticOrder, true, true>(L, g, S, E, wave_s);
            }
            for (int u = vcu; u < 256; u += NG) {
                const int b0 = u >> 3, h0 = u & 7, bh = u >> 4, qb = u & 15, j = bh >> 3, h1 = bh & 7;
                const int cq0 = chunk == 0 ? 2 * b0 : j * 32 + qb * 2, hh = chunk == 0 ? h0 : h1;
                gmlp_pair(cq0 * 8 + hh, (cq0 + 1) * 8 + hh, OABC, WSb, SSV, INP(13), INP(15), L, wave_s);
                if (chunk == 0) { const int b = b0, h = h0; const size_t r0 = (size_t)b * 256;
                    att::attn_unit(Qb + r0 * NQ + h * 192, KN + r0 * DM + h * 128, KR + r0 * 64, Vb + r0 * DM + h * 128, OABC + r0 * 2048 + 1024 + h * 128, 256, (char*)lds, wave_s);
                } else { const int h = h1; const size_t q0 = (size_t)j * 4096 + qb * 256, k0 = (size_t)j * 4352;
                    att::attn_unit(Qb + q0 * NQ + h * 192, KN + k0 * DM + h * 128, KR + k0 * 64, Vb + k0 * DM + h * 128, OABC + q0 * 2048 + 1024 + h * 128, 4352, (char*)lds, wave_s); }
            }
        } else if (kind == 7 && MK_EN(7)) {
            const int Mg = chunk ? 2 * TC : TC; pg8::Gemm g{OAB, WAB, Mg, DM, 2048, 2048}; pg8::StaticOrder S; S.init(Mg, DM, Gx, cx); pg8::EpiMerge E{GT};
            if (chunk == 1) {
                pg8::Unit um; if (S.next(0, um)) { pg8::Gemm gg{XS + (size_t)T_CTX * DM, WIN + (size_t)2816 * DM, Mg, 2048, DM, DM}; pg8::StaticOrder Sg; Sg.init(Mg, 2048, NG, bx); Sg.pair = 1; Sg.pm0 = um.pm; Sg.pn0 = um.pn;
                    pg8::EpiGate Eg{ssp2, bias2, GT, 32}; pg8::gemm_phase<pg8::EpiGate, pg8::StaticOrder, true, true>(L, gg, Sg, Eg, wave_s); } }
            pg8::gemm_phase<pg8::EpiMerge, pg8::StaticOrder, true, true>(L, g, S, E, wave_s);
        } else if (kind == 9 && MK_EN(9)) {
            const int lane = fresh_lane(), tid = wave * 64 + lane; (void)tid;
            for (int m0 = 2 * gw; m0 < T_ALL; m0 += 2 * NGW) { const int m1 = m0 + 1;
                const float pa = lane < 16 ? sspf[(size_t)m0 * 16 + lane] : 0.f, pb = lane < 16 ? sspf[(size_t)m1 * 16 + lane] : 0.f; v2u xa[4], xb[4];
#pragma unroll
                for (int j = 0; j < 4; ++j) { const int c = 4 * lane + 256 * j; xa[j] = *(const v2u*)(XS + (size_t)m0 * DM + c); xb[j] = *(const v2u*)(XS + (size_t)m1 * DM + c); }
                const float ra = rsqrtf(wave_sum(pa) * (1.f / DM) + EPS), rb = rsqrtf(wave_sum(pb) * (1.f / DM) + EPS);
#pragma unroll
                for (int j = 0; j < 4; ++j) { const int c = 4 * lane + 256 * j;
                    __builtin_nontemporal_store((f32x4){bflo(xa[j].x), bfhi(xa[j].x), bflo(xa[j].y), bfhi(xa[j].y)} * ra, (f32x4*)(X + (size_t)m0 * DM + c)); }
#pragma unroll
                for (int j = 0; j < 4; ++j) { const int c = 4 * lane + 256 * j;
                    __builtin_nontemporal_store((f32x4){bflo(xb[j].x), bfhi(xb[j].x), bflo(xb[j].y), bfhi(xb[j].y)} * rb, (f32x4*)(X + (size_t)m1 * DM + c)); } }
        }
    }
}

#undef INP
#undef SS2_DELTA
#undef OABC
#undef OUTP
#undef mods
#undef tab
#undef bias1
#undef bias2
#undef bias3
#undef rope
#undef ss1
#undef ssp2
#undef ssp3
#undef sspf
#undef SSV
#undef SSQ
#undef SSC
#undef W1IN
#undef W1OUT
#undef WIN
#undef WQ
#undef WKV
#undef WAB
#undef WO
#undef W2IN
#undef W2OUT
#undef WSb
#undef XS
#undef ACT
#undef OAB
#undef GT
#undef Qb
#undef KN
#undef Vb
#undef QL
#undef CKV
#undef KR
#undef X
#undef nckv
#undef rawckv
#undef rawkr
#undef nkr
#ifndef MK_SPLIT
#define MK_SPLIT 0
#endif
extern "C" void kernel_launch(void* const* d_in, const int* in_sizes, int n_in, void* d_out, int out_size, void* d_ws, size_t ws_size, hipStream_t stream) {
    static int grid = 0;
    if (grid == 0) {
        if (n_in != 27 || ws_size < WS_END || out_size != T_ALL * DM + T_CTX * 256 + T_CTX * 64) { fprintf(stderr, "kernel_launch: unexpected shapes: n_in %d out %d ws %zu (need %zu)\n", n_in, out_size, ws_size, (size_t)WS_END); grid = -1; return; }
        int dev = 0, cus = 0, per_cu = 0;
        if (hipGetDevice(&dev) != hipSuccess || hipDeviceGetAttribute(&cus, hipDeviceAttributeMultiprocessorCount, dev) != hipSuccess) { grid = -1; return; }
        if (hipFuncSetAttribute((const void*)mk_fwd, hipFuncAttributeMaxDynamicSharedMemorySize, LDS_BYTES) != hipSuccess) { fprintf(stderr, "kernel_launch: hipFuncSetAttribute failed\n"); grid = -1; return; }
        if (hipOccupancyMaxActiveBlocksPerMultiprocessor(&per_cu, (const void*)mk_fwd, NWAVES * 64, LDS_BYTES) != hipSuccess || per_cu < 1) { fprintf(stderr, "kernel_launch: occupancy query says %d\n", per_cu); per_cu = 1; }
        (void)hipGetLastError();
        if (cus < 256) { fprintf(stderr, "kernel_launch: built for a 256-CU device (got %d CUs)\n", cus); grid = -1; return; }
        grid = 256;
    }
    if (grid < 0) return;
    KArgs a{};
    for (int i = 0; i < 27; ++i) a.in[i] = (const float*)d_in[i];
    a.out = (float*)d_out; a.ws = (unsigned char*)d_ws;
#if MK_SPLIT
#ifndef MK_SKIP_MASK
#define MK_SKIP_MASK 0u
#endif
    for (int p = 0; p < NPH; ++p) { if ((MK_SKIP_MASK >> p) & 1u) continue; a.ph_lo = p; a.ph_hi = p + 1; hipLaunchKernelGGL(mk_fwd, dim3(grid), dim3(NWAVES * 64), LDS_BYTES, stream, a); }
#else
#ifndef MK_REPEAT_MASK
#define MK_REPEAT_MASK 0
#endif
    a.ph_lo = 0; a.ph_hi = NPH; a.rep_mask = MK_REPEAT_MASK;
    void* args[] = {&a};
    hipError_t e = hipLaunchCooperativeKernel((const void*)mk_fwd, dim3(grid), dim3(NWAVES * 64), args, LDS_BYTES, stream);
    if (e != hipSuccess) fprintf(stderr, "kernel_launch: cooperative launch failed: %s (grid %d)\n", hipGetErrorString(e), grid);
#endif
}
```

```cpp
#include <hip/hip_runtime.h>
#include <cstdio>
#include <cstdint>

constexpr int DM = 1024;
constexpr int T_CTX = 8192, T_LAT = 16384, T_ALL = 24576;
constexpr int TC = 8192, NCHUNK = 3;
constexpr int FF = 2816, FF2 = 5632;
constexpr int NIN = 4864;
constexpr int NQ = 1536, NKV = 2048;
constexpr int KEYROWS = 8704;
constexpr float EPS = 1e-6f;
constexpr int NMOD = 5;
constexpr int NPH = 18;

template <int O> __device__ __forceinline__ float xor_swz(float v) {
    return __builtin_bit_cast(float, __builtin_amdgcn_ds_swizzle(__builtin_bit_cast(int, v), (O << 10) | 0x1f)); }
__device__ __forceinline__ float add_xor32(float v) {
    auto r = __builtin_amdgcn_permlane32_swap(__builtin_bit_cast(unsigned, v), __builtin_bit_cast(unsigned, v), false, false);
    const unsigned r0 = r[0], r1 = r[1];
    return __builtin_bit_cast(float, r0) + __builtin_bit_cast(float, r1); }
__device__ __forceinline__ float add_xor16(float v) {
    auto r = __builtin_amdgcn_permlane16_swap(__builtin_bit_cast(unsigned, v), __builtin_bit_cast(unsigned, v), false, false);
    const unsigned r0 = r[0], r1 = r[1];
    return __builtin_bit_cast(float, r0) + __builtin_bit_cast(float, r1); }
template <int CTRL> __device__ __forceinline__ float dpp_get(float v) {
    return __builtin_bit_cast(float, __builtin_amdgcn_update_dpp(0, __builtin_bit_cast(int, v), CTRL, 0xF, 0xF, true)); }
__device__ __forceinline__ float wave_sum(float v) {
    v += dpp_get<0xB1>(v); v += dpp_get<0x4E>(v); v += dpp_get<0x141>(v); v += dpp_get<0x140>(v); v = add_xor16(v); return add_xor32(v); }
__device__ __forceinline__ float lane_bcast(float v, int srclane) {
    return __builtin_bit_cast(float, __builtin_amdgcn_ds_bpermute(srclane << 2, __builtin_bit_cast(int, v))); }

__device__ __forceinline__ int fresh_lane() { int l; asm volatile("v_mbcnt_lo_u32_b32 %0, -1, 0\n\tv_mbcnt_hi_u32_b32 %0, -1, %0" : "=v"(l)); return l; }

namespace pg8 {
#define PG8_LAS __attribute__((address_space(3)))
typedef unsigned short bf16_t;
typedef short bf16x8 __attribute__((ext_vector_type(8)));
typedef float f32x4 __attribute__((ext_vector_type(4)));
typedef unsigned u32x4 __attribute__((ext_vector_type(4)));
constexpr int BM = 256, BK = 64, HALF = 128, HTB = HALF * BK * 2  , STAGE_BYTES = 8 * HTB, NXCD = 8, WGM = 8;

__host__ __device__ __forceinline__ int lds_byte(int r, int c) { const int st = (r >> 4) * 2 + (c >> 5), rr = r & 15, cc = c & 31, ob = rr * 64 + cc * 2; return st * 1024 + (ob ^ (((ob >> 9) & 1) << 5)); }
__host__ __device__ __forceinline__ void stage_rc(int b, int& R, int& C) { const int st = b / 1024, sb = b % 1024, swz = sb ^ (((sb >> 9) & 1) << 5); R = (st >> 1) * 16 + swz / 64; C = (st & 1) * 32 + (swz % 64) / 2; }
__host__ __device__ __forceinline__ int perm32(int rho) { const int n = rho >> 4, i = rho & 15; return 8 * (i >> 2) + 4 * n + (i & 3); }

struct Unit { int pm, pn, half; };
struct Gemm { const bf16_t* A; const bf16_t* Bt; int M, N, K, lda; };

struct StaticOrder {
    int nM, nN, nwg, G, c, pair, pm0, pn0;
    __host__ __device__ void init(int M, int N, int G_, int c_) { nM = M / BM; nN = N / BM; nwg = nM * nN; G = G_; c = c_; pair = 0; pm0 = 0; pn0 = 0; }
    __host__ __device__ __forceinline__ bool next(int i, Unit& u) const {
        if (pair) { if (i > 1) return false; u.pm = pm0; u.pn = pn0 + 4 * i; u.half = 0; return true; }
        const int rfull = nwg / G, R = nwg - rfull * G;
        if (i == rfull && R > 0 && 2 * R <= G) { if (c >= 2 * R) return false;
            const bool ok = at((long)rfull * G + (((c >> 4) << 3) | (c & 7)), u); u.half = 1 + ((c >> 3) & 1); return ok; }
        return at((long)i * G + c, u);
    }
    __host__ __device__ __forceinline__ bool at(const long L, Unit& u) const {
        if (L >= nwg) return false;
        int wgid = (int)L; { const int q = nwg / NXCD, r = nwg % NXCD, xcd = wgid % NXCD, off = wgid / NXCD; wgid = (xcd < r ? xcd * (q + 1) : r * (q + 1) + (xcd - r) * q) + off; }
        const int nig = WGM * nN, gid = wgid / nig, fm = gid * WGM, gsz = (nM - fm) < WGM ? (nM - fm) : WGM;
        u.pm = fm + ((wgid % nig) % gsz); u.pn = (wgid % nig) / gsz; u.half = 0; return true;
    }
    __device__ __forceinline__ void a_ready(const Unit&) const {}
    __device__ __forceinline__ void done(const Unit&) const {}
};

typedef float f32x2c_t __attribute__((ext_vector_type(2))); typedef __bf16 bf16x2c_t __attribute__((ext_vector_type(2)));
__device__ __forceinline__ unsigned cvt_pk_bf16(float lo, float hi) { f32x2c_t v = {lo, hi}; bf16x2c_t b = __builtin_convertvector(v, bf16x2c_t); return __builtin_bit_cast(unsigned, b); }
typedef float f32x2 __attribute__((ext_vector_type(2)));
typedef unsigned u32x2 __attribute__((ext_vector_type(2)));
__device__ __forceinline__ float silu_f(float x) { return x * __builtin_amdgcn_rcpf(1.f + __expf(-x)); }
__device__ __forceinline__ float sigm_f(float x) { return __builtin_amdgcn_rcpf(1.f + __expf(-x)); }
__device__ __forceinline__ u32x4 pack8(const f32x4 a, const f32x4 b) { u32x4 w; w.x = cvt_pk_bf16(a[0], a[1]); w.y = cvt_pk_bf16(a[2], a[3]); w.z = cvt_pk_bf16(b[0], b[1]); w.w = cvt_pk_bf16(b[2], b[3]); return w; }
__device__ __forceinline__ float bf_lo(unsigned w) { return __builtin_bit_cast(float, w << 16); }
__device__ __forceinline__ float bf_hi(unsigned w) { return __builtin_bit_cast(float, w & 0xffff0000u); }
__device__ __forceinline__ float dot4(const f32x4 x) { return (x[0] * x[0] + x[1] * x[1]) + (x[2] * x[2] + x[3] * x[3]); }
__device__ __forceinline__ int mod_index(int gpm) { return gpm < 32 ? 0 : 1 + ((gpm - 32) >> 4); }

template <int NP>
__device__ __forceinline__ void row_rstd(const float* ssp, int rbase, float invn, int fq, int lane, float (&rs)[2][4]) {
    float v[2];
#pragma unroll
    for (int ai = 0; ai < 2; ++ai) {
        const float* p = ssp + (size_t)(rbase + ai * 128 + fq * 16) * NP; float s;
        if constexpr (NP == 1) { s = p[0]; }
        else { s = 0.f;
#pragma unroll
            for (int q = 0; q < NP / 4; ++q) { const f32x4 t = *(const f32x4*)(p + 4 * q); s += (t[0] + t[1]) + (t[2] + t[3]); } }
        v[ai] = rsqrtf(s * invn + EPS);
    }
#pragma unroll
    for (int ai = 0; ai < 2; ++ai) {
        const unsigned x = __builtin_bit_cast(unsigned, v[ai]);
        auto s16 = __builtin_amdgcn_permlane16_swap(x, x, false, false); const unsigned e = s16[0], o = s16[1];
        auto se = __builtin_amdgcn_permlane32_swap(e, e, false, false); const unsigned e0 = se[0], e2 = se[1];
        auto so = __builtin_amdgcn_permlane32_swap(o, o, false, false); const unsigned o1 = so[0], o3 = so[1];
        rs[ai][0] = __builtin_bit_cast(float, e0); rs[ai][1] = __builtin_bit_cast(float, o1); rs[ai][2] = __builtin_bit_cast(float, e2); rs[ai][3] = __builtin_bit_cast(float, o3); }
    (void)lane;
}

struct EpiSwiGLU {
    static constexpr bool PERM = true, AFTER_DRAIN = false, MID = false;
    bf16_t* ACT; const float* ssp; int np; const float* bias;
    __device__ __forceinline__ void operator()(const f32x4 (&acc)[2][2][4][2], const Unit& u, int wr, int wc, int fr, int fq) const {
        const int lane = fr + 16 * fq, rl0 = u.pm * BM + wr * 64 + fr, mi = mod_index(u.pm);
        float rs[2][4];
        if (np == 1) row_rstd<1>(ssp, rl0, 1.f / DM, fq, lane, rs); else row_rstd<16>(ssp, rl0, 1.f / DM, fq, lane, rs);
        const float* bp = bias + (size_t)mi * FF2 + u.pn * BM + wc * 32 + 8 * fq;
        f32x4 bg[2], bu[2];
#pragma unroll
        for (int n = 0; n < 2; ++n) { bg[n] = *(const f32x4*)(bp + 4 * n); bu[n] = *(const f32x4*)(bp + HALF + 4 * n); }
#pragma unroll
        for (int ai = 0; ai < 2; ++ai) if (u.half != 2 - ai)
#pragma unroll
            for (int m = 0; m < 4; ++m) { const float r = rs[ai][m]; bf16_t* op = ACT + (unsigned)((rl0 + ai * HALF + m * 16) * FF + u.pn * HALF + wc * 32 + 8 * fq);
                f32x4 a[2];
#pragma unroll
                for (int n = 0; n < 2; ++n) { const f32x4 zg = acc[ai][0][m][n] * r + bg[n], zu = acc[ai][1][m][n] * r + bu[n];
#pragma unroll
                    for (int i = 0; i < 4; ++i) a[n][i] = silu_f(zg[i]) * zu[i]; }
                *(u32x4*)op = pack8(a[0], a[1]); }
    }
};

struct EpiResid {
    static constexpr bool PERM = true, AFTER_DRAIN = false, MID = false;
    const float* csb;
    const float* gate; const float* cs; int cs_stride; bf16_t* XS; float* ssp; int prow0;
    __device__ __forceinline__ void operator()(const f32x4 (&acc)[2][2][4][2], const Unit& u, int wr, int wc, int fr, int fq) const {
        const int gpm = prow0 + u.pm, mi = mod_index(gpm), grow0 = gpm * BM + wr * 64 + fr, c0 = u.pn * BM + wc * 32 + 8 * fq;
#pragma unroll
        for (int ai = 0; ai < 2; ++ai) if (u.half != 2 - ai) { float s[4] = {0.f, 0.f, 0.f, 0.f};
#pragma unroll
            for (int bj = 0; bj < 2; ++bj) {
                u32x4 w[4]; f32x4 gvb[2], cvb[2], ivb[2];
#pragma unroll
                for (int m = 0; m < 4; ++m) w[m] = *(const u32x4*)(XS + (unsigned)((grow0 + ai * HALF + m * 16) * DM + c0 + bj * HALF));
#pragma unroll
                for (int n = 0; n < 2; ++n) { gvb[n] = *(const f32x4*)(gate + mi * DM + c0 + bj * HALF + 4 * n); cvb[n] = *(const f32x4*)(cs + mi * cs_stride + c0 + bj * HALF + 4 * n);
                    ivb[n] = *(const f32x4*)(csb + mi * DM + c0 + bj * HALF + 4 * n);
#pragma unroll
                    for (int i = 0; i < 4; ++i) ivb[n][i] = ivb[n][i] == 0.f ? 0.f : __builtin_amdgcn_rcpf(ivb[n][i]); }
#pragma unroll
                for (int m = 0; m < 4; ++m) { const unsigned off = (unsigned)((grow0 + ai * HALF + m * 16) * DM + c0 + bj * HALF);
                    const f32x4 x0 = (f32x4){bf_lo(w[m][0]), bf_hi(w[m][0]), bf_lo(w[m][1]), bf_hi(w[m][1])} * ivb[0] + gvb[0] * acc[ai][bj][m][0];
                    const f32x4 x1 = (f32x4){bf_lo(w[m][2]), bf_hi(w[m][2]), bf_lo(w[m][3]), bf_hi(w[m][3])} * ivb[1] + gvb[1] * acc[ai][bj][m][1];
                    s[m] += dot4(x0) + dot4(x1);
                    *(u32x4*)(XS + off) = pack8(x0 * cvb[0], x1 * cvb[1]); }
                asm volatile("" ::: "memory");
            }
#pragma unroll
            for (int m = 0; m < 4; ++m) { float t = s[m]; t = add_xor16(t); t = add_xor32(t);
                if (fq == 0) ssp[(unsigned)((grow0 + ai * HALF + m * 16) * 16 + 4 * u.pn + wc)] = t; }
        }
    }
};

struct EpiWin {
    static constexpr bool PERM = true, AFTER_DRAIN = false, MID = false;
    const float* ssp2; const float* bias; bf16_t* OAB; bf16_t* QL_; bf16_t* CKV_; bf16_t* KR_; float* SSV_; float* SSQ_; float* SSC_; float* nckv; float* nkr; const float* rope; int chunk; long set2_bytes, ss2_bytes; int pn0;
    __device__ __forceinline__ void operator()(const f32x4 (&acc)[2][2][4][2], const Unit& u, int wr, int wc, int fr, int fq) const {
        const bool set2 = u.pm >= 32; const int pml = u.pm & 31;
        const int lane = fr + 16 * fq, rlo0 = u.pm * BM + wr * 64 + fr, rl0 = pml * BM + wr * 64 + fr, gpm = chunk * 32 + u.pm, mi = mod_index(gpm), pn = u.pn + pn0, c0 = wc * 32 + 8 * fq;
        const int kr0 = (chunk == 0 ? pml : 17 * (pml >> 4) + 1 + (pml & 15)) * BM + wr * 64 + fr;
        bf16_t* QL = (bf16_t*)((char*)QL_ + (set2 ? set2_bytes : 0)); bf16_t* CKV = (bf16_t*)((char*)CKV_ + (set2 ? set2_bytes : 0)); bf16_t* KR = (bf16_t*)((char*)KR_ + (set2 ? set2_bytes : 0));
        float* SSV = (float*)((char*)SSV_ + (set2 ? ss2_bytes : 0)); float* SSQ = (float*)((char*)SSQ_ + (set2 ? ss2_bytes : 0)); float* SSC = (float*)((char*)SSC_ + (set2 ? ss2_bytes : 0));
        float rs[2][4]; row_rstd<16>(ssp2, gpm * BM + wr * 64 + fr, 1.f / DM, fq, lane, rs);
        const float* bp = bias + (size_t)mi * NIN + pn * BM + c0;
        f32x4 bv[2][2];
#pragma unroll
        for (int bj = 0; bj < 2; ++bj)
#pragma unroll
            for (int n = 0; n < 2; ++n) bv[bj][n] = *(const f32x4*)(bp + bj * HALF + 4 * n);
        if (pn < 8) {
            bf16_t* dst = OAB + (pn < 4 ? pn * BM : DM + (pn - 4) * BM) + c0;
#pragma unroll
            for (int ai = 0; ai < 2; ++ai) if (u.half != 2 - ai)
#pragma unroll
                for (int m = 0; m < 4; ++m) { const int row = rl0 + ai * HALF + m * 16, rowo = rlo0 + ai * HALF + m * 16; const float r = rs[ai][m]; float s = 0.f;
#pragma unroll
                    for (int bj = 0; bj < 2; ++bj) { const f32x4 z0 = acc[ai][bj][m][0] * r + bv[bj][0], z1 = acc[ai][bj][m][1] * r + bv[bj][1]; s += dot4(z0) + dot4(z1);
                        *(u32x4*)(dst + (unsigned)(rowo * 2048 + bj * HALF)) = pack8(z0, z1); }
                    if (pn >= 4) { s = add_xor16(s); s = add_xor32(s); if (fq == 0) SSV[(size_t)row * 16 + 4 * (pn - 4) + wc] = s; } }
        } else if (pn == 8) {
#pragma unroll
            for (int ai = 0; ai < 2; ++ai) if (u.half != 2 - ai)
#pragma unroll
                for (int m = 0; m < 4; ++m) { const int row = rl0 + ai * HALF + m * 16; const float r = rs[ai][m]; float s = 0.f;
#pragma unroll
                    for (int bj = 0; bj < 2; ++bj) { const f32x4 z0 = acc[ai][bj][m][0] * r + bv[bj][0], z1 = acc[ai][bj][m][1] * r + bv[bj][1]; s += dot4(z0) + dot4(z1);
                        *(u32x4*)(QL + (size_t)row * 256 + bj * HALF + c0) = pack8(z0, z1); }
                    s = add_xor16(s); s = add_xor32(s); if (fq == 0) SSQ[(size_t)row * 4 + wc] = s; }
        } else if (pn == 9) {
#pragma unroll
            for (int ai = 0; ai < 2; ++ai) if (u.half != 2 - ai)
#pragma unroll
                for (int m = 0; m < 4; ++m) { const int row = rl0 + ai * HALF + m * 16, krow = kr0 + ai * HALF + m * 16; const float r = rs[ai][m]; float s = 0.f;
#pragma unroll
                    for (int bj = 0; bj < 2; ++bj) { const f32x4 z0 = acc[ai][bj][m][0] * r + bv[bj][0], z1 = acc[ai][bj][m][1] * r + bv[bj][1]; s += dot4(z0) + dot4(z1);
                        *(u32x4*)(CKV + (size_t)krow * 256 + bj * HALF + c0) = pack8(z0, z1);
                        if (chunk == 0) { *(f32x4*)(nckv + (size_t)row * 256 + bj * HALF + c0) = z0; *(f32x4*)(nckv + (size_t)row * 256 + bj * HALF + c0 + 4) = z1; } }
                    s = add_xor16(s); s = add_xor32(s); if (fq == 0) SSC[(size_t)krow * 4 + wc] = s; }
        } else if (wc < 2) {
#pragma unroll
            for (int ai = 0; ai < 2; ++ai) if (u.half != 2 - ai)
#pragma unroll
                for (int m = 0; m < 4; ++m) { const int row = rl0 + ai * HALF + m * 16, krow = kr0 + ai * HALF + m * 16; const float r = rs[ai][m];
                    const f32x4 z0 = acc[ai][0][m][0] * r + bv[0][0], z1 = acc[ai][0][m][1] * r + bv[0][1]; f32x4 o0 = z0, o1 = z1;
                    if (chunk == 0) { *(f32x4*)(nkr + (size_t)row * 64 + 32 * wc + 4 * fq) = z0; *(f32x4*)(nkr + (size_t)row * 64 + 32 * wc + 16 + 4 * fq) = z1; }
                    else { const int t = row & 4095, pos = wc == 0 ? (t >> 6) : (t & 63); const f32x4 cs_ = *(const f32x4*)(rope + pos * 16 + 4 * fq), sn_ = *(const f32x4*)(rope + 1024 + pos * 16 + 4 * fq);
                        o0 = z0 * cs_ - z1 * sn_; o1 = z1 * cs_ + z0 * sn_; }
                    *(u32x4*)(KR + (size_t)krow * 64 + 32 * wc + 8 * fq) = pack8(o0, o1); }
        }
    }
};

struct EpiQ {
    static constexpr bool PERM = true, AFTER_DRAIN = false, MID = false;
    bf16_t* Q; const float* SSQ; const float* rope; int chunk;
    __device__ __forceinline__ void operator()(const f32x4 (&acc)[2][2][4][2], const Unit& u, int wr, int wc, int fr, int fq) const {
        const int lane = fr + 16 * fq, rl0 = u.pm * BM + wr * 64 + fr;
        float rs[2][4]; row_rstd<4>(SSQ, rl0, 1.f / 256.f, fq, lane, rs);
#pragma unroll
        for (int ai = 0; ai < 2; ++ai) if (u.half != 2 - ai)
#pragma unroll
            for (int m = 0; m < 4; ++m) rs[ai][m] *= 0.10411754584f;
#pragma unroll
        for (int bj = 0; bj < 2; ++bj) { const int C32 = u.pn * BM + bj * HALF + wc * 32, w = C32 % 192; const bool rot = (w >= 128) && (chunk > 0); const bool colang = (w >= 160);
#pragma unroll
            for (int ai = 0; ai < 2; ++ai) if (u.half != 2 - ai)
#pragma unroll
                for (int m = 0; m < 4; ++m) { const int row = rl0 + ai * HALF + m * 16; const float r = rs[ai][m];
                    f32x4 z0 = acc[ai][bj][m][0] * r, z1 = acc[ai][bj][m][1] * r;
                    if (rot) { const int t = row & 4095, pos = colang ? (t & 63) : (t >> 6); const f32x4 cs_ = *(const f32x4*)(rope + pos * 16 + 4 * fq), sn_ = *(const f32x4*)(rope + 1024 + pos * 16 + 4 * fq);
                        const f32x4 o0 = z0 * cs_ - z1 * sn_, o1 = z1 * cs_ + z0 * sn_; z0 = o0; z1 = o1; }
                    *(u32x4*)(Q + (unsigned)(row * NQ + C32 + 8 * fq)) = pack8(z0, z1); } }
    }
};

struct EpiKV {
    static constexpr bool PERM = true, AFTER_DRAIN = false, MID = false;
    bf16_t* KN; bf16_t* V; const float* SSC; int chunk;
    __device__ __forceinline__ void operator()(const f32x4 (&acc)[2][2][4][2], const Unit& u, int wr, int wc, int fr, int fq) const {
        const int lane = fr + 16 * fq, rl0 = u.pm * BM + wr * 64 + fr, c0 = wc * 32 + 8 * fq;
        float rs[2][4]; row_rstd<4>(SSC, rl0, 1.f / 256.f, fq, lane, rs);
        const bool cache = (chunk > 0) && (u.pm % 17 == 0);
        bf16_t* dst = (u.pn < 4 ? KN + u.pn * BM : V + (u.pn - 4) * BM) + c0;
#pragma unroll
        for (int ai = 0; ai < 2; ++ai) if (u.half != 2 - ai)
#pragma unroll
            for (int m = 0; m < 4; ++m) { const int row = rl0 + ai * HALF + m * 16; const float r = cache ? 1.f : rs[ai][m];
#pragma unroll
                for (int bj = 0; bj < 2; ++bj) *(u32x4*)(dst + (unsigned)(row * DM + bj * HALF)) = pack8(acc[ai][bj][m][0] * r, acc[ai][bj][m][1] * r); }
    }
};

struct EpiGate {
    static constexpr bool PERM = true, AFTER_DRAIN = false, MID = false;
    const float* ssp2; const float* bias; bf16_t* G; int prow0;
    __device__ __forceinline__ void operator()(const f32x4 (&acc)[2][2][4][2], const Unit& u, int wr, int wc, int fr, int fq) const {
        const int lane = fr + 16 * fq, rl0 = u.pm * BM + wr * 64 + fr, gpm = prow0 + u.pm, mi = mod_index(gpm), c0 = u.pn * BM + wc * 32 + 8 * fq;
        float rs[2][4]; row_rstd<16>(ssp2, gpm * BM + wr * 64 + fr, 1.f / DM, fq, lane, rs);
        const float* bp = bias + (size_t)mi * NIN + 2816 + c0;
        f32x4 bv[2][2];
#pragma unroll
        for (int bj = 0; bj < 2; ++bj)
#pragma unroll
            for (int n = 0; n < 2; ++n) bv[bj][n] = *(const f32x4*)(bp + bj * HALF + 4 * n);
#pragma unroll
        for (int ai = 0; ai < 2; ++ai) if (u.half != 2 - ai)
#pragma unroll
            for (int m = 0; m < 4; ++m) { const int row = rl0 + ai * HALF + m * 16; const float r = rs[ai][m];
#pragma unroll
                for (int bj = 0; bj < 2; ++bj) { f32x4 z0 = acc[ai][bj][m][0] * r + bv[bj][0], z1 = acc[ai][bj][m][1] * r + bv[bj][1];
#pragma unroll
                    for (int i = 0; i < 4; ++i) { z0[i] = sigm_f(z0[i]); z1[i] = sigm_f(z1[i]); }
                    *(u32x4*)(G + (unsigned)(row * 2048 + bj * HALF + c0)) = pack8(z0, z1); } }
    }
};

struct EpiMerge {
    static constexpr bool PERM = true, AFTER_DRAIN = false, MID = true;
    bf16_t* G;
    __device__ __forceinline__ void mid(f32x4 (&acc)[2][2][4][2], const Unit& u, int wr, int wc, int fr, int fq) const {
        const int rl0 = u.pm * BM + wr * 64 + fr, c0 = u.pn * BM + wc * 32 + 8 * fq;
#pragma unroll
        for (int ai = 0; ai < 2; ++ai) if (u.half != 2 - ai)
#pragma unroll
            for (int mh = 0; mh < 2; ++mh) { u32x4 ga[2][2], gb[2][2];
#pragma unroll
                for (int m2 = 0; m2 < 2; ++m2) { const bf16_t* gp = G + (unsigned)((rl0 + ai * HALF + (2 * mh + m2) * 16) * 2048 + c0);
#pragma unroll
                    for (int bj = 0; bj < 2; ++bj) { ga[m2][bj] = *(const u32x4*)(gp + bj * HALF); gb[m2][bj] = *(const u32x4*)(gp + DM + bj * HALF); } }
#pragma unroll
                for (int m2 = 0; m2 < 2; ++m2)
#pragma unroll
                    for (int bj = 0; bj < 2; ++bj)
#pragma unroll
                        for (int k = 0; k < 4; ++k) { const int m = 2 * mh + m2;
                            const float r0 = bf_lo(ga[m2][bj][k]) * __builtin_amdgcn_rcpf(fmaxf(bf_lo(gb[m2][bj][k]), 1e-30f)), r1 = bf_hi(ga[m2][bj][k]) * __builtin_amdgcn_rcpf(fmaxf(bf_hi(gb[m2][bj][k]), 1e-30f));
                            acc[ai][bj][m][k >> 1][(k & 1) * 2] *= r0; acc[ai][bj][m][k >> 1][(k & 1) * 2 + 1] *= r1; }
                asm volatile("" ::: "memory"); }
    }
    __device__ __forceinline__ void operator()(const f32x4 (&acc)[2][2][4][2], const Unit& u, int wr, int wc, int fr, int fq) const {
        const int rl0 = u.pm * BM + wr * 64 + fr, c0 = u.pn * BM + wc * 32 + 8 * fq;
#pragma unroll
        for (int ai = 0; ai < 2; ++ai) if (u.half != 2 - ai) { u32x4 gb[4][2];
#pragma unroll
            for (int m = 0; m < 4; ++m)
#pragma unroll
                for (int bj = 0; bj < 2; ++bj) gb[m][bj] = *(const u32x4*)(G + (size_t)(rl0 + ai * HALF + m * 16) * 2048 + DM + c0 + bj * HALF);
#pragma unroll
            for (int m = 0; m < 4; ++m) { const size_t row = (size_t)(rl0 + ai * HALF + m * 16);
#pragma unroll
                for (int bj = 0; bj < 2; ++bj) { const u32x4 g = gb[m][bj];
                    const f32x4 g0 = {bf_lo(g[0]), bf_hi(g[0]), bf_lo(g[1]), bf_hi(g[1])}, g1 = {bf_lo(g[2]), bf_hi(g[2]), bf_lo(g[3]), bf_hi(g[3])};
                    *(u32x4*)(G + row * 2048 + c0 + bj * HALF) = pack8(acc[ai][bj][m][0] * g0, acc[ai][bj][m][1] * g1); } }
            asm volatile("" ::: "memory"); }
    }
};

template <class Epi, class Sched, bool ALIGN_EPI = false, bool SP2 = false>
__device__ __forceinline__ void gemm_phase(PG8_LAS unsigned char* lds, const Gemm g, const Sched& S, const Epi& E, const int wave_s) {
    int wid_ = wave_s; asm volatile("" : "+s"(wid_));
    const int lane = fresh_lane(), wid = wid_, tid = wid * 64 + lane, wr = wid >> 2, wc = wid & 3, fr = lane & 15, fq = lane >> 4;
    const int K = g.K, nt = K / BK, LDA = g.lda;
    unsigned voffA[2], voffB[2];
#pragma unroll
    for (int i = 0; i < 2; ++i) { int R, C; stage_rc(tid * 16 + i * 8192, R, C); const int Rb = Epi::PERM ? ((R & ~31) + perm32(R & 31)) : R;
        voffA[i] = (unsigned)(R * LDA + C) * 2u; voffB[i] = (unsigned)(Rb * K + C) * 2u; }
    const size_t kstep = (size_t)(BK * 2);
    const size_t hstepB = (size_t)HALF * K * 2, tstepB = 2 * hstepB;
    const size_t hstepA = (size_t)HALF * LDA * 2, tstepA = 2 * hstepA;
    const unsigned ldsw = (unsigned)wid * 1024u;
    const int aoff = lds_byte(wr * 64 + fr, fq * 8), boff = lds_byte(wc * 32 + fr, fq * 8);
#define PG8_SA(b, h) (((b) * 2 + (h)) * HTB)
#define PG8_SB(b, h) ((4 + (b) * 2 + (h)) * HTB)
#define PG8_STAGE(bufoff, gbase, voff) do { _Pragma("unroll") for (int _i = 0; _i < 2; ++_i) \
        __builtin_amdgcn_global_load_lds((const unsigned*)((const char*)(gbase) + (voff)[_i]), (PG8_LAS unsigned*)(lds + (bufoff) + ldsw + _i * 8192), 16, 0, 0); } while (0)
#define PG8_LDA(dst, b, h) do { _Pragma("unroll") for (int m = 0; m < 4; ++m) _Pragma("unroll") for (int k = 0; k < 2; ++k) dst[m][k] = *(const PG8_LAS bf16x8*)(lds + PG8_SA(b, h) + aoff + m * 2048 + k * 1024); } while (0)
#define PG8_LDB(dst, b, h) do { _Pragma("unroll") for (int n = 0; n < 2; ++n) _Pragma("unroll") for (int k = 0; k < 2; ++k) dst[n][k] = *(const PG8_LAS bf16x8*)(lds + PG8_SB(b, h) + boff + n * 2048 + k * 1024); } while (0)
#define PG8_MMA(ai, bj, At, Bt) do { __builtin_amdgcn_s_setprio(1); _Pragma("unroll") for (int m = 0; m < 4; ++m) _Pragma("unroll") for (int n = 0; n < 2; ++n) _Pragma("unroll") for (int k = 0; k < 2; ++k) \
        acc[ai][bj][m][n] = __builtin_amdgcn_mfma_f32_16x16x32_bf16(Bt[n][k], At[m][k], acc[ai][bj][m][n], 0, 0, 0); __builtin_amdgcn_s_setprio(0); } while (0)
#define PG8_WAIT_V(n) asm volatile("s_waitcnt vmcnt(" #n ")" ::: "memory")
#define PG8_WAIT_L(n) asm volatile("s_waitcnt lgkmcnt(" #n ")" ::: "memory")
#define PG8_BAR __builtin_amdgcn_s_barrier()
#define PG8_SCHED __builtin_amdgcn_sched_barrier(0)
    Unit cur, nxt; int ui = 0;
    if (!S.next(0, cur)) return;
    f32x4 acc[2][2][4][2];
#pragma unroll
    for (int a = 0; a < 2; ++a)
#pragma unroll
        for (int b = 0; b < 2; ++b)
#pragma unroll
            for (int m = 0; m < 4; ++m)
#pragma unroll
                for (int n = 0; n < 2; ++n) acc[a][b][m][n] = (f32x4){0.f, 0.f, 0.f, 0.f};
    bf16x8 At[4][2], B0[2][2], B1[2][2];
    const char* cA = (const char*)g.A + (size_t)cur.pm * tstepA; const char* cB = (const char*)g.Bt + (size_t)cur.pn * tstepB;
    S.a_ready(cur);
    if constexpr (SP2) {
        PG8_STAGE(PG8_SB(0, 0), cB, voffB); PG8_STAGE(PG8_SB(0, 1), cB + hstepB, voffB); PG8_STAGE(PG8_SA(0, 0), cA, voffA); PG8_STAGE(PG8_SA(0, 1), cA + hstepA, voffA);
        if (wr == 1) PG8_BAR;
        PG8_WAIT_V(2); PG8_BAR;
        PG8_STAGE(PG8_SB(1, 0), cB + kstep, voffB); PG8_STAGE(PG8_SA(1, 0), cA + kstep, voffA); PG8_STAGE(PG8_SB(1, 1), cB + hstepB + kstep, voffB);
        PG8_WAIT_V(6); PG8_BAR;
    } else {
        PG8_STAGE(PG8_SB(0, 0), cB, voffB); PG8_STAGE(PG8_SA(0, 0), cA, voffA); PG8_STAGE(PG8_SB(0, 1), cB + hstepB, voffB); PG8_STAGE(PG8_SA(0, 1), cA + hstepA, voffA);
        if (wr == 1) PG8_BAR;
        PG8_WAIT_V(4); PG8_BAR;
        PG8_STAGE(PG8_SB(1, 0), cB + kstep, voffB); PG8_STAGE(PG8_SA(1, 0), cA + kstep, voffA); PG8_STAGE(PG8_SB(1, 1), cB + hstepB + kstep, voffB);
        PG8_WAIT_V(6); PG8_BAR;
    }
    for (;;) {
        const bool has_next = S.next(ui + 1, nxt);
        const char* nA = has_next ? (const char*)g.A + (size_t)nxt.pm * tstepA : cA; const char* nB = has_next ? (const char*)g.Bt + (size_t)nxt.pn * tstepB : cB;
        const bool do0 = cur.half != 2, do1 = cur.half != 1;
#pragma unroll 1
        for (int t = 0; t < nt; t += 2) {
            if constexpr (Epi::MID) { if (__builtin_expect(t == (nt >> 1), 0)) { const int l2 = fresh_lane(); E.mid(acc, cur, wr, wc, l2 & 15, l2 >> 4); } }
            const bool last = (t == nt - 2);
            const char* a1 = cA + (size_t)(t + 1) * kstep;
            const char* a2 = last ? nA : cA + (size_t)(t + 2) * kstep; const char* b2 = last ? nB : cB + (size_t)(t + 2) * kstep;
            const char* a3 = a2 + kstep; const char* b3 = b2 + kstep;
            if (last && has_next) S.a_ready(nxt);
            if constexpr (SP2) {
            PG8_LDB(B0, 0, 0); PG8_LDB(B1, 0, 1); PG8_SCHED; if (do0) PG8_LDA(At, 0, 0); PG8_STAGE(PG8_SA(1, 1), a1 + hstepA, voffA);
            PG8_WAIT_V(8); PG8_WAIT_L(0); PG8_BAR; if (do0) { PG8_MMA(0, 0, At, B0); PG8_MMA(0, 1, At, B1); } PG8_BAR; PG8_SCHED;
            if (do1) PG8_LDA(At, 0, 1); PG8_STAGE(PG8_SB(0, 0), b2, voffB); PG8_STAGE(PG8_SB(0, 1), b2 + hstepB, voffB); PG8_STAGE(PG8_SA(0, 0), a2, voffA);
            PG8_WAIT_V(8); PG8_WAIT_L(0); PG8_BAR; if (do1) { PG8_MMA(1, 0, At, B0); PG8_MMA(1, 1, At, B1); } PG8_BAR; PG8_SCHED;
            PG8_LDB(B0, 1, 0); PG8_LDB(B1, 1, 1); PG8_SCHED; if (do0) PG8_LDA(At, 1, 0); PG8_STAGE(PG8_SA(0, 1), a2 + hstepA, voffA);
            PG8_WAIT_V(8); PG8_WAIT_L(0); PG8_BAR; if (do0) { PG8_MMA(0, 0, At, B0); PG8_MMA(0, 1, At, B1); } PG8_BAR; PG8_SCHED;
            if (do1) PG8_LDA(At, 1, 1); PG8_STAGE(PG8_SB(1, 0), b3, voffB); PG8_STAGE(PG8_SB(1, 1), b3 + hstepB, voffB); PG8_STAGE(PG8_SA(1, 0), a3, voffA);
            PG8_WAIT_V(8); PG8_WAIT_L(0); PG8_BAR; if (do1) { PG8_MMA(1, 0, At, B0); PG8_MMA(1, 1, At, B1); } PG8_BAR; PG8_SCHED;
            } else {
            PG8_LDB(B0, 0, 0); PG8_SCHED; PG8_LDA(At, 0, 0); PG8_STAGE(PG8_SA(1, 1), a1 + hstepA, voffA);
            PG8_WAIT_L(8); PG8_BAR; PG8_WAIT_L(0); PG8_MMA(0, 0, At, B0); PG8_BAR; PG8_SCHED;
            PG8_LDB(B1, 0, 1); PG8_STAGE(PG8_SB(0, 0), b2, voffB);
            PG8_BAR; PG8_WAIT_L(0); PG8_MMA(0, 1, At, B1); PG8_BAR;
            PG8_LDA(At, 0, 1); PG8_STAGE(PG8_SA(0, 0), a2, voffA);
            PG8_BAR; PG8_WAIT_L(0); PG8_MMA(1, 0, At, B0); PG8_BAR; PG8_SCHED;
            PG8_STAGE(PG8_SB(0, 1), b2 + hstepB, voffB);
            PG8_WAIT_V(6); PG8_BAR; PG8_MMA(1, 1, At, B1); PG8_BAR;
            PG8_LDB(B0, 1, 0); PG8_SCHED; PG8_LDA(At, 1, 0); PG8_STAGE(PG8_SA(0, 1), a2 + hstepA, voffA);
            PG8_WAIT_L(8); PG8_BAR; PG8_WAIT_L(0); PG8_MMA(0, 0, At, B0); PG8_BAR; PG8_SCHED;
            PG8_LDB(B1, 1, 1); PG8_STAGE(PG8_SB(1, 0), b3, voffB);
            PG8_BAR; PG8_WAIT_L(0); PG8_MMA(0, 1, At, B1); PG8_BAR;
            PG8_LDA(At, 1, 1); PG8_STAGE(PG8_SA(1, 0), a3, voffA);
            PG8_BAR; PG8_WAIT_L(0); PG8_MMA(1, 0, At, B0); PG8_BAR; PG8_SCHED;
            PG8_STAGE(PG8_SB(1, 1), b3 + hstepB, voffB);
            PG8_WAIT_V(6); PG8_BAR; PG8_MMA(1, 1, At, B1); PG8_BAR;
            }
        }
        if constexpr (ALIGN_EPI) { if (wr == 0) PG8_BAR; }
        if constexpr (!Epi::AFTER_DRAIN) { const int l2 = fresh_lane(); E(acc, cur, wr, wc, l2 & 15, l2 >> 4); S.done(cur); }
        if (!has_next) break;
#pragma unroll
        for (int a = 0; a < 2; ++a)
#pragma unroll
            for (int b = 0; b < 2; ++b)
#pragma unroll
                for (int m = 0; m < 4; ++m)
#pragma unroll
                    for (int n = 0; n < 2; ++n) acc[a][b][m][n] = (f32x4){0.f, 0.f, 0.f, 0.f};
        cur = nxt; cA = nA; cB = nB; ++ui;
        if constexpr (ALIGN_EPI) { if (wr == 1) PG8_BAR; }
    }
    PG8_WAIT_V(0);
    if constexpr (!ALIGN_EPI) { if (wr == 0) PG8_BAR; }
    PG8_BAR;
    if constexpr (Epi::AFTER_DRAIN) { E.fused(acc, cur, wr, wc, fr, fq, lds, wid, lane); S.done(cur); }
#undef PG8_SA
#undef PG8_SB
#undef PG8_STAGE
#undef PG8_LDA
#undef PG8_LDB
#undef PG8_MMA
#undef PG8_WAIT_V
#undef PG8_WAIT_L
#undef PG8_BAR
#undef PG8_SCHED
}
}
namespace att {
typedef unsigned short bf16_t;
using bf16x8 = __attribute__((ext_vector_type(8))) short;
using s16x4  = __attribute__((ext_vector_type(4))) short;
using f32x16 = __attribute__((ext_vector_type(16))) float;
using u32x4  = __attribute__((ext_vector_type(4))) unsigned;
constexpr int NW = 8, QBLK = 32, KVBLK = 64;
constexpr int LDQ = 1536, LDKN = 1024, LDKR = 64, LDV = 1024, LDO = 2048;
constexpr float SCALE = 0.072168783648703220f;
constexpr float THR = 8.f;
constexpr int SHM_V = KVBLK * 128 * 2, SHM_KN = KVBLK * 128 * 2, SHM_KR = KVBLK * 64 * 2;
constexpr int STG = SHM_V + SHM_KN + SHM_KR, OFF_V = 0, OFF_KN = SHM_V, OFF_KR = SHM_V + SHM_KN, OFF_WS = 3 * STG, SHM_ATTN = OFF_WS + NW * 64 * 4;
typedef __attribute__((address_space(3))) unsigned lds_u32;
#define KSWZ(row, colB) ((row) * 256 + ((colB) ^ (((row) & 15) << 4)))
#define KRSWZ(row, colB) ((row) * 128 + ((colB) ^ ((((row) >> 1) & 7) << 4)))
#define SBAR() __builtin_amdgcn_sched_barrier(0)
__device__ __forceinline__ int crow(int r, int hi) { return (r & 3) + 8 * (r >> 2) + 4 * hi; }
typedef float f32x2a_t __attribute__((ext_vector_type(2))); typedef __bf16 bf16x2a_t __attribute__((ext_vector_type(2)));
__device__ __forceinline__ unsigned cvtpk(float lo, float hi) { f32x2a_t v = {lo, hi}; bf16x2a_t b = __builtin_convertvector(v, bf16x2a_t); return __builtin_bit_cast(unsigned, b); }

constexpr float THRL = THR * 1.4426950408889634f;
#define MX3(a, b, c) fmaxf(fmaxf((a), (b)), (c))
__device__ __forceinline__ void partialSM(f32x16& p0, f32x16& p1, float& m_reg, float& alpha) {
  float a = MX3(p0[0], p0[1], p1[0]), b = MX3(p0[2], p0[3], p1[1]); a = MX3(a, p1[2], p1[3]);
#pragma unroll
  for (int r = 4; r < 16; r += 4) { a = MX3(a, p0[r], p0[r + 1]); b = MX3(b, p0[r + 2], p0[r + 3]); a = MX3(a, p1[r], p1[r + 1]); b = MX3(b, p1[r + 2], p1[r + 3]); }
  float pmax = fmaxf(a, b);
  { auto rr = __builtin_amdgcn_permlane32_swap(__float_as_uint(pmax), __float_as_uint(pmax), false, false);
    pmax = fmaxf(__uint_as_float(rr[0]), __uint_as_float(rr[1])); }
  if (__builtin_expect(__all(pmax <= THRL), 1)) { alpha = 1.f; }
  else { const float d = fmaxf(pmax, 0.f); for (int r = 0; r < 16; ++r) { p0[r] -= d; p1[r] -= d; } m_reg += d; alpha = __builtin_amdgcn_exp2f(-d); }
  for (int r = 0; r < 16; ++r) p0[r] = __builtin_amdgcn_exp2f(p0[r]);
}
#undef MX3
__device__ __forceinline__ void finishSM(f32x16& p0, f32x16& p1, float alpha, float& l_reg, bf16x8& pa0, bf16x8& pa1, bf16x8& pa2, bf16x8& pa3) {
  for (int r = 0; r < 16; ++r) p1[r] = __builtin_amdgcn_exp2f(p1[r]);
  float ps = 0; for (int r = 0; r < 16; ++r) ps += p0[r]; for (int r = 0; r < 16; ++r) ps += p1[r];
  { auto rr = __builtin_amdgcn_permlane32_swap(__float_as_uint(ps), __float_as_uint(ps), false, false);
    ps = __uint_as_float(rr[0]) + __uint_as_float(rr[1]); }
  l_reg = l_reg * alpha + ps;
#define PK4(P, BASE, OUT) do { unsigned a0 = cvtpk(P[BASE + 0], P[BASE + 1]), a1 = cvtpk(P[BASE + 2], P[BASE + 3]);   \
    unsigned b0 = cvtpk(P[BASE + 4], P[BASE + 5]), b1 = cvtpk(P[BASE + 6], P[BASE + 7]);                              \
    auto r0 = __builtin_amdgcn_permlane32_swap(a0, b0, false, false); auto r1 = __builtin_amdgcn_permlane32_swap(a1, b1, false, false); \
    u32x4 w = {r0[0], r1[0], r0[1], r1[1]}; OUT = *reinterpret_cast<bf16x8*>(&w); } while (0)
  PK4(p0, 0, pa0); PK4(p0, 8, pa1); PK4(p1, 0, pa2); PK4(p1, 8, pa3);
#undef PK4
}
__device__ __forceinline__ void qkt(f32x16& p0, f32x16& p1, const char* KNs, const char* KRs, const bf16x8* qr, int r32, int hi, float negm) {
#pragma unroll
  for (int r = 0; r < 16; ++r) { p0[r] = negm; p1[r] = negm; }
#pragma unroll
  for (int d0 = 0; d0 < 8; ++d0) { int cb = (d0 * 16 + hi * 8) * 2;
    bf16x8 b0 = *reinterpret_cast<const bf16x8*>(KNs + KSWZ(r32, cb));
    bf16x8 b1 = *reinterpret_cast<const bf16x8*>(KNs + KSWZ(32 + r32, cb));
    p0 = __builtin_amdgcn_mfma_f32_32x32x16_bf16(b0, qr[d0], p0, 0, 0, 0);
    p1 = __builtin_amdgcn_mfma_f32_32x32x16_bf16(b1, qr[d0], p1, 0, 0, 0); }
#pragma unroll
  for (int d0 = 0; d0 < 4; ++d0) { int cb = (d0 * 16 + hi * 8) * 2;
    bf16x8 b0 = *reinterpret_cast<const bf16x8*>(KRs + KRSWZ(r32, cb));
    bf16x8 b1 = *reinterpret_cast<const bf16x8*>(KRs + KRSWZ(32 + r32, cb));
    p0 = __builtin_amdgcn_mfma_f32_32x32x16_bf16(b0, qr[8 + d0], p0, 0, 0, 0);
    p1 = __builtin_amdgcn_mfma_f32_32x32x16_bf16(b1, qr[8 + d0], p1, 0, 0, 0); }
}
__device__ __forceinline__ int v_st(int k, int c) { const int kk = (k & ~0xC) | ((k & 4) << 1) | ((k & 8) >> 1); return ((kk >> 3) * 4 + (c >> 5)) * 512 + ((kk & 7) * 32 + (c & 31)) * 2; }
__device__ __forceinline__ int v_rd_base(int lane) { return ((lane & 3) << 3) | (((lane >> 2) & 3) << 6) | (((lane >> 4) & 1) << 5) | (((lane >> 5) & 1) << 8); }
constexpr int v_rd_off(int d0, int ks, int half) { return d0 * 512 + ks * 4096 + half * 2048; }
template <int OFF> __device__ __forceinline__ s16x4 tr_read(int vb) {
  s16x4 r; asm volatile("ds_read_b64_tr_b16 %0, %1 offset:%2" : "=&v"(r) : "v"(vb), "i"(OFF) : "memory"); return r;
}
template <int D0> __device__ __forceinline__ void pv_one(f32x16& od, int vb, bf16x8 pa0, bf16x8 pa1, bf16x8 pa2, bf16x8 pa3) {
  const s16x4 l0 = tr_read<v_rd_off(D0, 0, 0)>(vb), h0 = tr_read<v_rd_off(D0, 0, 1)>(vb), l1 = tr_read<v_rd_off(D0, 1, 0)>(vb), h1 = tr_read<v_rd_off(D0, 1, 1)>(vb);
  const s16x4 l2 = tr_read<v_rd_off(D0, 2, 0)>(vb), h2 = tr_read<v_rd_off(D0, 2, 1)>(vb), l3 = tr_read<v_rd_off(D0, 3, 0)>(vb), h3 = tr_read<v_rd_off(D0, 3, 1)>(vb);
  asm volatile("s_waitcnt lgkmcnt(0)" ::: "memory"); SBAR();
#define PK(L, H) (bf16x8){L[0], L[1], L[2], L[3], H[0], H[1], H[2], H[3]}
  od = __builtin_amdgcn_mfma_f32_32x32x16_bf16(pa0, PK(l0, h0), od, 0, 0, 0);
  od = __builtin_amdgcn_mfma_f32_32x32x16_bf16(pa1, PK(l1, h1), od, 0, 0, 0);
  od = __builtin_amdgcn_mfma_f32_32x32x16_bf16(pa2, PK(l2, h2), od, 0, 0, 0);
  od = __builtin_amdgcn_mfma_f32_32x32x16_bf16(pa3, PK(l3, h3), od, 0, 0, 0);
#undef PK
}
__device__ __forceinline__ void pv_d0(f32x16* o, int vb, bf16x8 pa0, bf16x8 pa1, bf16x8 pa2, bf16x8 pa3) {
  pv_one<0>(o[0], vb, pa0, pa1, pa2, pa3); pv_one<1>(o[1], vb, pa0, pa1, pa2, pa3); pv_one<2>(o[2], vb, pa0, pa1, pa2, pa3); pv_one<3>(o[3], vb, pa0, pa1, pa2, pa3);
}
__device__ __forceinline__ unsigned short f2bf(float f) { unsigned u = __builtin_bit_cast(unsigned, f); return (unsigned short)((u + 0x7fffu + ((u >> 16) & 1u)) >> 16); }

__device__ __forceinline__ void attn_unit(const bf16_t* __restrict__ Qb, const bf16_t* __restrict__ KNh, const bf16_t* __restrict__ KRb, const bf16_t* __restrict__ Vh,
                                          bf16_t* __restrict__ Ob, int seq, char* lds, const int wave_s) {
  int wid_ = wave_s; asm volatile("" : "+s"(wid_));
  const int lane = fresh_lane(), wid = wid_, tid = wid * 64 + lane, r32 = lane & 31, hi = lane >> 5;
  float* ws = (float*)(lds + OFF_WS) + wid * 64; float* li_l = ws; float* al_l = ws + 32;
  float m_reg = 0.f, l_reg = 0; f32x16 o[4] = {}; bf16x8 qr[12];
  const bf16_t* Qw = Qb + (long)(wid * QBLK + r32) * LDQ + hi * 8;
#pragma unroll
  for (int d0 = 0; d0 < 12; ++d0) qr[d0] = *reinterpret_cast<const bf16x8*>(Qw + d0 * 16);
  unsigned voV, voK, voR;
  { const int sub = tid >> 5, within = tid & 31, kk = (sub >> 2) * 8 + (within >> 2), c = (sub & 3) * 32 + (within & 3) * 8, k = (kk & ~0xC) | ((kk & 4) << 1) | ((kk & 8) >> 1);
    voV = (unsigned)(k * LDV + c) * 2u;
    const int row = tid >> 4, slot = tid & 15; voK = (unsigned)(row * LDKN * 2 + ((slot << 4) ^ ((row & 15) << 4)));
    const int rr = tid >> 3, sl = tid & 7; voR = (unsigned)(rr * LDKR * 2 + ((sl << 4) ^ (((rr >> 1) & 7) << 4))); }
  const lds_u32* ldsL_ = (const lds_u32*)(lds); (void)ldsL_;
  const int vb0 = (int)(uintptr_t)lds + OFF_V + v_rd_base(lane);
  const int ldsw = wid * 1024;
#define DMA1(src, dstoff) __builtin_amdgcn_global_load_lds((const unsigned*)(src), (lds_u32*)(lds + (dstoff)), 16, 0, 0)
#define ISSUE(st, k0) do { const char* vb_ = (const char*)Vh + (size_t)(k0) * (LDV * 2); const char* kb_ = (const char*)KNh + (size_t)(k0) * (LDKN * 2); const char* rb_ = (const char*)KRb + (size_t)(k0) * (LDKR * 2); \
    DMA1(kb_ + voK, (st) + OFF_KN + ldsw); DMA1(kb_ + 32 * LDKN * 2 + voK, (st) + OFF_KN + 8192 + ldsw); DMA1(rb_ + voR, (st) + OFF_KR + ldsw); \
    DMA1(vb_ + voV, (st) + OFF_V + ldsw); DMA1(vb_ + 32 * LDV * 2 + voV, (st) + OFF_V + 8192 + ldsw); } while (0)
#define TOP() do { asm volatile("s_waitcnt vmcnt(0) lgkmcnt(0)" ::: "memory"); __builtin_amdgcn_s_barrier(); SBAR(); } while (0)
#define RESC(a) do { if (__any((a) < 1.f)) { if (hi == 0) al_l[r32] = (a); asm volatile("s_waitcnt lgkmcnt(0)" ::: "memory"); \
    for (int d = 0; d < 4; ++d) for (int r = 0; r < 16; ++r) o[d][r] *= al_l[crow(r, hi)]; } } while (0)
#define ROT() do { sV = sK; sK = sN; sN = (sN == 2 * STG) ? 0 : sN + STG; } while (0)
  f32x16 pA0, pA1, pB0, pB1; float alA, alB; bf16x8 pa0, pa1, pa2, pa3; const int NT = seq / KVBLK;
  ISSUE(0, 0); ISSUE(STG, KVBLK);
  asm volatile("s_waitcnt vmcnt(5)" ::: "memory"); __builtin_amdgcn_s_barrier(); SBAR();
  qkt(pA0, pA1, lds + OFF_KN, lds + OFF_KR, qr, r32, hi, -m_reg); partialSM(pA0, pA1, m_reg, alA);
  int sV = 0, sK = STG, sN = 2 * STG;
  for (int j = 1; j + 1 < NT; j += 2) {
    TOP(); ISSUE(sN, (j + 1) * KVBLK); SBAR();
    qkt(pB0, pB1, lds + sK + OFF_KN, lds + sK + OFF_KR, qr, r32, hi, -m_reg);
    finishSM(pA0, pA1, alA, l_reg, pa0, pa1, pa2, pa3); SBAR();
    pv_d0(o, vb0 + sV, pa0, pa1, pa2, pa3); partialSM(pB0, pB1, m_reg, alB);
    RESC(alB); ROT();
    TOP(); if (j + 2 < NT) ISSUE(sN, (j + 2) * KVBLK); SBAR();
    qkt(pA0, pA1, lds + sK + OFF_KN, lds + sK + OFF_KR, qr, r32, hi, -m_reg);
    finishSM(pB0, pB1, alB, l_reg, pa0, pa1, pa2, pa3); SBAR();
    pv_d0(o, vb0 + sV, pa0, pa1, pa2, pa3); partialSM(pA0, pA1, m_reg, alA);
    RESC(alA); ROT();
  }
  TOP();
  qkt(pB0, pB1, lds + sK + OFF_KN, lds + sK + OFF_KR, qr, r32, hi, -m_reg);
  finishSM(pA0, pA1, alA, l_reg, pa0, pa1, pa2, pa3); SBAR();
  pv_d0(o, vb0 + sV, pa0, pa1, pa2, pa3); partialSM(pB0, pB1, m_reg, alB);
  RESC(alB);
  finishSM(pB0, pB1, alB, l_reg, pa0, pa1, pa2, pa3); SBAR();
  pv_d0(o, vb0 + sK, pa0, pa1, pa2, pa3);
  if (hi == 0) li_l[r32] = l_reg; asm volatile("s_waitcnt lgkmcnt(0)" ::: "memory");
  const int lane2 = fresh_lane(), r32e = lane2 & 31, hie = lane2 >> 5;
  float rli[16];
#pragma unroll
  for (int r = 0; r < 16; ++r) rli[r] = __builtin_amdgcn_rcpf(li_l[crow(r, hie)]);
  __syncthreads();
  bf16_t* stg = (bf16_t*)lds + wid * 4096;
#pragma unroll
  for (int r = 0; r < 16; ++r) { const int orow = crow(r, hie);
#pragma unroll
    for (int d0 = 0; d0 < 4; ++d0) stg[orow * 128 + d0 * 32 + r32e] = f2bf(o[d0][r] * rli[r]); }
  asm volatile("s_waitcnt lgkmcnt(0)" ::: "memory");
#pragma unroll
  for (int i = 0; i < 8; ++i) { const int row = i * 4 + (lane2 >> 4), ch = lane2 & 15; const u32x4 v = *(const u32x4*)(stg + row * 128 + ch * 8);
    *(u32x4*)(Ob + (long)(wid * QBLK + row) * LDO + ch * 8) = v; }
  __syncthreads();
#undef DMA1
#undef ISSUE
#undef TOP
#undef RESC
#undef ROT
}
#undef KSWZ
#undef KRSWZ
#undef SBAR
}

constexpr int NWAVES = 8;
constexpr size_t MiB = 1u << 20;
constexpr size_t WS_CTL = 0;
constexpr size_t WS_MODS  = 1 * MiB;
constexpr size_t WS_TAB   = WS_MODS + 256 * 1024;
constexpr size_t WS_BIAS1 = WS_TAB + 128 * 1024;
constexpr size_t WS_BIAS2 = WS_BIAS1 + 128 * 1024;
constexpr size_t WS_BIAS3 = WS_BIAS2 + 128 * 1024;
constexpr size_t WS_ROPE  = WS_BIAS3 + 128 * 1024;
constexpr size_t WS_SS1   = WS_ROPE + 64 * 1024;
constexpr size_t WS_SSP2  = 2 * MiB;
constexpr size_t WS_SSP3  = WS_SSP2 + (size_t)T_ALL * 64;
constexpr size_t WS_SSPF  = WS_SSP3 + (size_t)T_ALL * 64;
constexpr size_t WS_SSV   = WS_SSPF + (size_t)T_ALL * 64;
constexpr size_t WS_SSQ   = WS_SSV + (size_t)TC * 64;
constexpr size_t WS_SSC   = WS_SSQ + (size_t)TC * 16;
static_assert(WS_SS1 + (size_t)T_ALL * 4 <= WS_SSP2 && WS_SSC + (size_t)KEYROWS * 16 <= 8 * MiB, "small tables");
constexpr size_t WS_W     = 8 * MiB;
constexpr size_t W_1IN = 0, W_1OUT = W_1IN + (size_t)FF2 * DM * 2, W_IN = W_1OUT + (size_t)DM * FF * 2, W_Q = W_IN + (size_t)NIN * DM * 2, W_KV = W_Q + (size_t)NQ * 256 * 2,
                 W_AB = W_KV + (size_t)NKV * 256 * 2, W_O = W_AB + (size_t)DM * 2048 * 2, W_2IN = W_O + (size_t)DM * DM * 2, W_2OUT = W_2IN + (size_t)FF2 * DM * 2, W_S = W_2OUT + (size_t)DM * FF * 2,
                 W_END = W_S + (size_t)8 * 128 * 128 * 2;
constexpr size_t WS_XS    = 59 * MiB;
static_assert(WS_W + W_END <= WS_XS, "weights");
constexpr size_t WS_BIG   = 107 * MiB;
constexpr size_t B_OAB = 0  , B_OAB2 = 32 * MiB  , B_G = 64 * MiB  , B_Q = 64 * MiB, B_KN = 88 * MiB, B_V = 105 * MiB, B_QL = 122 * MiB, B_CKV = 126 * MiB, B_KR = B_CKV + (size_t)KEYROWS * 256 * 2;
constexpr size_t B_QL0 = 32 * MiB, B_CKV0 = 36 * MiB, B_KR0 = 143 * MiB;
constexpr size_t B_SET2 = 10 * MiB;
constexpr size_t B_SS2 = 142 * MiB;
constexpr size_t WS_END = WS_BIG + 144 * MiB;
static_assert(B_KR + B_SET2 + (size_t)KEYROWS * 64 * 2 <= B_SS2 && WS_END <= 256 * MiB && B_KR + (size_t)KEYROWS * 64 * 2 <= 132 * MiB && B_KN + (size_t)KEYROWS * DM * 2 <= B_V && B_V + (size_t)KEYROWS * DM * 2 <= B_QL && (size_t)T_ALL * FF * 2 <= 132 * MiB, "mixer map");
constexpr int RING_BYTES = 131072, LDSCTL_OFF = 146432  , MISC_OFF = LDSCTL_OFF + 320, LDS_BYTES = 147456;
static_assert(att::SHM_ATTN <= RING_BYTES, "attention scratch");

#define GAS __attribute__((address_space(1)))
#define LAS __attribute__((address_space(3)))
typedef unsigned short bf16;
typedef unsigned v4u __attribute__((ext_vector_type(4)));
typedef unsigned v2u __attribute__((ext_vector_type(2)));
typedef float f32x4 __attribute__((ext_vector_type(4)));
typedef short bf16x8 __attribute__((ext_vector_type(8)));
typedef float f32x16 __attribute__((ext_vector_type(16)));
#define LDS_WAIT() asm volatile("s_waitcnt lgkmcnt(0)" ::: "memory")
#define VM_WAIT() asm volatile("s_waitcnt vmcnt(0)" ::: "memory")
__device__ __forceinline__ unsigned f2bf(float f) { unsigned u = __builtin_bit_cast(unsigned, f); return (u + 0x7fffu + ((u >> 16) & 1u)) >> 16; }
__device__ __forceinline__ unsigned pk2(float lo, float hi) { return f2bf(lo) | (f2bf(hi) << 16); }
__device__ __forceinline__ float bflo(unsigned w) { return __builtin_bit_cast(float, w << 16); }
__device__ __forceinline__ float bfhi(unsigned w) { return __builtin_bit_cast(float, w & 0xffff0000u); }

#define XB_TMO      128
#define XB_XCNT(j)  (256  + 64 * (j))
#define XB_XSUB(j)  (1280 + 64 * (j))
#define XB_XGEN(j)  (2304 + 64 * (j))
#define XB_TOP      3328
#define XB_TOPGEN   3392
#define XCD_BAR_WORDS 3456
#define XB_SPIN_CAP (1u << 21)
__device__ unsigned mk_bar_words[XCD_BAR_WORDS];
__device__ __forceinline__ unsigned xb_ld(unsigned* p)              { return __hip_atomic_load(p, __ATOMIC_RELAXED, __HIP_MEMORY_SCOPE_AGENT); }
__device__ __forceinline__ unsigned xb_add(unsigned* p, unsigned v) { return __hip_atomic_fetch_add(p, v, __ATOMIC_RELAXED, __HIP_MEMORY_SCOPE_AGENT); }
__device__ __forceinline__ unsigned xb_xcc_id() { return (unsigned)__builtin_amdgcn_s_getreg((3 << 11) | 20) & 0xFu; }
#define XB_SPIN(cond, bar) do { unsigned _sp = 0; while (cond) { __builtin_amdgcn_s_sleep(1); \
    if ((++_sp & 255u) == 0u) { if (xb_ld(&(bar)[XB_TMO])) break; if (_sp > XB_SPIN_CAP) { atomicAdd(&(bar)[XB_TMO], 1u); break; } } } } while (0)
struct XcdBarrier { unsigned* bar; unsigned x; volatile LAS unsigned* st; };
__device__ __forceinline__ XcdBarrier xcd_barrier_post(unsigned* bar, volatile LAS unsigned* st) {
    XcdBarrier b; b.bar = bar; b.x = xb_xcc_id(); b.st = st;
    if (threadIdx.x == 0) { (void)xb_add(&bar[XB_XCNT(b.x)], 1u); st[0] = 0u; st[1] = 0u; st[2] = xb_ld(&bar[XB_XGEN(b.x)]); st[3] = xb_ld(&bar[XB_TOPGEN]); }
    return b;
}
__device__ __forceinline__ void xcd_barrier_complete(unsigned* bar, unsigned x, unsigned& nloc, unsigned& nx) {
    const unsigned G = gridDim.x * gridDim.y * gridDim.z;
    unsigned sum, cnt, mine, sp = 0u;
    for (;;) {
        sum = 0u; cnt = 0u; mine = 0u;
#pragma unroll
        for (unsigned j = 0; j < 16; ++j) { const unsigned c = xb_ld(&bar[XB_XCNT(j)]); sum += c; cnt += (c > 0u) ? 1u : 0u; mine = (j == x) ? c : mine; }
        if (sum == G) break;
        __builtin_amdgcn_s_sleep(1);
        if ((++sp & 255u) == 0u) { if (xb_ld(&bar[XB_TMO])) break; if (sp > XB_SPIN_CAP) { atomicAdd(&bar[XB_TMO], 1u); break; } }
    }
    nloc = mine > 0u ? mine : 1u; nx = cnt > 0u ? cnt : 1u;
}
__device__ __forceinline__ void xcd_barrier(const XcdBarrier& b, const int wave_s) {
    asm volatile("s_waitcnt vmcnt(0)" ::: "memory");
    __syncthreads();
    if (wave_s == 0 && fresh_lane() == 0) {
        unsigned* bar = b.bar; unsigned bx_ = b.x; asm volatile("" : "+s"(bar), "+s"(bx_));
        __builtin_amdgcn_s_waitcnt(0);
        unsigned nloc = b.st[0], nx = b.st[1]; const unsigned gx = b.st[2], gt = b.st[3]; bool first = false;
        if (nloc == 0u) { xcd_barrier_complete(bar, bx_, nloc, nx); b.st[0] = nloc; b.st[1] = nx; first = true; }
        b.st[2] = gx + 1u; b.st[3] = gt + 1u;
        const unsigned old = xb_add(&bar[XB_XSUB(bx_)], 1u);
        if (old + 1u == nloc) {
            (void)xb_add(&bar[XB_XSUB(bx_)], 0u - nloc);
            __builtin_amdgcn_fence(__ATOMIC_RELEASE, "agent");
            asm volatile("s_waitcnt vmcnt(0)" ::: "memory");
            const unsigned og = xb_add(&bar[XB_TOP], 1u);
            if (og + 1u == nx) { (void)xb_add(&bar[XB_TOPGEN], 1u); (void)xb_add(&bar[XB_TOP], 0u - nx); }
            else XB_SPIN(xb_ld(&bar[XB_TOPGEN]) == gt, bar);
            (void)xb_add(&bar[XB_XGEN(bx_)], 1u);
            if (first) (void)xb_add(&bar[XB_XCNT(bx_)], 0u - nloc);
            __builtin_amdgcn_fence(__ATOMIC_ACQUIRE, "agent");
            asm volatile("s_waitcnt vmcnt(0)" ::: "memory");
        } else {
            XB_SPIN(xb_ld(&bar[XB_XGEN(bx_)]) == gx, bar);
            __builtin_amdgcn_fence(__ATOMIC_ACQUIRE, "agent");
            asm volatile("s_waitcnt vmcnt(0)" ::: "memory");
        }
    }
    __syncthreads();
}

enum { MAP_PLAIN = 0, MAP_FFNIN = 1, MAP_WIN = 2, MAP_WQ = 3, MAP_WKV = 4 };
__device__ __forceinline__ int dst_row(int mode, int n) {
    if (mode == MAP_FFNIN) { const bool isu = n >= FF; const int j = isu ? n - FF : n; return 256 * (j >> 7) + (isu ? 128 : 0) + (j & 127); }
    if (mode == MAP_WIN) { if (n < 2560) return n; if (n < 2624) { const int d = n - 2560; return 2560 + (d & 32) + pg8::perm32(d & 31); } return 2816 + (n - 2624); }
    if (mode == MAP_WQ) { const int h = n / 192, d = n % 192; if (d < 128) return n; const int dd = d - 128; return h * 192 + 128 + (dd & 32) + pg8::perm32(dd & 31); }
    if (mode == MAP_WKV) { const int h = n >> 8, d = n & 255; return d < 128 ? h * 128 + d : 1024 + h * 128 + (d - 128); }
    return n;
}
__device__ __forceinline__ void tr_item(const float* W, int N, bf16* WT, int ldk, int kofs, int mode, const float* kscale, int item, LAS float* scr, int lane) {
    const int nblk = N / 64, kb = item / nblk, nb = item % nblk, k0 = 64 * kb, n0 = 64 * nb, r = lane >> 4, q = lane & 15;
    f32x4 wv[16];
#pragma unroll
    for (int i = 0; i < 16; ++i) wv[i] = __builtin_nontemporal_load((const f32x4*)(W + (size_t)(k0 + 4 * i + r) * N + n0 + 4 * q));
    if (kscale) {
#pragma unroll
        for (int i = 0; i < 16; ++i) wv[i] *= kscale[k0 + 4 * i + r]; }
#pragma unroll
    for (int i = 0; i < 16; ++i) { LAS float* p = scr + (4 * i + r) * 65 + 4 * q; p[0] = wv[i][0]; p[1] = wv[i][1]; p[2] = wv[i][2]; p[3] = wv[i][3]; }
    LDS_WAIT(); asm volatile("" ::: "memory");
    const int c = lane & 7;
#pragma unroll
    for (int j = 0; j < 8; ++j) { const int n = (lane >> 3) + 8 * j; const LAS float* s = scr + (8 * c) * 65 + n;
        v4u o; o.x = pk2(s[0 * 65], s[1 * 65]); o.y = pk2(s[2 * 65], s[3 * 65]); o.z = pk2(s[4 * 65], s[5 * 65]); o.w = pk2(s[6 * 65], s[7 * 65]);
        *(GAS v4u*)(WT + (size_t)dst_row(mode, n0 + n) * ldk + kofs + k0 + 8 * c) = o; }
    LDS_WAIT(); asm volatile("" ::: "memory");
}
constexpr int IT_FFNIN = 16 * (FF2 / 64), IT_FFNOUT = (FF / 64) * (DM / 64), IT_WIN = 16 * (4672 / 64), IT_WQ = 4 * (NQ / 64), IT_WKV = 4 * (NKV / 64), IT_SQ = 16 * (DM / 64);
constexpr int IT_TR = 2 * IT_FFNIN + 2 * IT_FFNOUT + IT_WIN + IT_WQ + IT_WKV + 3 * IT_SQ;
constexpr int IT_PAD = 192, IT_WS = 256, IT_ROPE = 1;
constexpr int IT_P0 = IT_TR + IT_PAD + IT_WS + IT_ROPE;
constexpr int IT_DEF = 3 * IT_SQ + IT_FFNIN + IT_FFNOUT;

struct KArgs { const float* in[27]; float* out; unsigned char* ws; int ph_lo, ph_hi; int rep_mask, pad; };

__constant__ int PH_KIND[NPH] = {0, 1, 2, 3,        4, 5, 6, 7, 8,           4,          6,       5, 6,     7, 8,         2, 3, 9};
__constant__ int PH_ARG[NPH]  = {0, 0, 0, 0,        0, 0, 0, 0, 0,           1,          1,       2, 2,     1, 1,         1, 1, 0};
__constant__ double ROPE_INV[16] = {1.0, 0.5623413251903491, 0.31622776601683794, 0.1778279410038923, 0.1, 0.05623413251903491, 0.03162277660168379, 0.01778279410038923,
                                    0.01, 0.005623413251903491, 0.0031622776601683794, 0.0017782794100389228, 0.001, 0.0005623413251903491, 0.00031622776601683794, 0.00017782794100389227};

__device__ __forceinline__ void gmlp_pair(int itemA, int itemB, bf16* OAB, const bf16* WSb, const float* SSV, const float* vnorm, const float* bs, LAS unsigned char* L, const int wave_s) {
    int wid_ = wave_s; asm volatile("" : "+s"(wid_));
    const int lane = fresh_lane(), wid = wid_, half = wid >> 2, w4 = wid & 3, t256 = w4 * 64 + lane;
    const int item = half ? itemB : itemA; const bool on = item >= 0;
    const int cq = item >> 3, g = item & 7, r0 = cq * 128, r32 = lane & 31, hi = lane >> 5;
    LAS unsigned short* A_l = (LAS unsigned short*)(L + half * 70144);
    LAS unsigned short* VT_l = (LAS unsigned short*)(L + half * 70144 + 34816);
    LAS float* rstd_l = (LAS float*)(L + half * 70144 + 69632);
#define GM_BAR() do { asm volatile("s_waitcnt lgkmcnt(0)" ::: "memory"); __builtin_amdgcn_s_barrier(); asm volatile("" ::: "memory"); } while (0)
    f32x4 sv[4]; v4u wq[8], vq[8], uq[8];
#pragma unroll
    for (int q = 0; q < 4; ++q) sv[q] = (f32x4){0.f, 0.f, 0.f, 0.f};
#pragma unroll
    for (int i = 0; i < 8; ++i) { wq[i] = (v4u){0u, 0u, 0u, 0u}; vq[i] = wq[i]; uq[i] = wq[i]; }
    if (on) {
        if (t256 < 128) { const float* p = SSV + (size_t)(r0 + t256) * 16;
#pragma unroll
            for (int q = 0; q < 4; ++q) sv[q] = *(const f32x4*)(p + 4 * q); }
#pragma unroll
        for (int i = 0; i < 8; ++i) { const int id = t256 + 256 * i, row = id >> 4, ch = id & 15; wq[i] = *(const v4u*)(WSb + (size_t)g * 16384 + row * 128 + ch * 8); }
#pragma unroll
        for (int i = 0; i < 8; ++i) { const int id = t256 + 256 * i, rw = id & 127, cv = id >> 7; vq[i] = *(const v4u*)(OAB + (size_t)(r0 + rw) * 2048 + 1024 + g * 128 + cv * 8); }
#pragma unroll
        for (int i = 0; i < 8; ++i) { const int id = t256 + 256 * i, row = id >> 4, ch = id & 15; uq[i] = *(const v4u*)(OAB + (size_t)(r0 + row) * 2048 + g * 128 + ch * 8); }
    }
    if (on && t256 < 128) { float s = 0.f;
#pragma unroll
        for (int q = 0; q < 4; ++q) s += (sv[q][0] + sv[q][1]) + (sv[q][2] + sv[q][3]);
        rstd_l[t256] = rsqrtf(s * (1.f / 1024.f) + EPS); }
    GM_BAR();
    if (on) {
#pragma unroll
        for (int i = 0; i < 8; ++i) { const int id = t256 + 256 * i, row = id >> 4, ch = id & 15;
            *(LAS v4u*)(A_l + row * 136 + ch * 8) = wq[i];
            const int rw = id & 127, cv = id >> 7;
            const v4u vv = vq[i];
            const float rq = rstd_l[rw]; const f32x4 n0 = *(const f32x4*)(vnorm + g * 128 + cv * 8), n1 = *(const f32x4*)(vnorm + g * 128 + cv * 8 + 4);
            LAS unsigned short* vt = VT_l + (cv * 8) * 136 + rw;
            vt[0 * 136] = (unsigned short)f2bf(bflo(vv[0]) * rq * n0[0]); vt[1 * 136] = (unsigned short)f2bf(bfhi(vv[0]) * rq * n0[1]);
            vt[2 * 136] = (unsigned short)f2bf(bflo(vv[1]) * rq * n0[2]); vt[3 * 136] = (unsigned short)f2bf(bfhi(vv[1]) * rq * n0[3]);
            vt[4 * 136] = (unsigned short)f2bf(bflo(vv[2]) * rq * n1[0]); vt[5 * 136] = (unsigned short)f2bf(bfhi(vv[2]) * rq * n1[1]);
            vt[6 * 136] = (unsigned short)f2bf(bflo(vv[3]) * rq * n1[2]); vt[7 * 136] = (unsigned short)f2bf(bfhi(vv[3]) * rq * n1[3]); }
    }
    GM_BAR();
    f32x16 acc[4] = {};
    if (on) {
#pragma unroll
        for (int ks = 0; ks < 8; ++ks) {
            const bf16x8 af = *(const LAS bf16x8*)(A_l + (w4 * 32 + r32) * 136 + ks * 16 + hi * 8);
#pragma unroll
            for (int db = 0; db < 4; ++db) { const bf16x8 bfr = *(const LAS bf16x8*)(VT_l + (db * 32 + r32) * 136 + ks * 16 + hi * 8);
                acc[db] = __builtin_amdgcn_mfma_f32_32x32x16_bf16(af, bfr, acc[db], 0, 0, 0); }
        }
    }
    GM_BAR();
    LAS float* M_l = (LAS float*)(L + half * 70144);
    if (on) {
#pragma unroll
        for (int r = 0; r < 16; ++r) { const int p = w4 * 32 + (r & 3) + 8 * (r >> 2) + 4 * hi; const float bb = bs[p * 8 + g];
#pragma unroll
            for (int db = 0; db < 4; ++db) M_l[p * 132 + db * 32 + r32] = acc[db][r] + bb; }
    }
    GM_BAR();
    if (on) {
#pragma unroll
        for (int i = 0; i < 8; ++i) { const int id = t256 + 256 * i, row = id >> 4, ch = id & 15;
            bf16* up = OAB + (size_t)(r0 + row) * 2048 + g * 128 + ch * 8; const v4u uv = uq[i];
            const f32x4 m0 = *(const LAS f32x4*)(M_l + row * 132 + ch * 8), m1 = *(const LAS f32x4*)(M_l + row * 132 + ch * 8 + 4);
            v4u o; o.x = pk2(bflo(uv.x) * m0[0], bfhi(uv.x) * m0[1]); o.y = pk2(bflo(uv.y) * m0[2], bfhi(uv.y) * m0[3]); o.z = pk2(bflo(uv.z) * m1[0], bfhi(uv.z) * m1[1]); o.w = pk2(bflo(uv.w) * m1[2], bfhi(uv.w) * m1[3]);
            *(v4u*)up = o; }
    }
    GM_BAR();
}
#undef GM_BAR

__device__ __forceinline__ void bias_pass(int lo, int hi, int gw, int NGW, int lane, const float* mods_, const bf16* w1, const bf16* wi, const bf16* w2, float* b1, float* b2, float* b3) {
    int curmat = -1; float shv[NMOD][16];
#pragma unroll
    for (int mi = 0; mi < NMOD; ++mi)
#pragma unroll
        for (int i = 0; i < 16; ++i) shv[mi][i] = 0.f;
#define BP_ROW(IT) (((IT) < FF2 ? w1 + (size_t)(IT) * DM : (IT) < FF2 + NIN ? wi + (size_t)((IT) - FF2) * DM : w2 + (size_t)((IT) - FF2 - NIN) * DM))
    v4u pw0 = {0u, 0u, 0u, 0u}, pw1 = pw0;
    if (lo + gw < hi) { const bf16* r0 = BP_ROW(lo + gw); pw0 = *(const v4u*)(r0 + 8 * lane); pw1 = *(const v4u*)(r0 + 8 * (lane + 64)); }
    for (int it = lo + gw; it < hi; it += NGW) {
        int mat, n; if (it < FF2) { mat = 0; n = it; } else if (it < FF2 + NIN) { mat = 1; n = it - FF2; } else { mat = 2; n = it - FF2 - NIN; }
        const v4u w0 = pw0, w1v = pw1;
        if (it + NGW < hi) { const bf16* r1 = BP_ROW(it + NGW); pw0 = *(const v4u*)(r1 + 8 * lane); pw1 = *(const v4u*)(r1 + 8 * (lane + 64)); }
        if (mat != curmat) { curmat = mat;
#pragma unroll
            for (int mi = 0; mi < NMOD; ++mi)
#pragma unroll
                for (int j = 0; j < 2; ++j) { const float* sp = mods_ + mi * 9216 + 3 * mat * 1024 + 8 * (lane + 64 * j); const f32x4 s0 = *(const f32x4*)sp, s1 = *(const f32x4*)(sp + 4);
#pragma unroll
                    for (int i = 0; i < 4; ++i) { shv[mi][j * 8 + i] = s0[i]; shv[mi][j * 8 + 4 + i] = s1[i]; } } }
        float wv[16];
#pragma unroll
        for (int k = 0; k < 4; ++k) { wv[2 * k] = bflo(w0[k]); wv[2 * k + 1] = bfhi(w0[k]); wv[8 + 2 * k] = bflo(w1v[k]); wv[8 + 2 * k + 1] = bfhi(w1v[k]); }
        float* bo = (mat == 0 ? b1 : mat == 1 ? b2 : b3); const int nrow = (mat == 1 ? NIN : FF2);
#pragma unroll
        for (int mi = 0; mi < NMOD; ++mi) { float s = 0.f;
#pragma unroll
            for (int i = 0; i < 16; ++i) s += wv[i] * shv[mi][i];
            s = wave_sum(s); if (lane == 0) bo[mi * nrow + n] = s; }
    }
#undef BP_ROW
}

#ifndef MK_ONLY
#define MK_EN(k) true
#else
#define MK_EN(k) ((k) == MK_ONLY)
#endif
#define SS2_DELTA (WS_BIG + B_SS2 - WS_SSV)
#define mods ((float*)(ws + WS_MODS))
#define tab ((float*)(ws + WS_TAB))
#define bias1 ((float*)(ws + WS_BIAS1))
#define bias2 ((float*)(ws + WS_BIAS2))
#define bias3 ((float*)(ws + WS_BIAS3))
#define rope ((float*)(ws + WS_ROPE))
#define ss1 ((float*)(ws + WS_SS1))
#define ssp2 ((float*)(ws + WS_SSP2))
#define ssp3 ((float*)(ws + WS_SSP3))
#define sspf ((float*)(ws + WS_SSPF))
#define SSV ((float*)(ws + WS_SSV + (chunk == 2 ? SS2_DELTA : 0)))
#define SSQ ((float*)(ws + WS_SSQ + (chunk == 2 ? SS2_DELTA : 0)))
#define SSC ((float*)(ws + WS_SSC + (chunk == 2 ? SS2_DELTA : 0)))
#define W1IN ((bf16*)(ws + WS_W + W_1IN))
#define W1OUT ((bf16*)(ws + WS_W + W_1OUT))
#define WIN ((bf16*)(ws + WS_W + W_IN))
#define WQ ((bf16*)(ws + WS_W + W_Q))
#define WKV ((bf16*)(ws + WS_W + W_KV))
#define WAB ((bf16*)(ws + WS_W + W_AB))
#define WO ((bf16*)(ws + WS_W + W_O))
#define W2IN ((bf16*)(ws + WS_W + W_2IN))
#define W2OUT ((bf16*)(ws + WS_W + W_2OUT))
#define WSb ((bf16*)(ws + WS_W + W_S))
#define XS ((bf16*)(ws + WS_XS))
#define ACT ((bf16*)(ws + WS_BIG))
#define OAB ((bf16*)(ws + WS_BIG + B_OAB))
#define OABC ((bf16*)(ws + WS_BIG + (chunk == 2 ? B_OAB2 : B_OAB)))
#define GT ((bf16*)(ws + WS_BIG + (chunk ? B_G : B_OAB2)))
#define Qb ((bf16*)(ws + WS_BIG + B_Q))
#define KN ((bf16*)(ws + WS_BIG + B_KN))
#define Vb ((bf16*)(ws + WS_BIG + B_V))
#define QL ((bf16*)(ws + WS_BIG + (chunk == 0 ? B_QL0 : B_QL + (chunk == 2 ? B_SET2 : 0))))
#define CKV ((bf16*)(ws + WS_BIG + (chunk == 0 ? B_CKV0 : B_CKV + (chunk == 2 ? B_SET2 : 0))))
#define KR ((bf16*)(ws + WS_BIG + (chunk == 0 ? B_KR0 : B_KR + (chunk == 2 ? B_SET2 : 0))))
#define INP(k) ((const float*)(const GAS float*)ap->in[k])
#define OUTP ((float*)(GAS float*)ap->out)
#define X (OUTP)
#define nckv (OUTP + (size_t)T_ALL * DM)
#define rawkr ((float*)(ws + WS_BIG + B_QL + B_SET2 + 8 * MiB))
#define rawckv ((float*)(ws + WS_BIG + B_QL + B_SET2))
#define nkr (OUTP + (size_t)T_ALL * DM + (size_t)T_CTX * 256)
__global__ void __launch_bounds__(NWAVES * 64, 2) mk_fwd(KArgs a) {
    extern __shared__ __attribute__((aligned(16))) unsigned char lds[];
    LAS unsigned char* L = (LAS unsigned char*)lds;
    const int wave_s = __builtin_amdgcn_readfirstlane(threadIdx.x >> 6);
    volatile LAS unsigned* MISC = (volatile LAS unsigned*)(L + MISC_OFF);
    const bool fused = (a.ph_hi - a.ph_lo) > 1;
    XcdBarrier bar; bar.bar = mk_bar_words; bar.x = 0; bar.st = MISC + 8;
    if (fused) bar = xcd_barrier_post(mk_bar_words, MISC + 8);

    for (int ph = a.ph_lo; ph < a.ph_hi; ++ph)
    for (int rep = 0; rep <= ((a.rep_mask >> ph) & 1); ++rep) {
        if (ph != a.ph_lo || rep != 0) xcd_barrier(bar, wave_s);
        int NG = gridDim.x, bx = blockIdx.x; asm volatile("" : "+s"(NG), "+s"(bx));
        const int vcu = (NG % 8 == 0) ? (bx % 8) * (NG / 8) + bx / 8 : bx, NGW = NG * NWAVES;
        int wave = wave_s; asm volatile("" : "+s"(wave));
        const int gw = vcu * NWAVES + wave;
        const __attribute__((address_space(4))) KArgs* ap = (const __attribute__((address_space(4))) KArgs*)__builtin_amdgcn_kernarg_segment_ptr(); asm volatile("" : "+s"(ap));
        GAS unsigned char* ws0 = (GAS unsigned char*)ap->ws; asm volatile("" : "+s"(ws0)); unsigned char* ws = (unsigned char*)ws0;

        const int kind0 = PH_KIND[ph], chunk0 = PH_ARG[ph];
        const bool split = (kind0 == 4 && chunk0 == 0), tailw = split && bx >= NG / 2;
        const bool split7 = (kind0 == 7 && chunk0 == 0), tail7 = split7 && bx >= NG / 2;
        const int chunk = tail7 ? 1 : chunk0;
        const int kind = tailw ? 3 : tail7 ? 4 : kind0, Gx = (split || split7) ? NG / 2 : NG, cx = (tailw || tail7) ? bx - NG / 2 : bx;

        if (kind == 0 && MK_EN(0)) {
            const int lane = fresh_lane(), tid = wave * 64 + lane; (void)tid;
            LAS float* stab = (LAS float*)(L + 67584);
            for (int i = tid; i < NMOD * 1024; i += NWAVES * 64) { const int mi = i >> 10, k = i & 1023; const float cv = mi == 0 ? INP(5)[k] : INP(2)[(mi - 1) * 1024 + k]; stab[k * 8 + mi] = cv / (1.f + __expf(-cv)); }
            __syncthreads();
            LAS float* red = (LAS float*)(L + 100352);
            for (int cgp = vcu; cgp < 576; cgp += NG) {
                const int j0 = 16 * cgp, kq = lane >> 2, cg = lane & 3; const float* wp = INP(6) + j0 + 4 * cg;
                f32x4 ac0 = {0.f, 0.f, 0.f, 0.f}, ac1 = ac0, ac2 = ac0, ac3 = ac0, ac4 = ac0;
#pragma unroll
                for (int i = 0; i < 8; ++i) { const int k = wave * 128 + kq + 16 * i; const f32x4 w = __builtin_nontemporal_load((const f32x4*)(wp + (size_t)k * 9216));
                    const f32x4 s03 = *(const LAS f32x4*)(stab + k * 8); const float s4 = stab[k * 8 + 4];
                    ac0 += w * s03[0]; ac1 += w * s03[1]; ac2 += w * s03[2]; ac3 += w * s03[3]; ac4 += w * s4; }
#pragma unroll
                for (int c = 0; c < 4; ++c) {
#define RED5(OP) ac0[c] = OP(ac0[c]); ac1[c] = OP(ac1[c]); ac2[c] = OP(ac2[c]); ac3[c] = OP(ac3[c]); ac4[c] = OP(ac4[c]);
#define R4(v) ((v) + dpp_get<0x124>(v))
#define R8(v) ((v) + dpp_get<0x128>(v))
#define R16(v) add_xor16(v)
                    RED5(R4) RED5(R8) RED5(R16) RED5(add_xor32)
#undef RED5
#undef R4
#undef R8
#undef R16
                }
                if (lane < 4) { LAS float* rp = red + (wave * 4 + lane) * 20; *(LAS f32x4*)(rp) = ac0; *(LAS f32x4*)(rp + 4) = ac1; *(LAS f32x4*)(rp + 8) = ac2; *(LAS f32x4*)(rp + 12) = ac3; *(LAS f32x4*)(rp + 16) = ac4; }
                __syncthreads();
                if (tid < 80) { const int l4 = tid / 20, e = tid % 20; float t = 0.f;
#pragma unroll
                    for (int w8 = 0; w8 < 8; ++w8) t += red[(w8 * 4 + l4) * 20 + e];
                    const int mi = e >> 2, col = j0 + 4 * l4 + (e & 3); mods[mi * 9216 + col] = t + INP(7)[col]; }
                __syncthreads();
            }
            LAS float* scr = (LAS float*)(L + wave * 16640);
            for (int it = NGW - 1 - gw; it < IT_P0 - IT_DEF; it += NGW) {
                int r = it;
                if (r < IT_FFNIN)  { tr_item(INP(9),  FF2, W1IN, DM, 0, MAP_FFNIN, nullptr, r, scr, lane); continue; } r -= IT_FFNIN;
                if (r < IT_FFNOUT) { tr_item(INP(10), DM, W1OUT, FF, 0, MAP_PLAIN, nullptr, r, scr, lane); continue; } r -= IT_FFNOUT;
                if (r < IT_WIN)    { tr_item(INP(12), 4672, WIN, DM, 0, MAP_WIN, nullptr, r, scr, lane); continue; } r -= IT_WIN;
                if (r < IT_WQ)     { tr_item(INP(17), NQ, WQ, 256, 0, MAP_WQ, INP(16), r, scr, lane); continue; } r -= IT_WQ;
                if (r < IT_WKV)    { tr_item(INP(19), NKV, WKV, 256, 0, MAP_WKV, INP(18), r, scr, lane); continue; } r -= IT_WKV;
                if (r < IT_PAD)    { const v4u z = {0u, 0u, 0u, 0u}; bf16* p = WIN + (size_t)(2624 + r) * DM + lane * 16; *(v4u*)p = z; *(v4u*)(p + 8) = z; continue; } r -= IT_PAD;
                if (r < IT_WS)     { const float* s = INP(14) + (size_t)r * 512 + lane * 8; const f32x4 x0 = *(const f32x4*)s, x1 = *(const f32x4*)(s + 4);
                                     v4u o; o.x = pk2(x0[0], x0[1]); o.y = pk2(x0[2], x0[3]); o.z = pk2(x1[0], x1[1]); o.w = pk2(x1[2], x1[3]); *(v4u*)(WSb + (size_t)r * 512 + lane * 8) = o; continue; } r -= IT_WS;
                if (lane < 16) {
                    const double th = ROPE_INV[lane], t2 = th * th;
                    const double s1 = th * (1.0 - t2 * (1.0 / 6.0) * (1.0 - t2 * (1.0 / 20.0) * (1.0 - t2 * (1.0 / 42.0) * (1.0 - t2 * (1.0 / 72.0) * (1.0 - t2 * (1.0 / 110.0) * (1.0 - t2 * (1.0 / 156.0) * (1.0 - t2 * (1.0 / 210.0))))))));
                    const double c1 = 1.0 - t2 * (1.0 / 2.0) * (1.0 - t2 * (1.0 / 12.0) * (1.0 - t2 * (1.0 / 30.0) * (1.0 - t2 * (1.0 / 56.0) * (1.0 - t2 * (1.0 / 90.0) * (1.0 - t2 * (1.0 / 132.0) * (1.0 - t2 * (1.0 / 182.0)))))));
                    double cp = 1.0, sp = 0.0;
                    for (int pos = 0; pos < 64; ++pos) { rope[pos * 16 + lane] = (float)cp; rope[1024 + pos * 16 + lane] = (float)sp; const double cn = cp * c1 - sp * s1, sn = sp * c1 + cp * s1; cp = cn; sp = sn; }
                }
            }
        } else if (kind == 1 && MK_EN(1)) {
            const int lane = fresh_lane(), tid = wave * 64 + lane; (void)tid;
            for (int it = gw; it < 480; it += NGW) { const int idx = it * 64 + lane, k = idx / 5120, rem = idx % 5120, mi = rem >> 10, c = rem & 1023; const float* mm = mods + mi * 9216; float v;
                if (k == 0) v = INP(8)[c] * (1.f + mm[1024 + c]); else if (k == 1) v = INP(11)[c] * (1.f + mm[4 * 1024 + c]); else if (k == 2) v = INP(23)[c] * (1.f + mm[7 * 1024 + c]);
                else if (k == 3) v = 0.5f * mm[2 * 1024 + c]; else if (k == 4) v = mm[5 * 1024 + c]; else v = 0.5f * mm[8 * 1024 + c];
                tab[idx] = v; }
            bias_pass(0, FF2 + NIN, gw, NGW, lane, mods, W1IN, WIN, W2IN, bias1, bias2, bias3);
            for (int m0 = gw; m0 < T_ALL; m0 += 2 * NGW) {
                const int m1 = m0 + NGW, mi = m0 < T_CTX ? 0 : 1 + ((m0 - T_CTX) >> 12);
                const float* s0 = m0 < T_CTX ? INP(0) + (size_t)m0 * DM : INP(1) + (size_t)(m0 - T_CTX) * DM; const float* s1 = m1 < T_CTX ? INP(0) + (size_t)m1 * DM : INP(1) + (size_t)(m1 - T_CTX) * DM;
                const float* sc = mods + mi * 9216 + 1024; f32x4 xa[4], xb[4], cs[4]; float ssa = 0.f, ssb = 0.f;
#pragma unroll
                for (int j = 0; j < 4; ++j) { const int c = 4 * lane + 256 * j; xa[j] = __builtin_nontemporal_load((const f32x4*)(s0 + c)); xb[j] = __builtin_nontemporal_load((const f32x4*)(s1 + c));     cs[j] = *(const f32x4*)(INP(8) + c) * (1.f + *(const f32x4*)(sc + c)); }
#pragma unroll
                for (int j = 0; j < 4; ++j) { const int c = 4 * lane + 256 * j; ssa += (xa[j][0] * xa[j][0] + xa[j][1] * xa[j][1]) + (xa[j][2] * xa[j][2] + xa[j][3] * xa[j][3]); ssb += (xb[j][0] * xb[j][0] + xb[j][1] * xb[j][1]) + (xb[j][2] * xb[j][2] + xb[j][3] * xb[j][3]);
                    const f32x4 ya = xa[j] * cs[j], yb = xb[j] * cs[j]; v2u o; o.x = pk2(ya[0], ya[1]); o.y = pk2(ya[2], ya[3]); *(v2u*)(XS + (size_t)m0 * DM + c) = o; o.x = pk2(yb[0], yb[1]); o.y = pk2(yb[2], yb[3]); *(v2u*)(XS + (size_t)m1 * DM + c) = o; }
                ssa = wave_sum(ssa); ssb = wave_sum(ssb); if (lane == 0) { ss1[m0] = ssa; ss1[m1] = ssb; }
            }
        } else if (kind == 2 && MK_EN(2)) {
            const bool second = (chunk == 1);
            pg8::Gemm g{XS, second ? W2IN : W1IN, T_ALL, FF2, DM, DM}; pg8::StaticOrder S; S.init(T_ALL, FF2, NG, bx);
            pg8::EpiSwiGLU E{ACT, second ? ssp3 : ss1, second ? 16 : 1, second ? bias3 : bias1};
            pg8::gemm_phase<pg8::EpiSwiGLU, pg8::StaticOrder, true, true>(L, g, S, E, wave_s);
            if (!second && bx >= 128) {
                const int lane = fresh_lane(); LAS float* scr = (LAS float*)(L + wave * 16640);
                for (int it = (bx - 128) * NWAVES + wave; it < IT_DEF - IT_FFNOUT; it += (NG - 128) * NWAVES) {
                    int r = it;
                    if (r < IT_SQ)     { tr_item(INP(20), DM, WAB, 2048, 0, MAP_PLAIN, nullptr, r, scr, lane); continue; } r -= IT_SQ;
                    if (r < IT_SQ)     { tr_item(INP(21), DM, WAB, 2048, 1024, MAP_PLAIN, nullptr, r, scr, lane); continue; } r -= IT_SQ;
                    if (r < IT_SQ)     { tr_item(INP(22), DM, WO, DM, 0, MAP_PLAIN, nullptr, r, scr, lane); continue; } r -= IT_SQ;
                    tr_item(INP(24), FF2, W2IN, DM, 0, MAP_FFNIN, nullptr, r, scr, lane);
                }
            }
        } else if ((kind == 3 || kind == 8) && MK_EN(3)) {
            pg8::Gemm g; pg8::EpiResid E; pg8::StaticOrder S;
            if (kind == 3) { const bool second = (chunk == 1);
                g = pg8::Gemm{ACT + (tailw ? (size_t)16384 * FF : 0), second ? W2OUT : W1OUT, second ? T_ALL : (tailw ? 8192 : 16384), DM, FF, FF};
                E = second ? pg8::EpiResid{tab + 2 * 5120, tab + 5 * 5120, INP(26), 0, XS, sspf, 0}
                           : pg8::EpiResid{tab + 0 * 5120, tab + 3 * 5120, tab + 1 * 5120, DM, XS, ssp2, tailw ? 64 : 0};
            } else {
                g = pg8::Gemm{GT, WO, chunk ? 2 * TC : TC, DM, DM, 2048};
                E = pg8::EpiResid{tab + 1 * 5120, tab + 4 * 5120, tab + 2 * 5120, DM, XS, ssp3, chunk * 32};
            }
            S.init(g.M, g.N, Gx, cx);
            pg8::gemm_phase<pg8::EpiResid, pg8::StaticOrder, true, true>(L, g, S, E, wave_s);
            if (tailw) bias_pass(FF2 + NIN, FF2 + NIN + FF2, cx * NWAVES + wave, Gx * NWAVES, fresh_lane(), mods, W1IN, WIN, W2IN, bias1, bias2, bias3);
        } else if (kind == 4 && MK_EN(4)) {
            const int lane = fresh_lane(), tid = wave * 64 + lane; (void)tid;
            const int Mw = chunk ? 2 * TC : TC;
            const int pn0 = tail7 ? 8 : 0, Nw = chunk == 0 ? 2816 : (tail7 ? 768 : 2048);
            pg8::Gemm g{XS + (size_t)chunk * TC * DM, WIN + (size_t)pn0 * 256 * DM, Mw, Nw, DM, DM}; pg8::StaticOrder S; S.init(Mw, Nw, Gx, cx);
            pg8::EpiWin E{ssp2, bias2, OAB, QL, CKV, KR, SSV, SSQ, SSC, rawckv, rawkr, rope, chunk, (long)B_SET2, (long)SS2_DELTA, pn0};
            pg8::gemm_phase<pg8::EpiWin, pg8::StaticOrder, true, true>(L, g, S, E, wave_s);
            if (tail7) {
                const int lane2 = fresh_lane(); LAS float* scr = (LAS float*)(L + wave * 16640);
                for (int it = cx * NWAVES + wave; it < IT_FFNOUT; it += Gx * NWAVES) tr_item(INP(25), DM, W2OUT, FF, 0, MAP_PLAIN, nullptr, it, scr, lane2);
                for (int it = cx * NWAVES + wave; it < 1024; it += Gx * NWAVES) { const int b = it >> 8, t = it & 255; const size_t kr = (size_t)(b & 1) * 4352 + t; const size_t d2 = (b >> 1) ? B_SET2 : 0;
                const f32x4 x = *(const f32x4*)(INP(3) + ((size_t)b * 256 + t) * 256 + 4 * lane2), kn = *(const f32x4*)(INP(18) + 4 * lane2);
                v2u o; o.x = pk2(x[0] / kn[0], x[1] / kn[1]); o.y = pk2(x[2] / kn[2], x[3] / kn[3]); *(v2u*)((char*)(CKV + kr * 256 + 4 * lane2) + d2) = o;
                const int s = lane2 & 31, dim = (lane2 & 32) + 16 * ((s >> 2) & 1) + 4 * (s >> 3) + (s & 3);
                *(bf16*)((char*)(KR + kr * 64 + lane2) + d2) = (bf16)f2bf(INP(4)[((size_t)b * 256 + t) * 64 + dim]); }
            }
        }
        if ((kind == 5 || (kind0 == 4 && chunk0 == 1)) && MK_EN(5)) {
            const int lane = fresh_lane(), tid = wave * 64 + lane; (void)tid;
#if !defined(MK_SUB) || MK_SUB == 0
            { pg8::Gemm g{QL, WQ, TC, NQ, 256, 256}; pg8::StaticOrder S; S.init(TC, NQ, NG, bx); pg8::EpiQ E{Qb, SSQ, rope, chunk};
              pg8::gemm_phase<pg8::EpiQ, pg8::StaticOrder, true, true>(L, g, S, E, wave_s); }
#endif
#if !defined(MK_SUB) || MK_SUB == 1
            { const int Mk = chunk == 0 ? TC : KEYROWS; pg8::Gemm g{CKV, WKV, Mk, NKV, 256, 256}; pg8::StaticOrder S; S.init(Mk, NKV, NG, (bx + 64) % NG);   pg8::EpiKV E{KN, Vb, SSC, chunk};
              pg8::gemm_phase<pg8::EpiKV, pg8::StaticOrder, true, true>(L, g, S, E, wave_s); }
#endif
#if !defined(MK_SUB) || MK_SUB == 2
#endif
            if (chunk == 0) for (int m = gw; m < T_CTX; m += NGW) { const f32x4 p = *(const f32x4*)(SSC + (size_t)m * 4); const float rstd = rsqrtf(((p[0] + p[1]) + (p[2] + p[3])) * (1.f / 256.f) + EPS);
                const f32x4 v = *(const f32x4*)(rawckv + (size_t)m * 256 + 4 * lane), kn = *(const f32x4*)(INP(18) + 4 * lane); __builtin_nontemporal_store(v * rstd * kn, (f32x4*)(nckv + (size_t)m * 256 + 4 * lane)); }
            if (chunk == 0) for (int i = gw; i < T_CTX * 64 / 256; i += NGW) __builtin_nontemporal_store(*(const f32x4*)(rawkr + (size_t)i * 256 + 4 * lane), (f32x4*)(nkr + (size_t)i * 256 + 4 * lane));
        } else if (kind == 6 && MK_EN(6)) {
            if (chunk == 0) {
                pg8::Gemm g{XS, WIN + (size_t)2816 * DM, TC, 2048, DM, DM}; pg8::StaticOrder S; S.init(TC, 2048, NG, bx);
                pg8::EpiGate E{ssp2, bias2, GT, 0};
                pg8::gemm_phase<pg8::EpiGate, pg8::StaticOrder, true, true>(L, g, S, E, wave_s);
            }
            for (int u = vcu; u < 256; u += NG) {
                const int b0 = u >> 3, h0 = u & 7, bh = u >> 4, qb = u & 15, j = bh >> 3, h1 = bh & 7;
                const int cq0 = chunk == 0 ? 2 * b0 : j * 32 + qb * 2, hh = chunk == 0 ? h0 : h1;
                gmlp_pair(cq0 * 8 + hh, (cq0 + 1) * 8 + hh, OABC, WSb, SSV, INP(13), INP(15), L, wave_s);
                if (chunk == 0) { const int b = b0, h = h0; const size_t r0 = (size_t)b * 256;
                    att::attn_unit(Qb + r0 * NQ + h * 192, KN + r0 * DM + h * 128, KR + r0 * 64, Vb + r0 * DM + h * 128, OABC + r0 * 2048 + 1024 + h * 128, 256, (char*)lds, wave_s);
                } else { const int h = h1; const size_t q0 = (size_t)j * 4096 + qb * 256, k0 = (size_t)j * 4352;
                    att::attn_unit(Qb + q0 * NQ + h * 192, KN + k0 * DM + h * 128, KR + k0 * 64, Vb + k0 * DM + h * 128, OABC + q0 * 2048 + 1024 + h * 128, 4352, (char*)lds, wave_s); }
            }
        } else if (kind == 7 && MK_EN(7)) {
            const int Mg = chunk ? 2 * TC : TC; pg8::Gemm g{OAB, WAB, Mg, DM, 2048, 2048}; pg8::StaticOrder S; S.init(Mg, DM, Gx, cx); pg8::EpiMerge E{GT};
            if (chunk == 1) {
                pg8::Unit um; if (S.next(0, um)) { pg8::Gemm gg{XS + (size_t)T_CTX * DM, WIN + (size_t)2816 * DM, Mg, 2048, DM, DM}; pg8::StaticOrder Sg; Sg.init(Mg, 2048, NG, bx); Sg.pair = 1; Sg.pm0 = um.pm; Sg.pn0 = um.pn;
                    pg8::EpiGate Eg{ssp2, bias2, GT, 32}; pg8::gemm_phase<pg8::EpiGate, pg8::StaticOrder, true, true>(L, gg, Sg, Eg, wave_s); } }
            pg8::gemm_phase<pg8::EpiMerge, pg8::StaticOrder, true, true>(L, g, S, E, wave_s);
        } else if (kind == 9 && MK_EN(9)) {
            const int lane = fresh_lane(), tid = wave * 64 + lane; (void)tid;
            for (int m0 = 2 * gw; m0 < T_ALL; m0 += 2 * NGW) { const int m1 = m0 + 1;
                const float pa = lane < 16 ? sspf[(size_t)m0 * 16 + lane] : 0.f, pb = lane < 16 ? sspf[(size_t)m1 * 16 + lane] : 0.f; v2u xa[4], xb[4];
#pragma unroll
                for (int j = 0; j < 4; ++j) { const int c = 4 * lane + 256 * j; xa[j] = *(const v2u*)(XS + (size_t)m0 * DM + c); xb[j] = *(const v2u*)(XS + (size_t)m1 * DM + c); }
                const float ra = rsqrtf(wave_sum(pa) * (1.f / DM) + EPS), rb = rsqrtf(wave_sum(pb) * (1.f / DM) + EPS);
#pragma unroll
                for (int j = 0; j < 4; ++j) { const int c = 4 * lane + 256 * j;
                    __builtin_nontemporal_store((f32x4){bflo(xa[j].x), bfhi(xa[j].x), bflo(xa[j].y), bfhi(xa[j].y)} * ra, (f32x4*)(X + (size_t)m0 * DM + c)); }
#pragma unroll
                for (int j = 0; j < 4; ++j) { const int c = 4 * lane + 256 * j;
                    __builtin_nontemporal_store((f32x4){bflo(xb[j].x), bfhi(xb[j].x), bflo(xb[j].y), bfhi(xb[j].y)} * rb, (f32x4*)(X + (size_t)m1 * DM + c)); } }
        }
    }
}

#undef INP
#undef SS2_DELTA
#undef OABC
#undef OUTP
#undef mods
#undef tab
#undef bias1
#undef bias2
#undef bias3
#undef rope
#undef ss1
#undef ssp2
#undef ssp3
#undef sspf
#undef SSV
#undef SSQ
#undef SSC
#undef W1IN
#undef W1OUT
#undef WIN
#undef WQ
#undef WKV
#undef WAB
#undef WO
#undef W2IN
#undef W2OUT
#undef WSb
#undef XS
#undef ACT
#undef OAB
#undef GT
#undef Qb
#undef KN
#undef Vb
#undef QL
#undef CKV
#undef KR
#undef X
#undef nckv
#undef rawckv
#undef rawkr
#undef nkr
#ifndef MK_SPLIT
#define MK_SPLIT 0
#endif
extern "C" void kernel_launch(void* const* d_in, const int* in_sizes, int n_in, void* d_out, int out_size, void* d_ws, size_t ws_size, hipStream_t stream) {
    static int grid = 0;
    if (grid == 0) {
        if (n_in != 27 || ws_size < WS_END || out_size != T_ALL * DM + T_CTX * 256 + T_CTX * 64) { fprintf(stderr, "kernel_launch: unexpected shapes: n_in %d out %d ws %zu (need %zu)\n", n_in, out_size, ws_size, (size_t)WS_END); grid = -1; return; }
        int dev = 0, cus = 0, per_cu = 0;
        if (hipGetDevice(&dev) != hipSuccess || hipDeviceGetAttribute(&cus, hipDeviceAttributeMultiprocessorCount, dev) != hipSuccess) { grid = -1; return; }
        if (hipFuncSetAttribute((const void*)mk_fwd, hipFuncAttributeMaxDynamicSharedMemorySize, LDS_BYTES) != hipSuccess) { fprintf(stderr, "kernel_launch: hipFuncSetAttribute failed\n"); grid = -1; return; }
        if (hipOccupancyMaxActiveBlocksPerMultiprocessor(&per_cu, (const void*)mk_fwd, NWAVES * 64, LDS_BYTES) != hipSuccess || per_cu < 1) { fprintf(stderr, "kernel_launch: occupancy query says %d\n", per_cu); per_cu = 1; }
        (void)hipGetLastError();
        if (cus < 256) { fprintf(stderr, "kernel_launch: built for a 256-CU device (got %d CUs)\n", cus); grid = -1; return; }
        grid = 256;
    }
    if (grid < 0) return;
    KArgs a{};
    for (int i = 0; i < 27; ++i) a.in[i] = (const float*)d_in[i];
    a.out = (float*)d_out; a.ws = (unsigned char*)d_ws;
#if MK_SPLIT
#ifndef MK_SKIP_MASK
#define MK_SKIP_MASK 0u
#endif
    for (int p = 0; p < NPH; ++p) { if ((MK_SKIP_MASK >> p) & 1u) continue; a.ph_lo = p; a.ph_hi = p + 1; hipLaunchKernelGGL(mk_fwd, dim3(grid), dim3(NWAVES * 64), LDS_BYTES, stream, a); }
#else
#ifndef MK_REPEAT_MASK
#define MK_REPEAT_MASK 0
#endif
    a.ph_lo = 0; a.ph_hi = NPH; a.rep_mask = MK_REPEAT_MASK;
    void* args[] = {&a};
    hipError_t e = hipLaunchCooperativeKernel((const void*)mk_fwd, dim3(grid), dim3(NWAVES * 64), args, LDS_BYTES, stream);
    if (e != hipSuccess) fprintf(stderr, "kernel_launch: cooperative launch failed: %s (grid %d)\n", hipGetErrorString(e), grid);
#endif
}
```

```cpp
#include <hip/hip_runtime.h>
#include <cstdio>
#include <cstdint>

constexpr int DM = 1024;
constexpr int T_CTX = 8192, T_LAT = 16384, T_ALL = 24576;
constexpr int TC = 8192, NCHUNK = 3;
constexpr int FF = 2816, FF2 = 5632;
constexpr int NIN = 4864;
constexpr int NQ = 1536, NKV = 2048;
constexpr int KEYROWS = 8704;
constexpr float EPS = 1e-6f;
constexpr int NMOD = 5;
constexpr int NPH = 18;

template <int O> __device__ __forceinline__ float xor_swz(float v) {
    return __builtin_bit_cast(float, __builtin_amdgcn_ds_swizzle(__builtin_bit_cast(int, v), (O << 10) | 0x1f)); }
__device__ __forceinline__ float add_xor32(float v) {
    auto r = __builtin_amdgcn_permlane32_swap(__builtin_bit_cast(unsigned, v), __builtin_bit_cast(unsigned, v), false, false);
    const unsigned r0 = r[0], r1 = r[1];
    return __builtin_bit_cast(float, r0) + __builtin_bit_cast(float, r1); }
__device__ __forceinline__ float add_xor16(float v) {
    auto r = __builtin_amdgcn_permlane16_swap(__builtin_bit_cast(unsigned, v), __builtin_bit_cast(unsigned, v), false, false);
    const unsigned r0 = r[0], r1 = r[1];
    return __builtin_bit_cast(float, r0) + __builtin_bit_cast(float, r1); }
template <int CTRL> __device__ __forceinline__ float dpp_get(float v) {
    return __builtin_bit_cast(float, __builtin_amdgcn_update_dpp(0, __builtin_bit_cast(int, v), CTRL, 0xF, 0xF, true)); }
__device__ __forceinline__ float wave_sum(float v) {
    v += dpp_get<0xB1>(v); v += dpp_get<0x4E>(v); v += dpp_get<0x141>(v); v += dpp_get<0x140>(v); v = add_xor16(v); return add_xor32(v); }
__device__ __forceinline__ float lane_bcast(float v, int srclane) {
    return __builtin_bit_cast(float, __builtin_amdgcn_ds_bpermute(srclane << 2, __builtin_bit_cast(int, v))); }

__device__ __forceinline__ int fresh_lane() { int l; asm volatile("v_mbcnt_lo_u32_b32 %0, -1, 0\n\tv_mbcnt_hi_u32_b32 %0, -1, %0" : "=v"(l)); return l; }

namespace pg8 {
#define PG8_LAS __attribute__((address_space(3)))
typedef unsigned short bf16_t;
typedef short bf16x8 __attribute__((ext_vector_type(8)));
typedef float f32x4 __attribute__((ext_vector_type(4)));
typedef unsigned u32x4 __attribute__((ext_vector_type(4)));
constexpr int BM = 256, BK = 64, HALF = 128, HTB = HALF * BK * 2  , STAGE_BYTES = 8 * HTB, NXCD = 8, WGM = 8;

__host__ __device__ __forceinline__ int lds_byte(int r, int c) { const int st = (r >> 4) * 2 + (c >> 5), rr = r & 15, cc = c & 31, ob = rr * 64 + cc * 2; return st * 1024 + (ob ^ (((ob >> 9) & 1) << 5)); }
__host__ __device__ __forceinline__ void stage_rc(int b, int& R, int& C) { const int st = b / 1024, sb = b % 1024, swz = sb ^ (((sb >> 9) & 1) << 5); R = (st >> 1) * 16 + swz / 64; C = (st & 1) * 32 + (swz % 64) / 2; }
__host__ __device__ __forceinline__ int perm32(int rho) { const int n = rho >> 4, i = rho & 15; return 8 * (i >> 2) + 4 * n + (i & 3); }

struct Unit { int pm, pn, half; };
struct Gemm { const bf16_t* A; const bf16_t* Bt; int M, N, K, lda; };

struct StaticOrder {
    int nM, nN, nwg, G, c, pair, pm0, pn0;
    __host__ __device__ void init(int M, int N, int G_, int c_) { nM = M / BM; nN = N / BM; nwg = nM * nN; G = G_; c = c_; pair = 0; pm0 = 0; pn0 = 0; }
    __host__ __device__ __forceinline__ bool next(int i, Unit& u) const {
        if (pair) { if (i > 1) return false; u.pm = pm0; u.pn = pn0 + 4 * i; u.half = 0; return true; }
        const int rfull = nwg / G, R = nwg - rfull * G;
        if (i == rfull && R > 0 && 2 * R <= G) { if (c >= 2 * R) return false;
            const bool ok = at((long)rfull * G + (((c >> 4) << 3) | (c & 7)), u); u.half = 1 + ((c >> 3) & 1); return ok; }
        return at((long)i * G + c, u);
    }
    __host__ __device__ __forceinline__ bool at(const long L, Unit& u) const {
        if (L >= nwg) return false;
        int wgid = (int)L; { const int q = nwg / NXCD, r = nwg % NXCD, xcd = wgid % NXCD, off = wgid / NXCD; wgid = (xcd < r ? xcd * (q + 1) : r * (q + 1) + (xcd - r) * q) + off; }
        const int nig = WGM * nN, gid = wgid / nig, fm = gid * WGM, gsz = (nM - fm) < WGM ? (nM - fm) : WGM;
        u.pm = fm + ((wgid % nig) % gsz); u.pn = (wgid % nig) / gsz; u.half = 0; return true;
    }
    __device__ __forceinline__ void a_ready(const Unit&) const {}
    __device__ __forceinline__ void done(const Unit&) const {}
};

typedef float f32x2c_t __attribute__((ext_vector_type(2))); typedef __bf16 bf16x2c_t __attribute__((ext_vector_type(2)));
__device__ __forceinline__ unsigned cvt_pk_bf16(float lo, float hi) { f32x2c_t v = {lo, hi}; bf16x2c_t b = __builtin_convertvector(v, bf16x2c_t); return __builtin_bit_cast(unsigned, b); }
typedef float f32x2 __attribute__((ext_vector_type(2)));
typedef unsigned u32x2 __attribute__((ext_vector_type(2)));
__device__ __forceinline__ float silu_f(float x) { return x * __builtin_amdgcn_rcpf(1.f + __expf(-x)); }
__device__ __forceinline__ float sigm_f(float x) { return __builtin_amdgcn_rcpf(1.f + __expf(-x)); }
__device__ __forceinline__ u32x4 pack8(const f32x4 a, const f32x4 b) { u32x4 w; w.x = cvt_pk_bf16(a[0], a[1]); w.y = cvt_pk_bf16(a[2], a[3]); w.z = cvt_pk_bf16(b[0], b[1]); w.w = cvt_pk_bf16(b[2], b[3]); return w; }
__device__ __forceinline__ float bf_lo(unsigned w) { return __builtin_bit_cast(float, w << 16); }
__device__ __forceinline__ float bf_hi(unsigned w) { return __builtin_bit_cast(float, w & 0xffff0000u); }
__device__ __forceinline__ float dot4(const f32x4 x) { return (x[0] * x[0] + x[1] * x[1]) + (x[2] * x[2] + x[3] * x[3]); }
__device__ __forceinline__ int mod_index(int gpm) { return gpm < 32 ? 0 : 1 + ((gpm - 32) >> 4); }

template <int NP>
__device__ __forceinline__ void row_rstd(const float* ssp, int rbase, float invn, int fq, int lane, float (&rs)[2][4]) {
    float v[2];
#pragma unroll
    for (int ai = 0; ai < 2; ++ai) {
        const float* p = ssp + (size_t)(rbase + ai * 128 + fq * 16) * NP; float s;
        if constexpr (NP == 1) { s = p[0]; }
        else { s = 0.f;
#pragma unroll
            for (int q = 0; q < NP / 4; ++q) { const f32x4 t = *(const f32x4*)(p + 4 * q); s += (t[0] + t[1]) + (t[2] + t[3]); } }
        v[ai] = rsqrtf(s * invn + EPS);
    }
#pragma unroll
    for (int ai = 0; ai < 2; ++ai) {
        const unsigned x = __builtin_bit_cast(unsigned, v[ai]);
        auto s16 = __builtin_amdgcn_permlane16_swap(x, x, false, false); const unsigned e = s16[0], o = s16[1];
        auto se = __builtin_amdgcn_permlane32_swap(e, e, false, false); const unsigned e0 = se[0], e2 = se[1];
        auto so = __builtin_amdgcn_permlane32_swap(o, o, false, false); const unsigned o1 = so[0], o3 = so[1];
        rs[ai][0] = __builtin_bit_cast(float, e0); rs[ai][1] = __builtin_bit_cast(float, o1); rs[ai][2] = __builtin_bit_cast(float, e2); rs[ai][3] = __builtin_bit_cast(float, o3); }
    (void)lane;
}

struct EpiSwiGLU {
    static constexpr bool PERM = true, AFTER_DRAIN = false, MID = false;
    bf16_t* ACT; const float* ssp; int np; const float* bias;
    __device__ __forceinline__ void operator()(const f32x4 (&acc)[2][2][4][2], const Unit& u, int wr, int wc, int fr, int fq) const {
        const int lane = fr + 16 * fq, rl0 = u.pm * BM + wr * 64 + fr, mi = mod_index(u.pm);
        float rs[2][4];
        if (np == 1) row_rstd<1>(ssp, rl0, 1.f / DM, fq, lane, rs); else row_rstd<16>(ssp, rl0, 1.f / DM, fq, lane, rs);
        const float* bp = bias + (size_t)mi * FF2 + u.pn * BM + wc * 32 + 8 * fq;
        f32x4 bg[2], bu[2];
#pragma unroll
        for (int n = 0; n < 2; ++n) { bg[n] = *(const f32x4*)(bp + 4 * n); bu[n] = *(const f32x4*)(bp + HALF + 4 * n); }
#pragma unroll
        for (int ai = 0; ai < 2; ++ai) if (u.half != 2 - ai)
#pragma unroll
            for (int m = 0; m < 4; ++m) { const float r = rs[ai][m]; bf16_t* op = ACT + (unsigned)((rl0 + ai * HALF + m * 16) * FF + u.pn * HALF + wc * 32 + 8 * fq);
                f32x4 a[2];
#pragma unroll
                for (int n = 0; n < 2; ++n) { const f32x4 zg = acc[ai][0][m][n] * r + bg[n], zu = acc[ai][1][m][n] * r + bu[n];
#pragma unroll
                    for (int i = 0; i < 4; ++i) a[n][i] = silu_f(zg[i]) * zu[i]; }
                *(u32x4*)op = pack8(a[0], a[1]); }
    }
};

struct EpiResid {
    static constexpr bool PERM = true, AFTER_DRAIN = false, MID = false;
    const float* csb;
    const float* gate; const float* cs; int cs_stride; bf16_t* XS; float* ssp; int prow0;
    __device__ __forceinline__ void operator()(const f32x4 (&acc)[2][2][4][2], const Unit& u, int wr, int wc, int fr, int fq) const {
        const int gpm = prow0 + u.pm, mi = mod_index(gpm), grow0 = gpm * BM + wr * 64 + fr, c0 = u.pn * BM + wc * 32 + 8 * fq;
#pragma unroll
        for (int ai = 0; ai < 2; ++ai) if (u.half != 2 - ai) { float s[4] = {0.f, 0.f, 0.f, 0.f};
#pragma unroll
            for (int bj = 0; bj < 2; ++bj) {
                u32x4 w[4]; f32x4 gvb[2], cvb[2], ivb[2];
#pragma unroll
                for (int m = 0; m < 4; ++m) w[m] = *(const u32x4*)(XS + (unsigned)((grow0 + ai * HALF + m * 16) * DM + c0 + bj * HALF));
#pragma unroll
                for (int n = 0; n < 2; ++n) { gvb[n] = *(const f32x4*)(gate + mi * DM + c0 + bj * HALF + 4 * n); cvb[n] = *(const f32x4*)(cs + mi * cs_stride + c0 + bj * HALF + 4 * n);
                    ivb[n] = *(const f32x4*)(csb + mi * DM + c0 + bj * HALF + 4 * n);
#pragma unroll
                    for (int i = 0; i < 4; ++i) ivb[n][i] = ivb[n][i] == 0.f ? 0.f : __builtin_amdgcn_rcpf(ivb[n][i]); }
#pragma unroll
                for (int m = 0; m < 4; ++m) { const unsigned off = (unsigned)((grow0 + ai * HALF + m * 16) * DM + c0 + bj * HALF);
                    const f32x4 x0 = (f32x4){bf_lo(w[m][0]), bf_hi(w[m][0]), bf_lo(w[m][1]), bf_hi(w[m][1])} * ivb[0] + gvb[0] * acc[ai][bj][m][0];
                    const f32x4 x1 = (f32x4){bf_lo(w[m][2]), bf_hi(w[m][2]), bf_lo(w[m][3]), bf_hi(w[m][3])} * ivb[1] + gvb[1] * acc[ai][bj][m][1];
                    s[m] += dot4(x0) + dot4(x1);
                    *(u32x4*)(XS + off) = pack8(x0 * cvb[0], x1 * cvb[1]); }
                asm volatile("" ::: "memory");
            }
#pragma unroll
            for (int m = 0; m < 4; ++m) { float t = s[m]; t = add_xor16(t); t = add_xor32(t);
                if (fq == 0) ssp[(unsigned)((grow0 + ai * HALF + m * 16) * 16 + 4 * u.pn + wc)] = t; }
        }
    }
};

struct EpiWin {
    static constexpr bool PERM = true, AFTER_DRAIN = false, MID = false;
    const float* ssp2; const float* bias; bf16_t* OAB; bf16_t* QL_; bf16_t* CKV_; bf16_t* KR_; float* SSV_; float* SSQ_; float* SSC_; float* nckv; float* nkr; const float* rope; int chunk; long set2_bytes, ss2_bytes; int pn0;
    __device__ __forceinline__ void operator()(const f32x4 (&acc)[2][2][4][2], const Unit& u, int wr, int wc, int fr, int fq) const {
        const bool set2 = u.pm >= 32; const int pml = u.pm & 31;
        const int lane = fr + 16 * fq, rlo0 = u.pm * BM + wr * 64 + fr, rl0 = pml * BM + wr * 64 + fr, gpm = chunk * 32 + u.pm, mi = mod_index(gpm), pn = u.pn + pn0, c0 = wc * 32 + 8 * fq;
        const int kr0 = (chunk == 0 ? pml : 17 * (pml >> 4) + 1 + (pml & 15)) * BM + wr * 64 + fr;
        bf16_t* QL = (bf16_t*)((char*)QL_ + (set2 ? set2_bytes : 0)); bf16_t* CKV = (bf16_t*)((char*)CKV_ + (set2 ? set2_bytes : 0)); bf16_t* KR = (bf16_t*)((char*)KR_ + (set2 ? set2_bytes : 0));
        float* SSV = (float*)((char*)SSV_ + (set2 ? ss2_bytes : 0)); float* SSQ = (float*)((char*)SSQ_ + (set2 ? ss2_bytes : 0)); float* SSC = (float*)((char*)SSC_ + (set2 ? ss2_bytes : 0));
        float rs[2][4]; row_rstd<16>(ssp2, gpm * BM + wr * 64 + fr, 1.f / DM, fq, lane, rs);
        const float* bp = bias + (size_t)mi * NIN + pn * BM + c0;
        f32x4 bv[2][2];
#pragma unroll
        for (int bj = 0; bj < 2; ++bj)
#pragma unroll
            for (int n = 0; n < 2; ++n) bv[bj][n] = *(const f32x4*)(bp + bj * HALF + 4 * n);
        if (pn < 8) {
            bf16_t* dst = OAB + (pn < 4 ? pn * BM : DM + (pn - 4) * BM) + c0;
#pragma unroll
            for (int ai = 0; ai < 2; ++ai) if (u.half != 2 - ai)
#pragma unroll
                for (int m = 0; m < 4; ++m) { const int row = rl0 + ai * HALF + m * 16, rowo = rlo0 + ai * HALF + m * 16; const float r = rs[ai][m]; float s = 0.f;
#pragma unroll
                    for (int bj = 0; bj < 2; ++bj) { const f32x4 z0 = acc[ai][bj][m][0] * r + bv[bj][0], z1 = acc[ai][bj][m][1] * r + bv[bj][1]; s += dot4(z0) + dot4(z1);
                        *(u32x4*)(dst + (unsigned)(rowo * 2048 + bj * HALF)) = pack8(z0, z1); }
                    if (pn >= 4) { s = add_xor16(s); s = add_xor32(s); if (fq == 0) SSV[(size_t)row * 16 + 4 * (pn - 4) + wc] = s; } }
        } else if (pn == 8) {
#pragma unroll
            for (int ai = 0; ai < 2; ++ai) if (u.half != 2 - ai)
#pragma unroll
                for (int m = 0; m < 4; ++m) { const int row = rl0 + ai * HALF + m * 16; const float r = rs[ai][m]; float s = 0.f;
#pragma unroll
                    for (int bj = 0; bj < 2; ++bj) { const f32x4 z0 = acc[ai][bj][m][0] * r + bv[bj][0], z1 = acc[ai][bj][m][1] * r + bv[bj][1]; s += dot4(z0) + dot4(z1);
                        *(u32x4*)(QL + (size_t)row * 256 + bj * HALF + c0) = pack8(z0, z1); }
                    s = add_xor16(s); s = add_xor32(s); if (fq == 0) SSQ[(size_t)row * 4 + wc] = s; }
        } else if (pn == 9) {
#pragma unroll
            for (int ai = 0; ai < 2; ++ai) if (u.half != 2 - ai)
#pragma unroll
                for (int m = 0; m < 4; ++m) { const int row = rl0 + ai * HALF + m * 16, krow = kr0 + ai * HALF + m * 16; const float r = rs[ai][m]; float s = 0.f;
#pragma unroll
                    for (int bj = 0; bj < 2; ++bj) { const f32x4 z0 = acc[ai][bj][m][0] * r + bv[bj][0], z1 = acc[ai][bj][m][1] * r + bv[bj][1]; s += dot4(z0) + dot4(z1);
                        *(u32x4*)(CKV + (size_t)krow * 256 + bj * HALF + c0) = pack8(z0, z1);
                        if (chunk == 0) { *(f32x4*)(nckv + (size_t)row * 256 + bj * HALF + c0) = z0; *(f32x4*)(nckv + (size_t)row * 256 + bj * HALF + c0 + 4) = z1; } }
                    s = add_xor16(s); s = add_xor32(s); if (fq == 0) SSC[(size_t)krow * 4 + wc] = s; }
        } else if (wc < 2) {
#pragma unroll
            for (int ai = 0; ai < 2; ++ai) if (u.half != 2 - ai)
#pragma unroll
                for (int m = 0; m < 4; ++m) { const int row = rl0 + ai * HALF + m * 16, krow = kr0 + ai * HALF + m * 16; const float r = rs[ai][m];
                    const f32x4 z0 = acc[ai][0][m][0] * r + bv[0][0], z1 = acc[ai][0][m][1] * r + bv[0][1]; f32x4 o0 = z0, o1 = z1;
                    if (chunk == 0) { *(f32x4*)(nkr + (size_t)row * 64 + 32 * wc + 4 * fq) = z0; *(f32x4*)(nkr + (size_t)row * 64 + 32 * wc + 16 + 4 * fq) = z1; }
                    else { const int t = row & 4095, pos = wc == 0 ? (t >> 6) : (t & 63); const f32x4 cs_ = *(const f32x4*)(rope + pos * 16 + 4 * fq), sn_ = *(const f32x4*)(rope + 1024 + pos * 16 + 4 * fq);
                        o0 = z0 * cs_ - z1 * sn_; o1 = z1 * cs_ + z0 * sn_; }
                    *(u32x4*)(KR + (size_t)krow * 64 + 32 * wc + 8 * fq) = pack8(o0, o1); }
        }
    }
};

struct EpiQ {
    static constexpr bool PERM = true, AFTER_DRAIN = false, MID = false;
    bf16_t* Q; const float* SSQ; const float* rope; int chunk;
    __device__ __forceinline__ void operator()(const f32x4 (&acc)[2][2][4][2], const Unit& u, int wr, int wc, int fr, int fq) const {
        const int lane = fr + 16 * fq, rl0 = u.pm * BM + wr * 64 + fr;
        float rs[2][4]; row_rstd<4>(SSQ, rl0, 1.f / 256.f, fq, lane, rs);
#pragma unroll
        for (int ai = 0; ai < 2; ++ai) if (u.half != 2 - ai)
#pragma unroll
            for (int m = 0; m < 4; ++m) rs[ai][m] *= 0.10411754584f;
#pragma unroll
        for (int bj = 0; bj < 2; ++bj) { const int C32 = u.pn * BM + bj * HALF + wc * 32, w = C32 % 192; const bool rot = (w >= 128) && (chunk > 0); const bool colang = (w >= 160);
#pragma unroll
            for (int ai = 0; ai < 2; ++ai) if (u.half != 2 - ai)
#pragma unroll
                for (int m = 0; m < 4; ++m) { const int row = rl0 + ai * HALF + m * 16; const float r = rs[ai][m];
                    f32x4 z0 = acc[ai][bj][m][0] * r, z1 = acc[ai][bj][m][1] * r;
                    if (rot) { const int t = row & 4095, pos = colang ? (t & 63) : (t >> 6); const f32x4 cs_ = *(const f32x4*)(rope + pos * 16 + 4 * fq), sn_ = *(const f32x4*)(rope + 1024 + pos * 16 + 4 * fq);
                        const f32x4 o0 = z0 * cs_ - z1 * sn_, o1 = z1 * cs_ + z0 * sn_; z0 = o0; z1 = o1; }
                    *(u32x4*)(Q + (unsigned)(row * NQ + C32 + 8 * fq)) = pack8(z0, z1); } }
    }
};

struct EpiKV {
    static constexpr bool PERM = true, AFTER_DRAIN = false, MID = false;
    bf16_t* KN; bf16_t* V; const float* SSC; int chunk;
    __device__ __forceinline__ void operator()(const f32x4 (&acc)[2][2][4][2], const Unit& u, int wr, int wc, int fr, int fq) const {
        const int lane = fr + 16 * fq, rl0 = u.pm * BM + wr * 64 + fr, c0 = wc * 32 + 8 * fq;
        float rs[2][4]; row_rstd<4>(SSC, rl0, 1.f / 256.f, fq, lane, rs);
        const bool cache = (chunk > 0) && (u.pm % 17 == 0);
        bf16_t* dst = (u.pn < 4 ? KN + u.pn * BM : V + (u.pn - 4) * BM) + c0;
#pragma unroll
        for (int ai = 0; ai < 2; ++ai) if (u.half != 2 - ai)
#pragma unroll
            for (int m = 0; m < 4; ++m) { const int row = rl0 + ai * HALF + m * 16; const float r = cache ? 1.f : rs[ai][m];
#pragma unroll
                for (int bj = 0; bj < 2; ++bj) *(u32x4*)(dst + (unsigned)(row * DM + bj * HALF)) = pack8(acc[ai][bj][m][0] * r, acc[ai][bj][m][1] * r); }
    }
};

struct EpiGate {
    static constexpr bool PERM = true, AFTER_DRAIN = false, MID = false;
    const float* ssp2; const float* bias; bf16_t* G; int prow0;
    __device__ __forceinline__ void operator()(const f32x4 (&acc)[2][2][4][2], const Unit& u, int wr, int wc, int fr, int fq) const {
        const int lane = fr + 16 * fq, rl0 = u.pm * BM + wr * 64 + fr, gpm = prow0 + u.pm, mi = mod_index(gpm), c0 = u.pn * BM + wc * 32 + 8 * fq;
        float rs[2][4]; row_rstd<16>(ssp2, gpm * BM + wr * 64 + fr, 1.f / DM, fq, lane, rs);
        const float* bp = bias + (size_t)mi * NIN + 2816 + c0;
        f32x4 bv[2][2];
#pragma unroll
        for (int bj = 0; bj < 2; ++bj)
#pragma unroll
            for (int n = 0; n < 2; ++n) bv[bj][n] = *(const f32x4*)(bp + bj * HALF + 4 * n);
#pragma unroll
        for (int ai = 0; ai < 2; ++ai) if (u.half != 2 - ai)
#pragma unroll
            for (int m = 0; m < 4; ++m) { const int row = rl0 + ai * HALF + m * 16; const float r = rs[ai][m];
#pragma unroll
                for (int bj = 0; bj < 2; ++bj) { f32x4 z0 = acc[ai][bj][m][0] * r + bv[bj][0], z1 = acc[ai][bj][m][1] * r + bv[bj][1];
#pragma unroll
                    for (int i = 0; i < 4; ++i) { z0[i] = sigm_f(z0[i]); z1[i] = sigm_f(z1[i]); }
                    *(u32x4*)(G + (unsigned)(row * 2048 + bj * HALF + c0)) = pack8(z0, z1); } }
    }
};

struct EpiMerge {
    static constexpr bool PERM = true, AFTER_DRAIN = false, MID = true;
    bf16_t* G;
    __device__ __forceinline__ void mid(f32x4 (&acc)[2][2][4][2], const Unit& u, int wr, int wc, int fr, int fq) const {
        const int rl0 = u.pm * BM + wr * 64 + fr, c0 = u.pn * BM + wc * 32 + 8 * fq;
#pragma unroll
        for (int ai = 0; ai < 2; ++ai) if (u.half != 2 - ai)
#pragma unroll
            for (int mh = 0; mh < 2; ++mh) { u32x4 ga[2][2], gb[2][2];
#pragma unroll
                for (int m2 = 0; m2 < 2; ++m2) { const bf16_t* gp = G + (unsigned)((rl0 + ai * HALF + (2 * mh + m2) * 16) * 2048 + c0);
#pragma unroll
                    for (int bj = 0; bj < 2; ++bj) { ga[m2][bj] = *(const u32x4*)(gp + bj * HALF); gb[m2][bj] = *(const u32x4*)(gp + DM + bj * HALF); } }
#pragma unroll
                for (int m2 = 0; m2 < 2; ++m2)
#pragma unroll
                    for (int bj = 0; bj < 2; ++bj)
#pragma unroll
                        for (int k = 0; k < 4; ++k) { const int m = 2 * mh + m2;
                            const float r0 = bf_lo(ga[m2][bj][k]) * __builtin_amdgcn_rcpf(fmaxf(bf_lo(gb[m2][bj][k]), 1e-30f)), r1 = bf_hi(ga[m2][bj][k]) * __builtin_amdgcn_rcpf(fmaxf(bf_hi(gb[m2][bj][k]), 1e-30f));
                            acc[ai][bj][m][k >> 1][(k & 1) * 2] *= r0; acc[ai][bj][m][k >> 1][(k & 1) * 2 + 1] *= r1; }
                asm volatile("" ::: "memory"); }
    }
    __device__ __forceinline__ void operator()(const f32x4 (&acc)[2][2][4][2], const Unit& u, int wr, int wc, int fr, int fq) const {
        const int rl0 = u.pm * BM + wr * 64 + fr, c0 = u.pn * BM + wc * 32 + 8 * fq;
#pragma unroll
        for (int ai = 0; ai < 2; ++ai) if (u.half != 2 - ai) { u32x4 gb[4][2];
#pragma unroll
            for (int m = 0; m < 4; ++m)
#pragma unroll
                for (int bj = 0; bj < 2; ++bj) gb[m][bj] = *(const u32x4*)(G + (size_t)(rl0 + ai * HALF + m * 16) * 2048 + DM + c0 + bj * HALF);
#pragma unroll
            for (int m = 0; m < 4; ++m) { const size_t row = (size_t)(rl0 + ai * HALF + m * 16);
#pragma unroll
                for (int bj = 0; bj < 2; ++bj) { const u32x4 g = gb[m][bj];
                    const f32x4 g0 = {bf_lo(g[0]), bf_hi(g[0]), bf_lo(g[1]), bf_hi(g[1])}, g1 = {bf_lo(g[2]), bf_hi(g[2]), bf_lo(g[3]), bf_hi(g[3])};
                    *(u32x4*)(G + row * 2048 + c0 + bj * HALF) = pack8(acc[ai][bj][m][0] * g0, acc[ai][bj][m][1] * g1); } }
            asm volatile("" ::: "memory"); }
    }
};

template <class Epi, class Sched, bool ALIGN_EPI = false, bool SP2 = false>
__device__ __forceinline__ void gemm_phase(PG8_LAS unsigned char* lds, const Gemm g, const Sched& S, const Epi& E, const int wave_s) {
    int wid_ = wave_s; asm volatile("" : "+s"(wid_));
    const int lane = fresh_lane(), wid = wid_, tid = wid * 64 + lane, wr = wid >> 2, wc = wid & 3, fr = lane & 15, fq = lane >> 4;
    const int K = g.K, nt = K / BK, LDA = g.lda;
    unsigned voffA[2], voffB[2];
#pragma unroll
    for (int i = 0; i < 2; ++i) { int R, C; stage_rc(tid * 16 + i * 8192, R, C); const int Rb = Epi::PERM ? ((R & ~31) + perm32(R & 31)) : R;
        voffA[i] = (unsigned)(R * LDA + C) * 2u; voffB[i] = (unsigned)(Rb * K + C) * 2u; }
    const size_t kstep = (size_t)(BK * 2);
    const size_t hstepB = (size_t)HALF * K * 2, tstepB = 2 * hstepB;
    const size_t hstepA = (size_t)HALF * LDA * 2, tstepA = 2 * hstepA;
    const unsigned ldsw = (unsigned)wid * 1024u;
    const int aoff = lds_byte(wr * 64 + fr, fq * 8), boff = lds_byte(wc * 32 + fr, fq * 8);
#define PG8_SA(b, h) (((b) * 2 + (h)) * HTB)
#define PG8_SB(b, h) ((4 + (b) * 2 + (h)) * HTB)
#define PG8_STAGE(bufoff, gbase, voff) do { _Pragma("unroll") for (int _i = 0; _i < 2; ++_i) \
        __builtin_amdgcn_global_load_lds((const unsigned*)((const char*)(gbase) + (voff)[_i]), (PG8_LAS unsigned*)(lds + (bufoff) + ldsw + _i * 8192), 16, 0, 0); } while (0)
#define PG8_LDA(dst, b, h) do { _Pragma("unroll") for (int m = 0; m < 4; ++m) _Pragma("unroll") for (int k = 0; k < 2; ++k) dst[m][k] = *(const PG8_LAS bf16x8*)(lds + PG8_SA(b, h) + aoff + m * 2048 + k * 1024); } while (0)
#define PG8_LDB(dst, b, h) do { _Pragma("unroll") for (int n = 0; n < 2; ++n) _Pragma("unroll") for (int k = 0; k < 2; ++k) dst[n][k] = *(const PG8_LAS bf16x8*)(lds + PG8_SB(b, h) + boff + n * 2048 + k * 1024); } while (0)
#define PG8_MMA(ai, bj, At, Bt) do { __builtin_amdgcn_s_setprio(1); _Pragma("unroll") for (int m = 0; m < 4; ++m) _Pragma("unroll") for (int n = 0; n < 2; ++n) _Pragma("unroll") for (int k = 0; k < 2; ++k) \
        acc[ai][bj][m][n] = __builtin_amdgcn_mfma_f32_16x16x32_bf16(Bt[n][k], At[m][k], acc[ai][bj][m][n], 0, 0, 0); __builtin_amdgcn_s_setprio(0); } while (0)
#define PG8_WAIT_V(n) asm volatile("s_waitcnt vmcnt(" #n ")" ::: "memory")
#define PG8_WAIT_L(n) asm volatile("s_waitcnt lgkmcnt(" #n ")" ::: "memory")
#define PG8_BAR __builtin_amdgcn_s_barrier()
#define PG8_SCHED __builtin_amdgcn_sched_barrier(0)
    Unit cur, nxt; int ui = 0;
    if (!S.next(0, cur)) return;
    f32x4 acc[2][2][4][2];
#pragma unroll
    for (int a = 0; a < 2; ++a)
#pragma unroll
        for (int b = 0; b < 2; ++b)
#pragma unroll
            for (int m = 0; m < 4; ++m)
#pragma unroll
                for (int n = 0; n < 2; ++n) acc[a][b][m][n] = (f32x4){0.f, 0.f, 0.f, 0.f};
    bf16x8 At[4][2], B0[2][2], B1[2][2];
    const char* cA = (const char*)g.A + (size_t)cur.pm * tstepA; const char* cB = (const char*)g.Bt + (size_t)cur.pn * tstepB;
    S.a_ready(cur);
    if constexpr (SP2) {
        PG8_STAGE(PG8_SB(0, 0), cB, voffB); PG8_STAGE(PG8_SB(0, 1), cB + hstepB, voffB); PG8_STAGE(PG8_SA(0, 0), cA, voffA); PG8_STAGE(PG8_SA(0, 1), cA + hstepA, voffA);
        if (wr == 1) PG8_BAR;
        PG8_WAIT_V(2); PG8_BAR;
        PG8_STAGE(PG8_SB(1, 0), cB + kstep, voffB); PG8_STAGE(PG8_SA(1, 0), cA + kstep, voffA); PG8_STAGE(PG8_SB(1, 1), cB + hstepB + kstep, voffB);
        PG8_WAIT_V(6); PG8_BAR;
    } else {
        PG8_STAGE(PG8_SB(0, 0), cB, voffB); PG8_STAGE(PG8_SA(0, 0), cA, voffA); PG8_STAGE(PG8_SB(0, 1), cB + hstepB, voffB); PG8_STAGE(PG8_SA(0, 1), cA + hstepA, voffA);
        if (wr == 1) PG8_BAR;
        PG8_WAIT_V(4); PG8_BAR;
        PG8_STAGE(PG8_SB(1, 0), cB + kstep, voffB); PG8_STAGE(PG8_SA(1, 0), cA + kstep, voffA); PG8_STAGE(PG8_SB(1, 1), cB + hstepB + kstep, voffB);
        PG8_WAIT_V(6); PG8_BAR;
    }
    for (;;) {
        const bool has_next = S.next(ui + 1, nxt);
        const char* nA = has_next ? (const char*)g.A + (size_t)nxt.pm * tstepA : cA; const char* nB = has_next ? (const char*)g.Bt + (size_t)nxt.pn * tstepB : cB;
        const bool do0 = cur.half != 2, do1 = cur.half != 1;
#pragma unroll 1
        for (int t = 0; t < nt; t += 2) {
            if constexpr (Epi::MID) { if (__builtin_expect(t == (nt >> 1), 0)) { const int l2 = fresh_lane(); E.mid(acc, cur, wr, wc, l2 & 15, l2 >> 4); } }
            const bool last = (t == nt - 2);
            const char* a1 = cA + (size_t)(t + 1) * kstep;
            const char* a2 = last ? nA : cA + (size_t)(t + 2) * kstep; const char* b2 = last ? nB : cB + (size_t)(t + 2) * kstep;
            const char* a3 = a2 + kstep; const char* b3 = b2 + kstep;
            if (last && has_next) S.a_ready(nxt);
            if constexpr (SP2) {
            PG8_LDB(B0, 0, 0); PG8_LDB(B1, 0, 1); PG8_SCHED; if (do0) PG8_LDA(At, 0, 0); PG8_STAGE(PG8_SA(1, 1), a1 + hstepA, voffA);
            PG8_WAIT_V(8); PG8_WAIT_L(0); PG8_BAR; if (do0) { PG8_MMA(0, 0, At, B0); PG8_MMA(0, 1, At, B1); } PG8_BAR; PG8_SCHED;
            if (do1) PG8_LDA(At, 0, 1); PG8_STAGE(PG8_SB(0, 0), b2, voffB); PG8_STAGE(PG8_SB(0, 1), b2 + hstepB, voffB); PG8_STAGE(PG8_SA(0, 0), a2, voffA);
            PG8_WAIT_V(8); PG8_WAIT_L(0); PG8_BAR; if (do1) { PG8_MMA(1, 0, At, B0); PG8_MMA(1, 1, At, B1); } PG8_BAR; PG8_SCHED;
            PG8_LDB(B0, 1, 0); PG8_LDB(B1, 1, 1); PG8_SCHED; if (do0) PG8_LDA(At, 1, 0); PG8_STAGE(PG8_SA(0, 1), a2 + hstepA, voffA);
            PG8_WAIT_V(8); PG8_WAIT_L(0); PG8_BAR; if (do0) { PG8_MMA(0, 0, At, B0); PG8_MMA(0, 1, At, B1); } PG8_BAR; PG8_SCHED;
            if (do1) PG8_LDA(At, 1, 1); PG8_STAGE(PG8_SB(1, 0), b3, voffB); PG8_STAGE(PG8_SB(1, 1), b3 + hstepB, voffB); PG8_STAGE(PG8_SA(1, 0), a3, voffA);
            PG8_WAIT_V(8); PG8_WAIT_L(0); PG8_BAR; if (do1) { PG8_MMA(1, 0, At, B0); PG8_MMA(1, 1, At, B1); } PG8_BAR; PG8_SCHED;
            } else {
            PG8_LDB(B0, 0, 0); PG8_SCHED; PG8_LDA(At, 0, 0); PG8_STAGE(PG8_SA(1, 1), a1 + hstepA, voffA);
            PG8_WAIT_L(8); PG8_BAR; PG8_WAIT_L(0); PG8_MMA(0, 0, At, B0); PG8_BAR; PG8_SCHED;
            PG8_LDB(B1, 0, 1); PG8_STAGE(PG8_SB(0, 0), b2, voffB);
            PG8_BAR; PG8_WAIT_L(0); PG8_MMA(0, 1, At, B1); PG8_BAR;
            PG8_LDA(At, 0, 1); PG8_STAGE(PG8_SA(0, 0), a2, voffA);
            PG8_BAR; PG8_WAIT_L(0); PG8_MMA(1, 0, At, B0); PG8_BAR; PG8_SCHED;
            PG8_STAGE(PG8_SB(0, 1), b2 + hstepB, voffB);
            PG8_WAIT_V(6); PG8_BAR; PG8_MMA(1, 1, At, B1); PG8_BAR;
            PG8_LDB(B0, 1, 0); PG8_SCHED; PG8_LDA(At, 1, 0); PG8_STAGE(PG8_SA(0, 1), a2 + hstepA, voffA);
            PG8_WAIT_L(8); PG8_BAR; PG8_WAIT_L(0); PG8_MMA(0, 0, At, B0); PG8_BAR; PG8_SCHED;
            PG8_LDB(B1, 1, 1); PG8_STAGE(PG8_SB(1, 0), b3, voffB);
            PG8_BAR; PG8_WAIT_L(0); PG8_MMA(0, 1, At, B1); PG8_BAR;
            PG8_LDA(At, 1, 1); PG8_STAGE(PG8_SA(1, 0), a3, voffA);
            PG8_BAR; PG8_WAIT_L(0); PG8_MMA(1, 0, At, B0); PG8_BAR; PG8_SCHED;
            PG8_STAGE(PG8_SB(1, 1), b3 + hstepB, voffB);
            PG8_WAIT_V(6); PG8_BAR; PG8_MMA(1, 1, At, B1); PG8_BAR;
            }
        }
        if constexpr (ALIGN_EPI) { if (wr == 0) PG8_BAR; }
        if constexpr (!Epi::AFTER_DRAIN) { const int l2 = fresh_lane(); E(acc, cur, wr, wc, l2 & 15, l2 >> 4); S.done(cur); }
        if (!has_next) break;
#pragma unroll
        for (int a = 0; a < 2; ++a)
#pragma unroll
            for (int b = 0; b < 2; ++b)
#pragma unroll
                for (int m = 0; m < 4; ++m)
#pragma unroll
                    for (int n = 0; n < 2; ++n) acc[a][b][m][n] = (f32x4){0.f, 0.f, 0.f, 0.f};
        cur = nxt; cA = nA; cB = nB; ++ui;
        if constexpr (ALIGN_EPI) { if (wr == 1) PG8_BAR; }
    }
    PG8_WAIT_V(0);
    if constexpr (!ALIGN_EPI) { if (wr == 0) PG8_BAR; }
    PG8_BAR;
    if constexpr (Epi::AFTER_DRAIN) { E.fused(acc, cur, wr, wc, fr, fq, lds, wid, lane); S.done(cur); }
#undef PG8_SA
#undef PG8_SB
#undef PG8_STAGE
#undef PG8_LDA
#undef PG8_LDB
#undef PG8_MMA
#undef PG8_WAIT_V
#undef PG8_WAIT_L
#undef PG8_BAR
#undef PG8_SCHED
}
}
namespace att {
typedef unsigned short bf16_t;
using bf16x8 = __attribute__((ext_vector_type(8))) short;
using s16x4  = __attribute__((ext_vector_type(4))) short;
using f32x16 = __attribute__((ext_vector_type(16))) float;
using u32x4  = __attribute__((ext_vector_type(4))) unsigned;
constexpr int NW = 8, QBLK = 32, KVBLK = 64;
constexpr int LDQ = 1536, LDKN = 1024, LDKR = 64, LDV = 1024, LDO = 2048;
constexpr float SCALE = 0.072168783648703220f;
constexpr float THR = 8.f;
constexpr int SHM_V = KVBLK * 128 * 2, SHM_KN = KVBLK * 128 * 2, SHM_KR = KVBLK * 64 * 2;
constexpr int STG = SHM_V + SHM_KN + SHM_KR, OFF_V = 0, OFF_KN = SHM_V, OFF_KR = SHM_V + SHM_KN, OFF_WS = 3 * STG, SHM_ATTN = OFF_WS + NW * 64 * 4;
typedef __attribute__((address_space(3))) unsigned lds_u32;
#define KSWZ(row, colB) ((row) * 256 + ((colB) ^ (((row) & 15) << 4)))
#define KRSWZ(row, colB) ((row) * 128 + ((colB) ^ ((((row) >> 1) & 7) << 4)))
#define SBAR() __builtin_amdgcn_sched_barrier(0)
__device__ __forceinline__ int crow(int r, int hi) { return (r & 3) + 8 * (r >> 2) + 4 * hi; }
typedef float f32x2a_t __attribute__((ext_vector_type(2))); typedef __bf16 bf16x2a_t __attribute__((ext_vector_type(2)));
__device__ __forceinline__ unsigned cvtpk(float lo, float hi) { f32x2a_t v = {lo, hi}; bf16x2a_t b = __builtin_convertvector(v, bf16x2a_t); return __builtin_bit_cast(unsigned, b); }

constexpr float THRL = THR * 1.4426950408889634f;
#define MX3(a, b, c) fmaxf(fmaxf((a), (b)), (c))
__device__ __forceinline__ void partialSM(f32x16& p0, f32x16& p1, float& m_reg, float& alpha) {
  float a = MX3(p0[0], p0[1], p1[0]), b = MX3(p0[2], p0[3], p1[1]); a = MX3(a, p1[2], p1[3]);
#pragma unroll
  for (int r = 4; r < 16; r += 4) { a = MX3(a, p0[r], p0[r + 1]); b = MX3(b, p0[r + 2], p0[r + 3]); a = MX3(a, p1[r], p1[r + 1]); b = MX3(b, p1[r + 2], p1[r + 3]); }
  float pmax = fmaxf(a, b);
  { auto rr = __builtin_amdgcn_permlane32_swap(__float_as_uint(pmax), __float_as_uint(pmax), false, false);
    pmax = fmaxf(__uint_as_float(rr[0]), __uint_as_float(rr[1])); }
  if (__builtin_expect(__all(pmax <= THRL), 1)) { alpha = 1.f; }
  else { const float d = fmaxf(pmax, 0.f); for (int r = 0; r < 16; ++r) { p0[r] -= d; p1[r] -= d; } m_reg += d; alpha = __builtin_amdgcn_exp2f(-d); }
  for (int r = 0; r < 16; ++r) p0[r] = __builtin_amdgcn_exp2f(p0[r]);
}
#undef MX3
__device__ __forceinline__ void finishSM(f32x16& p0, f32x16& p1, float alpha, float& l_reg, bf16x8& pa0, bf16x8& pa1, bf16x8& pa2, bf16x8& pa3) {
  for (int r = 0; r < 16; ++r) p1[r] = __builtin_amdgcn_exp2f(p1[r]);
  float ps = 0; for (int r = 0; r < 16; ++r) ps += p0[r]; for (int r = 0; r < 16; ++r) ps += p1[r];
  { auto rr = __builtin_amdgcn_permlane32_swap(__float_as_uint(ps), __float_as_uint(ps), false, false);
    ps = __uint_as_float(rr[0]) + __uint_as_float(rr[1]); }
  l_reg = l_reg * alpha + ps;
#define PK4(P, BASE, OUT) do { unsigned a0 = cvtpk(P[BASE + 0], P[BASE + 1]), a1 = cvtpk(P[BASE + 2], P[BASE + 3]);   \
    unsigned b0 = cvtpk(P[BASE + 4], P[BASE + 5]), b1 = cvtpk(P[BASE + 6], P[BASE + 7]);                              \
    auto r0 = __builtin_amdgcn_permlane32_swap(a0, b0, false, false); auto r1 = __builtin_amdgcn_permlane32_swap(a1, b1, false, false); \
    u32x4 w = {r0[0], r1[0], r0[1], r1[1]}; OUT = *reinterpret_cast<bf16x8*>(&w); } while (0)
  PK4(p0, 0, pa0); PK4(p0, 8, pa1); PK4(p1, 0, pa2); PK4(p1, 8, pa3);
#undef PK4
}
__device__ __forceinline__ void qkt(f32x16& p0, f32x16& p1, const char* KNs, const char* KRs, const bf16x8* qr, int r32, int hi, float negm) {
#pragma unroll
  for (int r = 0; r < 16; ++r) { p0[r] = negm; p1[r] = negm; }
#pragma unroll
  for (int d0 = 0; d0 < 8; ++d0) { int cb = (d0 * 16 + hi * 8) * 2;
    bf16x8 b0 = *reinterpret_cast<const bf16x8*>(KNs + KSWZ(r32, cb));
    bf16x8 b1 = *reinterpret_cast<const bf16x8*>(KNs + KSWZ(32 + r32, cb));
    p0 = __builtin_amdgcn_mfma_f32_32x32x16_bf16(b0, qr[d0], p0, 0, 0, 0);
    p1 = __builtin_amdgcn_mfma_f32_32x32x16_bf16(b1, qr[d0], p1, 0, 0, 0); }
#pragma unroll
  for (int d0 = 0; d0 < 4; ++d0) { int cb = (d0 * 16 + hi * 8) * 2;
    bf16x8 b0 = *reinterpret_cast<const bf16x8*>(KRs + KRSWZ(r32, cb));
    bf16x8 b1 = *reinterpret_cast<const bf16x8*>(KRs + KRSWZ(32 + r32, cb));
    p0 = __builtin_amdgcn_mfma_f32_32x32x16_bf16(b0, qr[8 + d0], p0, 0, 0, 0);
    p1 = __builtin_amdgcn_mfma_f32_32x32x16_bf16(b1, qr[8 + d0], p1, 0, 0, 0); }
}
__device__ __forceinline__ int v_st(int k, int c) { const int kk = (k & ~0xC) | ((k & 4) << 1) | ((k & 8) >> 1); return ((kk >> 3) * 4 + (c >> 5)) * 512 + ((kk & 7) * 32 + (c & 31)) * 2; }
__device__ __forceinline__ int v_rd_base(int lane) { return ((lane & 3) << 3) | (((lane >> 2) & 3) << 6) | (((lane >> 4) & 1) << 5) | (((lane >> 5) & 1) << 8); }
constexpr int v_rd_off(int d0, int ks, int half) { return d0 * 512 + ks * 4096 + half * 2048; }
template <int OFF> __device__ __forceinline__ s16x4 tr_read(int vb) {
  s16x4 r; asm volatile("ds_read_b64_tr_b16 %0, %1 offset:%2" : "=&v"(r) : "v"(vb), "i"(OFF) : "memory"); return r;
}
template <int D0> __device__ __forceinline__ void pv_one(f32x16& od, int vb, bf16x8 pa0, bf16x8 pa1, bf16x8 pa2, bf16x8 pa3) {
  const s16x4 l0 = tr_read<v_rd_off(D0, 0, 0)>(vb), h0 = tr_read<v_rd_off(D0, 0, 1)>(vb), l1 = tr_read<v_rd_off(D0, 1, 0)>(vb), h1 = tr_read<v_rd_off(D0, 1, 1)>(vb);
  const s16x4 l2 = tr_read<v_rd_off(D0, 2, 0)>(vb), h2 = tr_read<v_rd_off(D0, 2, 1)>(vb), l3 = tr_read<v_rd_off(D0, 3, 0)>(vb), h3 = tr_read<v_rd_off(D0, 3, 1)>(vb);
  asm volatile("s_waitcnt lgkmcnt(0)" ::: "memory"); SBAR();
#define PK(L, H) (bf16x8){L[0], L[1], L[2], L[3], H[0], H[1], H[2], H[3]}
  od = __builtin_amdgcn_mfma_f32_32x32x16_bf16(pa0, PK(l0, h0), od, 0, 0, 0);
  od = __builtin_amdgcn_mfma_f32_32x32x16_bf16(pa1, PK(l1, h1), od, 0, 0, 0);
  od = __builtin_amdgcn_mfma_f32_32x32x16_bf16(pa2, PK(l2, h2), od, 0, 0, 0);
  od = __builtin_amdgcn_mfma_f32_32x32x16_bf16(pa3, PK(l3, h3), od, 0, 0, 0);
#undef PK
}
__device__ __forceinline__ void pv_d0(f32x16* o, int vb, bf16x8 pa0, bf16x8 pa1, bf16x8 pa2, bf16x8 pa3) {
  pv_one<0>(o[0], vb, pa0, pa1, pa2, pa3); pv_one<1>(o[1], vb, pa0, pa1, pa2, pa3); pv_one<2>(o[2], vb, pa0, pa1, pa2, pa3); pv_one<3>(o[3], vb, pa0, pa1, pa2, pa3);
}
__device__ __forceinline__ unsigned short f2bf(float f) { unsigned u = __builtin_bit_cast(unsigned, f); return (unsigned short)((u + 0x7fffu + ((u >> 16) & 1u)) >> 16); }

__device__ __forceinline__ void attn_unit(const bf16_t* __restrict__ Qb, const bf16_t* __restrict__ KNh, const bf16_t* __restrict__ KRb, const bf16_t* __restrict__ Vh,
                                          bf16_t* __restrict__ Ob, int seq, char* lds, const int wave_s) {
  int wid_ = wave_s; asm volatile("" : "+s"(wid_));
  const int lane = fresh_lane(), wid = wid_, tid = wid * 64 + lane, r32 = lane & 31, hi = lane >> 5;
  float* ws = (float*)(lds + OFF_WS) + wid * 64; float* li_l = ws; float* al_l = ws + 32;
  float m_reg = 0.f, l_reg = 0; f32x16 o[4] = {}; bf16x8 qr[12];
  const bf16_t* Qw = Qb + (long)(wid * QBLK + r32) * LDQ + hi * 8;
#pragma unroll
  for (int d0 = 0; d0 < 12; ++d0) qr[d0] = *reinterpret_cast<const bf16x8*>(Qw + d0 * 16);
  unsigned voV, voK, voR;
  { const int sub = tid >> 5, within = tid & 31, kk = (sub >> 2) * 8 + (within >> 2), c = (sub & 3) * 32 + (within & 3) * 8, k = (kk & ~0xC) | ((kk & 4) << 1) | ((kk & 8) >> 1);
    voV = (unsigned)(k * LDV + c) * 2u;
    const int row = tid >> 4, slot = tid & 15; voK = (unsigned)(row * LDKN * 2 + ((slot << 4) ^ ((row & 15) << 4)));
    const int rr = tid >> 3, sl = tid & 7; voR = (unsigned)(rr * LDKR * 2 + ((sl << 4) ^ (((rr >> 1) & 7) << 4))); }
  const lds_u32* ldsL_ = (const lds_u32*)(lds); (void)ldsL_;
  const int vb0 = (int)(uintptr_t)lds + OFF_V + v_rd_base(lane);
  const int ldsw = wid * 1024;
#define DMA1(src, dstoff) __builtin_amdgcn_global_load_lds((const unsigned*)(src), (lds_u32*)(lds + (dstoff)), 16, 0, 0)
#define ISSUE(st, k0) do { const char* vb_ = (const char*)Vh + (size_t)(k0) * (LDV * 2); const char* kb_ = (const char*)KNh + (size_t)(k0) * (LDKN * 2); const char* rb_ = (const char*)KRb + (size_t)(k0) * (LDKR * 2); \
    DMA1(kb_ + voK, (st) + OFF_KN + ldsw); DMA1(kb_ + 32 * LDKN * 2 + voK, (st) + OFF_KN + 8192 + ldsw); DMA1(rb_ + voR, (st) + OFF_KR + ldsw); \
    DMA1(vb_ + voV, (st) + OFF_V + ldsw); DMA1(vb_ + 32 * LDV * 2 + voV, (st) + OFF_V + 8192 + ldsw); } while (0)
#define TOP() do { asm volatile("s_waitcnt vmcnt(0) lgkmcnt(0)" ::: "memory"); __builtin_amdgcn_s_barrier(); SBAR(); } while (0)
#define RESC(a) do { if (__any((a) < 1.f)) { if (hi == 0) al_l[r32] = (a); asm volatile("s_waitcnt lgkmcnt(0)" ::: "memory"); \
    for (int d = 0; d < 4; ++d) for (int r = 0; r < 16; ++r) o[d][r] *= al_l[crow(r, hi)]; } } while (0)
#define ROT() do { sV = sK; sK = sN; sN = (sN == 2 * STG) ? 0 : sN + STG; } while (0)
  f32x16 pA0, pA1, pB0, pB1; float alA, alB; bf16x8 pa0, pa1, pa2, pa3; const int NT = seq / KVBLK;
  ISSUE(0, 0); ISSUE(STG, KVBLK);
  asm volatile("s_waitcnt vmcnt(5)" ::: "memory"); __builtin_amdgcn_s_barrier(); SBAR();
  qkt(pA0, pA1, lds + OFF_KN, lds + OFF_KR, qr, r32, hi, -m_reg); partialSM(pA0, pA1, m_reg, alA);
  int sV = 0, sK = STG, sN = 2 * STG;
  for (int j = 1; j + 1 < NT; j += 2) {
    TOP(); ISSUE(sN, (j + 1) * KVBLK); SBAR();
    qkt(pB0, pB1, lds + sK + OFF_KN, lds + sK + OFF_KR, qr, r32, hi, -m_reg);
    finishSM(pA0, pA1, alA, l_reg, pa0, pa1, pa2, pa3); SBAR();
    pv_d0(o, vb0 + sV, pa0, pa1, pa2, pa3); partialSM(pB0, pB1, m_reg, alB);
    RESC(alB); ROT();
    TOP(); if (j + 2 < NT) ISSUE(sN, (j + 2) * KVBLK); SBAR();
    qkt(pA0, pA1, lds + sK + OFF_KN, lds + sK + OFF_KR, qr, r32, hi, -m_reg);
    finishSM(pB0, pB1, alB, l_reg, pa0, pa1, pa2, pa3); SBAR();
    pv_d0(o, vb0 + sV, pa0, pa1, pa2, pa3); partialSM(pA0, pA1, m_reg, alA);
    RESC(alA); ROT();
  }
  TOP();
  qkt(pB0, pB1, lds + sK + OFF_KN, lds + sK + OFF_KR, qr, r32, hi, -m_reg);
  finishSM(pA0, pA1, alA, l_reg, pa0, pa1, pa2, pa3); SBAR();
  pv_d0(o, vb0 + sV, pa0, pa1, pa2, pa3); partialSM(pB0, pB1, m_reg, alB);
  RESC(alB);
  finishSM(pB0, pB1, alB, l_reg, pa0, pa1, pa2, pa3); SBAR();
  pv_d0(o, vb0 + sK, pa0, pa1, pa2, pa3);
  if (hi == 0) li_l[r32] = l_reg; asm volatile("s_waitcnt lgkmcnt(0)" ::: "memory");
  const int lane2 = fresh_lane(), r32e = lane2 & 31, hie = lane2 >> 5;
  float rli[16];
#pragma unroll
  for (int r = 0; r < 16; ++r) rli[r] = __builtin_amdgcn_rcpf(li_l[crow(r, hie)]);
  __syncthreads();
  bf16_t* stg = (bf16_t*)lds + wid * 4096;
#pragma unroll
  for (int r = 0; r < 16; ++r) { const int orow = crow(r, hie);
#pragma unroll
    for (int d0 = 0; d0 < 4; ++d0) stg[orow * 128 + d0 * 32 + r32e] = f2bf(o[d0][r] * rli[r]); }
  asm volatile("s_waitcnt lgkmcnt(0)" ::: "memory");
#pragma unroll
  for (int i = 0; i < 8; ++i) { const int row = i * 4 + (lane2 >> 4), ch = lane2 & 15; const u32x4 v = *(const u32x4*)(stg + row * 128 + ch * 8);
    *(u32x4*)(Ob + (long)(wid * QBLK + row) * LDO + ch * 8) = v; }
  __syncthreads();
#undef DMA1
#undef ISSUE
#undef TOP
#undef RESC
#undef ROT
}
#undef KSWZ
#undef KRSWZ
#undef SBAR
}

constexpr int NWAVES = 8;
constexpr size_t MiB = 1u << 20;
constexpr size_t WS_CTL = 0;
constexpr size_t WS_MODS  = 1 * MiB;
constexpr size_t WS_TAB   = WS_MODS + 256 * 1024;
constexpr size_t WS_BIAS1 = WS_TAB + 128 * 1024;
constexpr size_t WS_BIAS2 = WS_BIAS1 + 128 * 1024;
constexpr size_t WS_BIAS3 = WS_BIAS2 + 128 * 1024;
constexpr size_t WS_ROPE  = WS_BIAS3 + 128 * 1024;
constexpr size_t WS_SS1   = WS_ROPE + 64 * 1024;
constexpr size_t WS_SSP2  = 2 * MiB;
constexpr size_t WS_SSP3  = WS_SSP2 + (size_t)T_ALL * 64;
constexpr size_t WS_SSPF  = WS_SSP3 + (size_t)T_ALL * 64;
constexpr size_t WS_SSV   = WS_SSPF + (size_t)T_ALL * 64;
constexpr size_t WS_SSQ   = WS_SSV + (size_t)TC * 64;
constexpr size_t WS_SSC   = WS_SSQ + (size_t)TC * 16;
static_assert(WS_SS1 + (size_t)T_ALL * 4 <= WS_SSP2 && WS_SSC + (size_t)KEYROWS * 16 <= 8 * MiB, "small tables");
constexpr size_t WS_W     = 8 * MiB;
constexpr size_t W_1IN = 0, W_1OUT = W_1IN + (size_t)FF2 * DM * 2, W_IN = W_1OUT + (size_t)DM * FF * 2, W_Q = W_IN + (size_t)NIN * DM * 2, W_KV = W_Q + (size_t)NQ * 256 * 2,
                 W_AB = W_KV + (size_t)NKV * 256 * 2, W_O = W_AB + (size_t)DM * 2048 * 2, W_2IN = W_O + (size_t)DM * DM * 2, W_2OUT = W_2IN + (size_t)FF2 * DM * 2, W_S = W_2OUT + (size_t)DM * FF * 2,
                 W_END = W_S + (size_t)8 * 128 * 128 * 2;
constexpr size_t WS_XS    = 59 * MiB;
static_assert(WS_W + W_END <= WS_XS, "weights");
constexpr size_t WS_BIG   = 107 * MiB;
constexpr size_t B_OAB = 0  , B_OAB2 = 32 * MiB  , B_G = 64 * MiB  , B_Q = 64 * MiB, B_KN = 88 * MiB, B_V = 105 * MiB, B_QL = 122 * MiB, B_CKV = 126 * MiB, B_KR = B_CKV + (size_t)KEYROWS * 256 * 2;
constexpr size_t B_QL0 = 32 * MiB, B_CKV0 = 36 * MiB, B_KR0 = 143 * MiB;
constexpr size_t B_SET2 = 10 * MiB;
constexpr size_t B_SS2 = 142 * MiB;
constexpr size_t WS_END = WS_BIG + 144 * MiB;
static_assert(B_KR + B_SET2 + (size_t)KEYROWS * 64 * 2 <= B_SS2 && WS_END <= 256 * MiB && B_KR + (size_t)KEYROWS * 64 * 2 <= 132 * MiB && B_KN + (size_t)KEYROWS * DM * 2 <= B_V && B_V + (size_t)KEYROWS * DM * 2 <= B_QL && (size_t)T_ALL * FF * 2 <= 132 * MiB, "mixer map");
constexpr int RING_BYTES = 131072, LDSCTL_OFF = 146432  , MISC_OFF = LDSCTL_OFF + 320, LDS_BYTES = 147456;
static_assert(att::SHM_ATTN <= RING_BYTES, "attention scratch");

#define GAS __attribute__((address_space(1)))
#define LAS __attribute__((address_space(3)))
typedef unsigned short bf16;
typedef unsigned v4u __attribute__((ext_vector_type(4)));
typedef unsigned v2u __attribute__((ext_vector_type(2)));
typedef float f32x4 __attribute__((ext_vector_type(4)));
typedef short bf16x8 __attribute__((ext_vector_type(8)));
typedef float f32x16 __attribute__((ext_vector_type(16)));
#define LDS_WAIT() asm volatile("s_waitcnt lgkmcnt(0)" ::: "memory")
#define VM_WAIT() asm volatile("s_waitcnt vmcnt(0)" ::: "memory")
__device__ __forceinline__ unsigned f2bf(float f) { unsigned u = __builtin_bit_cast(unsigned, f); return (u + 0x7fffu + ((u >> 16) & 1u)) >> 16; }
__device__ __forceinline__ unsigned pk2(float lo, float hi) { return f2bf(lo) | (f2bf(hi) << 16); }
__device__ __forceinline__ float bflo(unsigned w) { return __builtin_bit_cast(float, w << 16); }
__device__ __forceinline__ float bfhi(unsigned w) { return __builtin_bit_cast(float, w & 0xffff0000u); }

#define XB_TMO      128
#define XB_XCNT(j)  (256  + 64 * (j))
#define XB_XSUB(j)  (1280 + 64 * (j))
#define XB_XGEN(j)  (2304 + 64 * (j))
#define XB_TOP      3328
#define XB_TOPGEN   3392
#define XCD_BAR_WORDS 3456
#define XB_SPIN_CAP (1u << 21)
__device__ unsigned mk_bar_words[XCD_BAR_WORDS];
__device__ __forceinline__ unsigned xb_ld(unsigned* p)              { return __hip_atomic_load(p, __ATOMIC_RELAXED, __HIP_MEMORY_SCOPE_AGENT); }
__device__ __forceinline__ unsigned xb_add(unsigned* p, unsigned v) { return __hip_atomic_fetch_add(p, v, __ATOMIC_RELAXED, __HIP_MEMORY_SCOPE_AGENT); }
__device__ __forceinline__ unsigned xb_xcc_id() { return (unsigned)__builtin_amdgcn_s_getreg((3 << 11) | 20) & 0xFu; }
#define XB_SPIN(cond, bar) do { unsigned _sp = 0; while (cond) { __builtin_amdgcn_s_sleep(1); \
    if ((++_sp & 255u) == 0u) { if (xb_ld(&(bar)[XB_TMO])) break; if (_sp > XB_SPIN_CAP) { atomicAdd(&(bar)[XB_TMO], 1u); break; } } } } while (0)
struct XcdBarrier { unsigned* bar; unsigned x; volatile LAS unsigned* st; };
__device__ __forceinline__ XcdBarrier xcd_barrier_post(unsigned* bar, volatile LAS unsigned* st) {
    XcdBarrier b; b.bar = bar; b.x = xb_xcc_id(); b.st = st;
    if (threadIdx.x == 0) { (void)xb_add(&bar[XB_XCNT(b.x)], 1u); st[0] = 0u; st[1] = 0u; st[2] = xb_ld(&bar[XB_XGEN(b.x)]); st[3] = xb_ld(&bar[XB_TOPGEN]); }
    return b;
}
__device__ __forceinline__ void xcd_barrier_complete(unsigned* bar, unsigned x, unsigned& nloc, unsigned& nx) {
    const unsigned G = gridDim.x * gridDim.y * gridDim.z;
    unsigned sum, cnt, mine, sp = 0u;
    for (;;) {
        sum = 0u; cnt = 0u; mine = 0u;
#pragma unroll
        for (unsigned j = 0; j < 16; ++j) { const unsigned c = xb_ld(&bar[XB_XCNT(j)]); sum += c; cnt += (c > 0u) ? 1u : 0u; mine = (j == x) ? c : mine; }
        if (sum == G) break;
        __builtin_amdgcn_s_sleep(1);
        if ((++sp & 255u) == 0u) { if (xb_ld(&bar[XB_TMO])) break; if (sp > XB_SPIN_CAP) { atomicAdd(&bar[XB_TMO], 1u); break; } }
    }
    nloc = mine > 0u ? mine : 1u; nx = cnt > 0u ? cnt : 1u;
}
__device__ __forceinline__ void xcd_barrier(const XcdBarrier& b, const int wave_s) {
    asm volatile("s_waitcnt vmcnt(0)" ::: "memory");
    __syncthreads();
    if (wave_s == 0 && fresh_lane() == 0) {
        unsigned* bar = b.bar; unsigned bx_ = b.x; asm volatile("" : "+s"(bar), "+s"(bx_));
        __builtin_amdgcn_s_waitcnt(0);
        unsigned nloc = b.st[0], nx = b.st[1]; const unsigned gx = b.st[2], gt = b.st[3]; bool first = false;
        if (nloc == 0u) { xcd_barrier_complete(bar, bx_, nloc, nx); b.st[0] = nloc; b.st[1] = nx; first = true; }
        b.st[2] = gx + 1u; b.st[3] = gt + 1u;
        const unsigned old = xb_add(&bar[XB_XSUB(bx_)], 1u);
        if (old + 1u == nloc) {
            (void)xb_add(&bar[XB_XSUB(bx_)], 0u - nloc);
            __builtin_amdgcn_fence(__ATOMIC_RELEASE, "agent");
            asm volatile("s_waitcnt vmcnt(0)" ::: "memory");
            const unsigned og = xb_add(&bar[XB_TOP], 1u);
            if (og + 1u == nx) { (void)xb_add(&bar[XB_TOPGEN], 1u); (void)xb_add(&bar[XB_TOP], 0u - nx); }
            else XB_SPIN(xb_ld(&bar[XB_TOPGEN]) == gt, bar);
            (void)xb_add(&bar[XB_XGEN(bx_)], 1u);
            if (first) (void)xb_add(&bar[XB_XCNT(bx_)], 0u - nloc);
            __builtin_amdgcn_fence(__ATOMIC_ACQUIRE, "agent");
            asm volatile("s_waitcnt vmcnt(0)" ::: "memory");
        } else {
            XB_SPIN(xb_ld(&bar[XB_XGEN(bx_)]) == gx, bar);
            __builtin_amdgcn_fence(__ATOMIC_ACQUIRE, "agent");
            asm volatile("s_waitcnt vmcnt(0)" ::: "memory");
        }
    }
    __syncthreads();
}

enum { MAP_PLAIN = 0, MAP_FFNIN = 1, MAP_WIN = 2, MAP_WQ = 3, MAP_WKV = 4 };
__device__ __forceinline__ int dst_row(int mode, int n) {
    if (mode == MAP_FFNIN) { const bool isu = n >= FF; const int j = isu ? n - FF : n; return 256 * (j >> 7) + (isu ? 128 : 0) + (j & 127); }
    if (mode == MAP_WIN) { if (n < 2560) return n; if (n < 2624) { const int d = n - 2560; return 2560 + (d & 32) + pg8::perm32(d & 31); } return 2816 + (n - 2624); }
    if (mode == MAP_WQ) { const int h = n / 192, d = n % 192; if (d < 128) return n; const int dd = d - 128; return h * 192 + 128 + (dd & 32) + pg8::perm32(dd & 31); }
    if (mode == MAP_WKV) { const int h = n >> 8, d = n & 255; return d < 128 ? h * 128 + d : 1024 + h * 128 + (d - 128); }
    return n;
}
__device__ __forceinline__ void tr_item(const float* W, int N, bf16* WT, int ldk, int kofs, int mode, const float* kscale, int item, LAS float* scr, int lane) {
    const int nblk = N / 64, kb = item / nblk, nb = item % nblk, k0 = 64 * kb, n0 = 64 * nb, r = lane >> 4, q = lane & 15;
    f32x4 wv[16];
#pragma unroll
    for (int i = 0; i < 16; ++i) wv[i] = __builtin_nontemporal_load((const f32x4*)(W + (size_t)(k0 + 4 * i + r) * N + n0 + 4 * q));
    if (kscale) {
#pragma unroll
        for (int i = 0; i < 16; ++i) wv[i] *= kscale[k0 + 4 * i + r]; }
#pragma unroll
    for (int i = 0; i < 16; ++i) { LAS float* p = scr + (4 * i + r) * 65 + 4 * q; p[0] = wv[i][0]; p[1] = wv[i][1]; p[2] = wv[i][2]; p[3] = wv[i][3]; }
    LDS_WAIT(); asm volatile("" ::: "memory");
    const int c = lane & 7;
#pragma unroll
    for (int j = 0; j < 8; ++j) { const int n = (lane >> 3) + 8 * j; const LAS float* s = scr + (8 * c) * 65 + n;
        v4u o; o.x = pk2(s[0 * 65], s[1 * 65]); o.y = pk2(s[2 * 65], s[3 * 65]); o.z = pk2(s[4 * 65], s[5 * 65]); o.w = pk2(s[6 * 65], s[7 * 65]);
        *(GAS v4u*)(WT + (size_t)dst_row(mode, n0 + n) * ldk + kofs + k0 + 8 * c) = o; }
    LDS_WAIT(); asm volatile("" ::: "memory");
}
constexpr int IT_FFNIN = 16 * (FF2 / 64), IT_FFNOUT = (FF / 64) * (DM / 64), IT_WIN = 16 * (4672 / 64), IT_WQ = 4 * (NQ / 64), IT_WKV = 4 * (NKV / 64), IT_SQ = 16 * (DM / 64);
constexpr int IT_TR = 2 * IT_FFNIN + 2 * IT_FFNOUT + IT_WIN + IT_WQ + IT_WKV + 3 * IT_SQ;
constexpr int IT_PAD = 192, IT_WS = 256, IT_ROPE = 1;
constexpr int IT_P0 = IT_TR + IT_PAD + IT_WS + IT_ROPE;
constexpr int IT_DEF = 3 * IT_SQ + IT_FFNIN + IT_FFNOUT;

struct KArgs { const float* in[27]; float* out; unsigned char* ws; int ph_lo, ph_hi; int rep_mask, pad; };

__constant__ int PH_KIND[NPH] = {0, 1, 2, 3,        4, 5, 6, 7, 8,           4,          6,       5, 6,     7, 8,         2, 3, 9};
__constant__ int PH_ARG[NPH]  = {0, 0, 0, 0,        0, 0, 0, 0, 0,           1,          1,       2, 2,     1, 1,         1, 1, 0};
__constant__ double ROPE_INV[16] = {1.0, 0.5623413251903491, 0.31622776601683794, 0.1778279410038923, 0.1, 0.05623413251903491, 0.03162277660168379, 0.01778279410038923,
                                    0.01, 0.005623413251903491, 0.0031622776601683794, 0.0017782794100389228, 0.001, 0.0005623413251903491, 0.00031622776601683794, 0.00017782794100389227};

__device__ __forceinline__ void gmlp_pair(int itemA, int itemB, bf16* OAB, const bf16* WSb, const float* SSV, const float* vnorm, const float* bs, LAS unsigned char* L, const int wave_s) {
    int wid_ = wave_s; asm volatile("" : "+s"(wid_));
    const int lane = fresh_lane(), wid = wid_, half = wid >> 2, w4 = wid & 3, t256 = w4 * 64 + lane;
    const int item = half ? itemB : itemA; const bool on = item >= 0;
    const int cq = item >> 3, g = item & 7, r0 = cq * 128, r32 = lane & 31, hi = lane >> 5;
    LAS unsigned short* A_l = (LAS unsigned short*)(L + half * 70144);
    LAS unsigned short* VT_l = (LAS unsigned short*)(L + half * 70144 + 34816);
    LAS float* rstd_l = (LAS float*)(L + half * 70144 + 69632);
    if (on && t256 < 128) { const float* p = SSV + (size_t)(r0 + t256) * 16; float s = 0.f;
#pragma unroll
        for (int q = 0; q < 4; ++q) { const f32x4 t = *(const f32x4*)(p + 4 * q); s += (t[0] + t[1]) + (t[2] + t[3]); }
        rstd_l[t256] = rsqrtf(s * (1.f / 1024.f) + EPS); }
    __syncthreads();
    if (on) {
#pragma unroll
        for (int i = 0; i < 8; ++i) { const int id = t256 + 256 * i, row = id >> 4, ch = id & 15;
            const v4u w = *(const v4u*)(WSb + (size_t)g * 16384 + row * 128 + ch * 8);
            *(LAS v4u*)(A_l + row * 136 + ch * 8) = w;
            const int rw = id & 127, cv = id >> 7;
            const v4u vv = *(const v4u*)(OAB + (size_t)(r0 + rw) * 2048 + 1024 + g * 128 + cv * 8);
            const float rq = rstd_l[rw]; const f32x4 n0 = *(const f32x4*)(vnorm + g * 128 + cv * 8), n1 = *(const f32x4*)(vnorm + g * 128 + cv * 8 + 4);
            LAS unsigned short* vt = VT_l + (cv * 8) * 136 + rw;
            vt[0 * 136] = (unsigned short)f2bf(bflo(vv[0]) * rq * n0[0]); vt[1 * 136] = (unsigned short)f2bf(bfhi(vv[0]) * rq * n0[1]);
            vt[2 * 136] = (unsigned short)f2bf(bflo(vv[1]) * rq * n0[2]); vt[3 * 136] = (unsigned short)f2bf(bfhi(vv[1]) * rq * n0[3]);
            vt[4 * 136] = (unsigned short)f2bf(bflo(vv[2]) * rq * n1[0]); vt[5 * 136] = (unsigned short)f2bf(bfhi(vv[2]) * rq * n1[1]);
            vt[6 * 136] = (unsigned short)f2bf(bflo(vv[3]) * rq * n1[2]); vt[7 * 136] = (unsigned short)f2bf(bfhi(vv[3]) * rq * n1[3]); }
    }
    __syncthreads();
    f32x16 acc[4] = {};
    if (on) {
#pragma unroll
        for (int ks = 0; ks < 8; ++ks) {
            const bf16x8 af = *(const LAS bf16x8*)(A_l + (w4 * 32 + r32) * 136 + ks * 16 + hi * 8);
#pragma unroll
            for (int db = 0; db < 4; ++db) { const bf16x8 bfr = *(const LAS bf16x8*)(VT_l + (db * 32 + r32) * 136 + ks * 16 + hi * 8);
                acc[db] = __builtin_amdgcn_mfma_f32_32x32x16_bf16(af, bfr, acc[db], 0, 0, 0); }
        }
    }
    __syncthreads();
    LAS float* M_l = (LAS float*)(L + half * 70144);
    if (on) {
#pragma unroll
        for (int r = 0; r < 16; ++r) { const int p = w4 * 32 + (r & 3) + 8 * (r >> 2) + 4 * hi; const float bb = bs[p * 8 + g];
#pragma unroll
            for (int db = 0; db < 4; ++db) M_l[p * 132 + db * 32 + r32] = acc[db][r] + bb; }
    }
    __syncthreads();
    if (on) {
#pragma unroll
        for (int i = 0; i < 8; ++i) { const int id = t256 + 256 * i, row = id >> 4, ch = id & 15;
            bf16* up = OAB + (size_t)(r0 + row) * 2048 + g * 128 + ch * 8; const v4u uv = *(const v4u*)up;
            const f32x4 m0 = *(const LAS f32x4*)(M_l + row * 132 + ch * 8), m1 = *(const LAS f32x4*)(M_l + row * 132 + ch * 8 + 4);
            v4u o; o.x = pk2(bflo(uv.x) * m0[0], bfhi(uv.x) * m0[1]); o.y = pk2(bflo(uv.y) * m0[2], bfhi(uv.y) * m0[3]); o.z = pk2(bflo(uv.z) * m1[0], bfhi(uv.z) * m1[1]); o.w = pk2(bflo(uv.w) * m1[2], bfhi(uv.w) * m1[3]);
            *(v4u*)up = o; }
    }
    __syncthreads();
}

__device__ __forceinline__ void bias_pass(int lo, int hi, int gw, int NGW, int lane, const float* mods_, const bf16* w1, const bf16* wi, const bf16* w2, float* b1, float* b2, float* b3) {
    int curmat = -1; float shv[NMOD][16];
#pragma unroll
    for (int mi = 0; mi < NMOD; ++mi)
#pragma unroll
        for (int i = 0; i < 16; ++i) shv[mi][i] = 0.f;
#define BP_ROW(IT) (((IT) < FF2 ? w1 + (size_t)(IT) * DM : (IT) < FF2 + NIN ? wi + (size_t)((IT) - FF2) * DM : w2 + (size_t)((IT) - FF2 - NIN) * DM))
    v4u pw0 = {0u, 0u, 0u, 0u}, pw1 = pw0;
    if (lo + gw < hi) { const bf16* r0 = BP_ROW(lo + gw); pw0 = *(const v4u*)(r0 + 8 * lane); pw1 = *(const v4u*)(r0 + 8 * (lane + 64)); }
    for (int it = lo + gw; it < hi; it += NGW) {
        int mat, n; if (it < FF2) { mat = 0; n = it; } else if (it < FF2 + NIN) { mat = 1; n = it - FF2; } else { mat = 2; n = it - FF2 - NIN; }
        const v4u w0 = pw0, w1v = pw1;
        if (it + NGW < hi) { const bf16* r1 = BP_ROW(it + NGW); pw0 = *(const v4u*)(r1 + 8 * lane); pw1 = *(const v4u*)(r1 + 8 * (lane + 64)); }
        if (mat != curmat) { curmat = mat;
#pragma unroll
            for (int mi = 0; mi < NMOD; ++mi)
#pragma unroll
                for (int j = 0; j < 2; ++j) { const float* sp = mods_ + mi * 9216 + 3 * mat * 1024 + 8 * (lane + 64 * j); const f32x4 s0 = *(const f32x4*)sp, s1 = *(const f32x4*)(sp + 4);
#pragma unroll
                    for (int i = 0; i < 4; ++i) { shv[mi][j * 8 + i] = s0[i]; shv[mi][j * 8 + 4 + i] = s1[i]; } } }
        float wv[16];
#pragma unroll
        for (int k = 0; k < 4; ++k) { wv[2 * k] = bflo(w0[k]); wv[2 * k + 1] = bfhi(w0[k]); wv[8 + 2 * k] = bflo(w1v[k]); wv[8 + 2 * k + 1] = bfhi(w1v[k]); }
        float* bo = (mat == 0 ? b1 : mat == 1 ? b2 : b3); const int nrow = (mat == 1 ? NIN : FF2);
#pragma unroll
        for (int mi = 0; mi < NMOD; ++mi) { float s = 0.f;
#pragma unroll
            for (int i = 0; i < 16; ++i) s += wv[i] * shv[mi][i];
            s = wave_sum(s); if (lane == 0) bo[mi * nrow + n] = s; }
    }
#undef BP_ROW
}

#ifndef MK_ONLY
#define MK_EN(k) true
#else
#define MK_EN(k) ((k) == MK_ONLY)
#endif
#define SS2_DELTA (WS_BIG + B_SS2 - WS_SSV)
#define mods ((float*)(ws + WS_MODS))
#define tab ((float*)(ws + WS_TAB))
#define bias1 ((float*)(ws + WS_BIAS1))
#define bias2 ((float*)(ws + WS_BIAS2))
#define bias3 ((float*)(ws + WS_BIAS3))
#define rope ((float*)(ws + WS_ROPE))
#define ss1 ((float*)(ws + WS_SS1))
#define ssp2 ((float*)(ws + WS_SSP2))
#define ssp3 ((float*)(ws + WS_SSP3))
#define sspf ((float*)(ws + WS_SSPF))
#define SSV ((float*)(ws + WS_SSV + (chunk == 2 ? SS2_DELTA : 0)))
#define SSQ ((float*)(ws + WS_SSQ + (chunk == 2 ? SS2_DELTA : 0)))
#define SSC ((float*)(ws + WS_SSC + (chunk == 2 ? SS2_DELTA : 0)))
#define W1IN ((bf16*)(ws + WS_W + W_1IN))
#define W1OUT ((bf16*)(ws + WS_W + W_1OUT))
#define WIN ((bf16*)(ws + WS_W + W_IN))
#define WQ ((bf16*)(ws + WS_W + W_Q))
#define WKV ((bf16*)(ws + WS_W + W_KV))
#define WAB ((bf16*)(ws + WS_W + W_AB))
#define WO ((bf16*)(ws + WS_W + W_O))
#define W2IN ((bf16*)(ws + WS_W + W_2IN))
#define W2OUT ((bf16*)(ws + WS_W + W_2OUT))
#define WSb ((bf16*)(ws + WS_W + W_S))
#define XS ((bf16*)(ws + WS_XS))
#define ACT ((bf16*)(ws + WS_BIG))
#define OAB ((bf16*)(ws + WS_BIG + B_OAB))
#define OABC ((bf16*)(ws + WS_BIG + (chunk == 2 ? B_OAB2 : B_OAB)))
#define GT ((bf16*)(ws + WS_BIG + (chunk ? B_G : B_OAB2)))
#define Qb ((bf16*)(ws + WS_BIG + B_Q))
#define KN ((bf16*)(ws + WS_BIG + B_KN))
#define Vb ((bf16*)(ws + WS_BIG + B_V))
#define QL ((bf16*)(ws + WS_BIG + (chunk == 0 ? B_QL0 : B_QL + (chunk == 2 ? B_SET2 : 0))))
#define CKV ((bf16*)(ws + WS_BIG + (chunk == 0 ? B_CKV0 : B_CKV + (chunk == 2 ? B_SET2 : 0))))
#define KR ((bf16*)(ws + WS_BIG + (chunk == 0 ? B_KR0 : B_KR + (chunk == 2 ? B_SET2 : 0))))
#define INP(k) ((const float*)(const GAS float*)ap->in[k])
#define OUTP ((float*)(GAS float*)ap->out)
#define X (OUTP)
#define nckv (OUTP + (size_t)T_ALL * DM)
#define rawkr ((float*)(ws + WS_BIG + B_QL + B_SET2 + 8 * MiB))
#define rawckv ((float*)(ws + WS_BIG + B_QL + B_SET2))
#define nkr (OUTP + (size_t)T_ALL * DM + (size_t)T_CTX * 256)
__global__ void __launch_bounds__(NWAVES * 64, 2) mk_fwd(KArgs a) {
    extern __shared__ __attribute__((aligned(16))) unsigned char lds[];
    LAS unsigned char* L = (LAS unsigned char*)lds;
    const int wave_s = __builtin_amdgcn_readfirstlane(threadIdx.x >> 6);
    volatile LAS unsigned* MISC = (volatile LAS unsigned*)(L + MISC_OFF);
    const bool fused = (a.ph_hi - a.ph_lo) > 1;
    XcdBarrier bar; bar.bar = mk_bar_words; bar.x = 0; bar.st = MISC + 8;
    if (fused) bar = xcd_barrier_post(mk_bar_words, MISC + 8);

    for (int ph = a.ph_lo; ph < a.ph_hi; ++ph)
    for (int rep = 0; rep <= ((a.rep_mask >> ph) & 1); ++rep) {
        if (ph != a.ph_lo || rep != 0) xcd_barrier(bar, wave_s);
        int NG = gridDim.x, bx = blockIdx.x; asm volatile("" : "+s"(NG), "+s"(bx));
        const int vcu = (NG % 8 == 0) ? (bx % 8) * (NG / 8) + bx / 8 : bx, NGW = NG * NWAVES;
        int wave = wave_s; asm volatile("" : "+s"(wave));
        const int gw = vcu * NWAVES + wave;
        const __attribute__((address_space(4))) KArgs* ap = (const __attribute__((address_space(4))) KArgs*)__builtin_amdgcn_kernarg_segment_ptr(); asm volatile("" : "+s"(ap));
        GAS unsigned char* ws0 = (GAS unsigned char*)ap->ws; asm volatile("" : "+s"(ws0)); unsigned char* ws = (unsigned char*)ws0;

        const int kind0 = PH_KIND[ph], chunk0 = PH_ARG[ph];
        const bool split = (kind0 == 4 && chunk0 == 0), tailw = split && bx >= NG / 2;
        const bool split7 = (kind0 == 7 && chunk0 == 0), tail7 = split7 && bx >= NG / 2;
        const int chunk = tail7 ? 1 : chunk0;
        const int kind = tailw ? 3 : tail7 ? 4 : kind0, Gx = (split || split7) ? NG / 2 : NG, cx = (tailw || tail7) ? bx - NG / 2 : bx;

        if (kind == 0 && MK_EN(0)) {
            const int lane = fresh_lane(), tid = wave * 64 + lane; (void)tid;
            LAS float* stab = (LAS float*)(L + 67584);
            for (int i = tid; i < NMOD * 1024; i += NWAVES * 64) { const int mi = i >> 10, k = i & 1023; const float cv = mi == 0 ? INP(5)[k] : INP(2)[(mi - 1) * 1024 + k]; stab[k * 8 + mi] = cv / (1.f + __expf(-cv)); }
            __syncthreads();
            LAS float* red = (LAS float*)(L + 100352);
            for (int cgp = vcu; cgp < 576; cgp += NG) {
                const int j0 = 16 * cgp, kq = lane >> 2, cg = lane & 3; const float* wp = INP(6) + j0 + 4 * cg;
                f32x4 ac0 = {0.f, 0.f, 0.f, 0.f}, ac1 = ac0, ac2 = ac0, ac3 = ac0, ac4 = ac0;
#pragma unroll
                for (int i = 0; i < 8; ++i) { const int k = wave * 128 + kq + 16 * i; const f32x4 w = __builtin_nontemporal_load((const f32x4*)(wp + (size_t)k * 9216));
                    const f32x4 s03 = *(const LAS f32x4*)(stab + k * 8); const float s4 = stab[k * 8 + 4];
                    ac0 += w * s03[0]; ac1 += w * s03[1]; ac2 += w * s03[2]; ac3 += w * s03[3]; ac4 += w * s4; }
#pragma unroll
                for (int c = 0; c < 4; ++c) {
#define RED5(OP) ac0[c] = OP(ac0[c]); ac1[c] = OP(ac1[c]); ac2[c] = OP(ac2[c]); ac3[c] = OP(ac3[c]); ac4[c] = OP(ac4[c]);
#define R4(v) ((v) + dpp_get<0x124>(v))
#define R8(v) ((v) + dpp_get<0x128>(v))
#define R16(v) add_xor16(v)
                    RED5(R4) RED5(R8) RED5(R16) RED5(add_xor32)
#undef RED5
#undef R4
#undef R8
#undef R16
                }
                if (lane < 4) { LAS float* rp = red + (wave * 4 + lane) * 20; *(LAS f32x4*)(rp) = ac0; *(LAS f32x4*)(rp + 4) = ac1; *(LAS f32x4*)(rp + 8) = ac2; *(LAS f32x4*)(rp + 12) = ac3; *(LAS f32x4*)(rp + 16) = ac4; }
                __syncthreads();
                if (tid < 80) { const int l4 = tid / 20, e = tid % 20; float t = 0.f;
#pragma unroll
                    for (int w8 = 0; w8 < 8; ++w8) t += red[(w8 * 4 + l4) * 20 + e];
                    const int mi = e >> 2, col = j0 + 4 * l4 + (e & 3); mods[mi * 9216 + col] = t + INP(7)[col]; }
                __syncthreads();
            }
            LAS float* scr = (LAS float*)(L + wave * 16640);
            for (int it = NGW - 1 - gw; it < IT_P0 - IT_DEF; it += NGW) {
                int r = it;
                if (r < IT_FFNIN)  { tr_item(INP(9),  FF2, W1IN, DM, 0, MAP_FFNIN, nullptr, r, scr, lane); continue; } r -= IT_FFNIN;
                if (r < IT_FFNOUT) { tr_item(INP(10), DM, W1OUT, FF, 0, MAP_PLAIN, nullptr, r, scr, lane); continue; } r -= IT_FFNOUT;
                if (r < IT_WIN)    { tr_item(INP(12), 4672, WIN, DM, 0, MAP_WIN, nullptr, r, scr, lane); continue; } r -= IT_WIN;
                if (r < IT_WQ)     { tr_item(INP(17), NQ, WQ, 256, 0, MAP_WQ, INP(16), r, scr, lane); continue; } r -= IT_WQ;
                if (r < IT_WKV)    { tr_item(INP(19), NKV, WKV, 256, 0, MAP_WKV, INP(18), r, scr, lane); continue; } r -= IT_WKV;
                if (r < IT_PAD)    { const v4u z = {0u, 0u, 0u, 0u}; bf16* p = WIN + (size_t)(2624 + r) * DM + lane * 16; *(v4u*)p = z; *(v4u*)(p + 8) = z; continue; } r -= IT_PAD;
                if (r < IT_WS)     { const float* s = INP(14) + (size_t)r * 512 + lane * 8; const f32x4 x0 = *(const f32x4*)s, x1 = *(const f32x4*)(s + 4);
                                     v4u o; o.x = pk2(x0[0], x0[1]); o.y = pk2(x0[2], x0[3]); o.z = pk2(x1[0], x1[1]); o.w = pk2(x1[2], x1[3]); *(v4u*)(WSb + (size_t)r * 512 + lane * 8) = o; continue; } r -= IT_WS;
                if (lane < 16) {
                    const double th = ROPE_INV[lane], t2 = th * th;
                    const double s1 = th * (1.0 - t2 * (1.0 / 6.0) * (1.0 - t2 * (1.0 / 20.0) * (1.0 - t2 * (1.0 / 42.0) * (1.0 - t2 * (1.0 / 72.0) * (1.0 - t2 * (1.0 / 110.0) * (1.0 - t2 * (1.0 / 156.0) * (1.0 - t2 * (1.0 / 210.0))))))));
                    const double c1 = 1.0 - t2 * (1.0 / 2.0) * (1.0 - t2 * (1.0 / 12.0) * (1.0 - t2 * (1.0 / 30.0) * (1.0 - t2 * (1.0 / 56.0) * (1.0 - t2 * (1.0 / 90.0) * (1.0 - t2 * (1.0 / 132.0) * (1.0 - t2 * (1.0 / 182.0)))))));
                    double cp = 1.0, sp = 0.0;
                    for (int pos = 0; pos < 64; ++pos) { rope[pos * 16 + lane] = (float)cp; rope[1024 + pos * 16 + lane] = (float)sp; const double cn = cp * c1 - sp * s1, sn = sp * c1 + cp * s1; cp = cn; sp = sn; }
                }
            }
        } else if (kind == 1 && MK_EN(1)) {
            const int lane = fresh_lane(), tid = wave * 64 + lane; (void)tid;
            for (int it = gw; it < 480; it += NGW) { const int idx = it * 64 + lane, k = idx / 5120, rem = idx % 5120, mi = rem >> 10, c = rem & 1023; const float* mm = mods + mi * 9216; float v;
                if (k == 0) v = INP(8)[c] * (1.f + mm[1024 + c]); else if (k == 1) v = INP(11)[c] * (1.f + mm[4 * 1024 + c]); else if (k == 2) v = INP(23)[c] * (1.f + mm[7 * 1024 + c]);
                else if (k == 3) v = 0.5f * mm[2 * 1024 + c]; else if (k == 4) v = mm[5 * 1024 + c]; else v = 0.5f * mm[8 * 1024 + c];
                tab[idx] = v; }
            bias_pass(0, FF2 + NIN, gw, NGW, lane, mods, W1IN, WIN, W2IN, bias1, bias2, bias3);
            for (int m0 = gw; m0 < T_ALL; m0 += 2 * NGW) {
                const int m1 = m0 + NGW, mi = m0 < T_CTX ? 0 : 1 + ((m0 - T_CTX) >> 12);
                const float* s0 = m0 < T_CTX ? INP(0) + (size_t)m0 * DM : INP(1) + (size_t)(m0 - T_CTX) * DM; const float* s1 = m1 < T_CTX ? INP(0) + (size_t)m1 * DM : INP(1) + (size_t)(m1 - T_CTX) * DM;
                const float* sc = mods + mi * 9216 + 1024; f32x4 xa[4], xb[4], cs[4]; float ssa = 0.f, ssb = 0.f;
#pragma unroll
                for (int j = 0; j < 4; ++j) { const int c = 4 * lane + 256 * j; xa[j] = __builtin_nontemporal_load((const f32x4*)(s0 + c)); xb[j] = __builtin_nontemporal_load((const f32x4*)(s1 + c));     cs[j] = *(const f32x4*)(INP(8) + c) * (1.f + *(const f32x4*)(sc + c)); }
#pragma unroll
                for (int j = 0; j < 4; ++j) { const int c = 4 * lane + 256 * j; ssa += (xa[j][0] * xa[j][0] + xa[j][1] * xa[j][1]) + (xa[j][2] * xa[j][2] + xa[j][3] * xa[j][3]); ssb += (xb[j][0] * xb[j][0] + xb[j][1] * xb[j][1]) + (xb[j][2] * xb[j][2] + xb[j][3] * xb[j][3]);
                    const f32x4 ya = xa[j] * cs[j], yb = xb[j] * cs[j]; v2u o; o.x = pk2(ya[0], ya[1]); o.y = pk2(ya[2], ya[3]); *(v2u*)(XS + (size_t)m0 * DM + c) = o; o.x = pk2(yb[0], yb[1]); o.y = pk2(yb[2], yb[3]); *(v2u*)(XS + (size_t)m1 * DM + c) = o; }
                ssa = wave_sum(ssa); ssb = wave_sum(ssb); if (lane == 0) { ss1[m0] = ssa; ss1[m1] = ssb; }
            }
        } else if (kind == 2 && MK_EN(2)) {
            const bool second = (chunk == 1);
            pg8::Gemm g{XS, second ? W2IN : W1IN, T_ALL, FF2, DM, DM}; pg8::StaticOrder S; S.init(T_ALL, FF2, NG, bx);
            pg8::EpiSwiGLU E{ACT, second ? ssp3 : ss1, second ? 16 : 1, second ? bias3 : bias1};
            pg8::gemm_phase<pg8::EpiSwiGLU, pg8::StaticOrder, true, true>(L, g, S, E, wave_s);
            if (!second && bx >= 128) {
                const int lane = fresh_lane(); LAS float* scr = (LAS float*)(L + wave * 16640);
                for (int it = (bx - 128) * NWAVES + wave; it < IT_DEF - IT_FFNOUT - 2 * IT_SQ; it += (NG - 128) * NWAVES) {
                    int r = it;
                    if (r < IT_SQ)     { tr_item(INP(22), DM, WO, DM, 0, MAP_PLAIN, nullptr, r, scr, lane); continue; } r -= IT_SQ;
                    tr_item(INP(24), FF2, W2IN, DM, 0, MAP_FFNIN, nullptr, r, scr, lane);
                }
            }
        } else if ((kind == 3 || kind == 8) && MK_EN(3)) {
            pg8::Gemm g; pg8::EpiResid E; pg8::StaticOrder S;
            if (kind == 3) { const bool second = (chunk == 1);
                g = pg8::Gemm{ACT + (tailw ? (size_t)16384 * FF : 0), second ? W2OUT : W1OUT, second ? T_ALL : (tailw ? 8192 : 16384), DM, FF, FF};
                E = second ? pg8::EpiResid{tab + 2 * 5120, tab + 5 * 5120, INP(26), 0, XS, sspf, 0}
                           : pg8::EpiResid{tab + 0 * 5120, tab + 3 * 5120, tab + 1 * 5120, DM, XS, ssp2, tailw ? 64 : 0};
            } else {
                g = pg8::Gemm{GT, WO, chunk ? 2 * TC : TC, DM, DM, 2048};
                E = pg8::EpiResid{tab + 1 * 5120, tab + 4 * 5120, tab + 2 * 5120, DM, XS, ssp3, chunk * 32};
            }
            S.init(g.M, g.N, Gx, cx);
            pg8::gemm_phase<pg8::EpiResid, pg8::StaticOrder, true, true>(L, g, S, E, wave_s);
            if (tailw) bias_pass(FF2 + NIN, FF2 + NIN + FF2, cx * NWAVES + wave, Gx * NWAVES, fresh_lane(), mods, W1IN, WIN, W2IN, bias1, bias2, bias3);
        } else if (kind == 4 && MK_EN(4)) {
            const int lane = fresh_lane(), tid = wave * 64 + lane; (void)tid;
            const int Mw = chunk ? 2 * TC : TC;
            const int pn0 = tail7 ? 8 : 0, Nw = chunk == 0 ? 2816 : (tail7 ? 768 : 2048);
            pg8::Gemm g{XS + (size_t)chunk * TC * DM, WIN + (size_t)pn0 * 256 * DM, Mw, Nw, DM, DM}; pg8::StaticOrder S; S.init(Mw, Nw, Gx, cx);
            pg8::EpiWin E{ssp2, bias2, OAB, QL, CKV, KR, SSV, SSQ, SSC, rawckv, rawkr, rope, chunk, (long)B_SET2, (long)SS2_DELTA, pn0};
            pg8::gemm_phase<pg8::EpiWin, pg8::StaticOrder, true, true>(L, g, S, E, wave_s);
            if (tail7) {
                const int lane2 = fresh_lane(); LAS float* scr = (LAS float*)(L + wave * 16640);
                for (int it = cx * NWAVES + wave; it < IT_FFNOUT; it += Gx * NWAVES) tr_item(INP(25), DM, W2OUT, FF, 0, MAP_PLAIN, nullptr, it, scr, lane2);
                for (int it = cx * NWAVES + wave; it < 1024; it += Gx * NWAVES) { const int b = it >> 8, t = it & 255; const size_t kr = (size_t)(b & 1) * 4352 + t; const size_t d2 = (b >> 1) ? B_SET2 : 0;
                const f32x4 x = *(const f32x4*)(INP(3) + ((size_t)b * 256 + t) * 256 + 4 * lane2), kn = *(const f32x4*)(INP(18) + 4 * lane2);
                v2u o; o.x = pk2(x[0] / kn[0], x[1] / kn[1]); o.y = pk2(x[2] / kn[2], x[3] / kn[3]); *(v2u*)((char*)(CKV + kr * 256 + 4 * lane2) + d2) = o;
                const int s = lane2 & 31, dim = (lane2 & 32) + 16 * ((s >> 2) & 1) + 4 * (s >> 3) + (s & 3);
                *(bf16*)((char*)(KR + kr * 64 + lane2) + d2) = (bf16)f2bf(INP(4)[((size_t)b * 256 + t) * 64 + dim]); }
            }
        }
        if ((kind == 5 || (kind0 == 4 && chunk0 == 1)) && MK_EN(5)) {
            const int lane = fresh_lane(), tid = wave * 64 + lane; (void)tid;
#if !defined(MK_SUB) || MK_SUB == 0
            { pg8::Gemm g{QL, WQ, TC, NQ, 256, 256}; pg8::StaticOrder S; S.init(TC, NQ, NG, bx); pg8::EpiQ E{Qb, SSQ, rope, chunk};
              pg8::gemm_phase<pg8::EpiQ, pg8::StaticOrder, true, true>(L, g, S, E, wave_s); }
#endif
#if !defined(MK_SUB) || MK_SUB == 1
            { const int Mk = chunk == 0 ? TC : KEYROWS; pg8::Gemm g{CKV, WKV, Mk, NKV, 256, 256}; pg8::StaticOrder S; S.init(Mk, NKV, NG, (bx + 64) % NG);   pg8::EpiKV E{KN, Vb, SSC, chunk};
              pg8::gemm_phase<pg8::EpiKV, pg8::StaticOrder, true, true>(L, g, S, E, wave_s); }
#endif
#if !defined(MK_SUB) || MK_SUB == 2
            if (kind == 5 && chunk == 0 && bx >= 192) {
                LAS float* scr = (LAS float*)(L + wave * 16640);
                for (int it = (bx - 192) * NWAVES + wave; it < 2 * IT_SQ; it += (NG - 192) * NWAVES) {
                    if (it < IT_SQ) tr_item(INP(20), DM, WAB, 2048, 0, MAP_PLAIN, nullptr, it, scr, lane);
                    else            tr_item(INP(21), DM, WAB, 2048, 1024, MAP_PLAIN, nullptr, it - IT_SQ, scr, lane); }
            }
#endif
            if (chunk == 0) for (int m = gw; m < T_CTX; m += NGW) { const f32x4 p = *(const f32x4*)(SSC + (size_t)m * 4); const float rstd = rsqrtf(((p[0] + p[1]) + (p[2] + p[3])) * (1.f / 256.f) + EPS);
                const f32x4 v = *(const f32x4*)(rawckv + (size_t)m * 256 + 4 * lane), kn = *(const f32x4*)(INP(18) + 4 * lane); __builtin_nontemporal_store(v * rstd * kn, (f32x4*)(nckv + (size_t)m * 256 + 4 * lane)); }
            if (chunk == 0) for (int i = gw; i < T_CTX * 64 / 256; i += NGW) __builtin_nontemporal_store(*(const f32x4*)(rawkr + (size_t)i * 256 + 4 * lane), (f32x4*)(nkr + (size_t)i * 256 + 4 * lane));
        } else if (kind == 6 && MK_EN(6)) {
            if (chunk == 0) {
                pg8::Gemm g{XS, WIN + (size_t)2816 * DM, TC, 2048, DM, DM}; pg8::StaticOrder S; S.init(TC, 2048, NG, bx);
                pg8::EpiGate E{ssp2, bias2, GT, 0};
                pg8::gemm_phase<pg8::EpiGate, pg8::StaticOrder, true, true>(L, g, S, E, wave_s);
            }
            for (int u = vcu; u < 256; u += NG) {
                const int b0 = u >> 3, h0 = u & 7, bh = u >> 4, qb = u & 15, j = bh >> 3, h1 = bh & 7;
                const int cq0 = chunk == 0 ? 2 * b0 : j * 32 + qb * 2, hh = chunk == 0 ? h0 : h1;
                gmlp_pair(cq0 * 8 + hh, (cq0 + 1) * 8 + hh, OABC, WSb, SSV, INP(13), INP(15), L, wave_s);
                if (chunk == 0) { const int b = b0, h = h0; const size_t r0 = (size_t)b * 256;
                    att::attn_unit(Qb + r0 * NQ + h * 192, KN + r0 * DM + h * 128, KR + r0 * 64, Vb + r0 * DM + h * 128, OABC + r0 * 2048 + 1024 + h * 128, 256, (char*)lds, wave_s);
                } else { const int h = h1; const size_t q0 = (size_t)j * 4096 + qb * 256, k0 = (size_t)j * 4352;
                    att::attn_unit(Qb + q0 * NQ + h * 192, KN + k0 * DM + h * 128, KR + k0 * 64, Vb + k0 * DM + h * 128, OABC + q0 * 2048 + 1024 + h * 128, 4352, (char*)lds, wave_s); }
            }
        } else if (kind == 7 && MK_EN(7)) {
            const int Mg = chunk ? 2 * TC : TC; pg8::Gemm g{OAB, WAB, Mg, DM, 2048, 2048}; pg8::StaticOrder S; S.init(Mg, DM, Gx, cx); pg8::EpiMerge E{GT};
            if (chunk == 1) {
                pg8::Unit um; if (S.next(0, um)) { pg8::Gemm gg{XS + (size_t)T_CTX * DM, WIN + (size_t)2816 * DM, Mg, 2048, DM, DM}; pg8::StaticOrder Sg; Sg.init(Mg, 2048, NG, bx); Sg.pair = 1; Sg.pm0 = um.pm; Sg.pn0 = um.pn;
                    pg8::EpiGate Eg{ssp2, bias2, GT, 32}; pg8::gemm_phase<pg8::EpiGate, pg8::StaticOrder, true, true>(L, gg, Sg, Eg, wave_s); } }
            pg8::gemm_phase<pg8::EpiMerge, pg8::StaticOrder, true, true>(L, g, S, E, wave_s);
        } else if (kind == 9 && MK_EN(9)) {
            const int lane = fresh_lane(), tid = wave * 64 + lane; (void)tid;
            for (int m0 = 2 * gw; m0 < T_ALL; m0 += 2 * NGW) { const int m1 = m0 + 1;
                const float pa = lane < 16 ? sspf[(size_t)m0 * 16 + lane] : 0.f, pb = lane < 16 ? sspf[(size_t)m1 * 16 + lane] : 0.f; v2u xa[4], xb[4];
#pragma unroll
                for (int j = 0; j < 4; ++j) { const int c = 4 * lane + 256 * j; xa[j] = *(const v2u*)(XS + (size_t)m0 * DM + c); xb[j] = *(const v2u*)(XS + (size_t)m1 * DM + c); }
                const float ra = rsqrtf(wave_sum(pa) * (1.f / DM) + EPS), rb = rsqrtf(wave_sum(pb) * (1.f / DM) + EPS);
#pragma unroll
                for (int j = 0; j < 4; ++j) { const int c = 4 * lane + 256 * j;
                    __builtin_nontemporal_store((f32x4){bflo(xa[j].x), bfhi(xa[j].x), bflo(xa[j].y), bfhi(xa[j].y)} * ra, (f32x4*)(X + (size_t)m0 * DM + c)); }
#pragma unroll
                for (int j = 0; j < 4; ++j) { const int c = 4 * lane + 256 * j;
                    __builtin_nontemporal_store((f32x4){bflo(xb[j].x), bfhi(xb[j].x), bflo(xb[j].y), bfhi(xb[j].y)} * rb, (f32x4*)(X + (size_t)m1 * DM + c)); } }
        }
    }
}

#undef INP
#undef SS2_DELTA
#undef OABC
#undef OUTP
#undef mods
#undef tab
#undef bias1
#undef bias2
#undef bias3
#undef rope
#undef ss1
#undef ssp2
#undef ssp3
#undef sspf
#undef SSV
#undef SSQ
#undef SSC
#undef W1IN
#undef W1OUT
#undef WIN
#undef WQ
#undef WKV
#undef WAB
#undef WO
#undef W2IN
#undef W2OUT
#undef WSb
#undef XS
#undef ACT
#undef OAB
#undef GT
#undef Qb
#undef KN
#undef Vb
#undef QL
#undef CKV
#undef KR
#undef X
#undef nckv
#undef rawckv
#undef rawkr
#undef nkr
#ifndef MK_SPLIT
#define MK_SPLIT 0
#endif
extern "C" void kernel_launch(void* const* d_in, const int* in_sizes, int n_in, void* d_out, int out_size, void* d_ws, size_t ws_size, hipStream_t stream) {
    static int grid = 0;
    if (grid == 0) {
        if (n_in != 27 || ws_size < WS_END || out_size != T_ALL * DM + T_CTX * 256 + T_CTX * 64) { fprintf(stderr, "kernel_launch: unexpected shapes: n_in %d out %d ws %zu (need %zu)\n", n_in, out_size, ws_size, (size_t)WS_END); grid = -1; return; }
        int dev = 0, cus = 0, per_cu = 0;
        if (hipGetDevice(&dev) != hipSuccess || hipDeviceGetAttribute(&cus, hipDeviceAttributeMultiprocessorCount, dev) != hipSuccess) { grid = -1; return; }
        if (hipFuncSetAttribute((const void*)mk_fwd, hipFuncAttributeMaxDynamicSharedMemorySize, LDS_BYTES) != hipSuccess) { fprintf(stderr, "kernel_launch: hipFuncSetAttribute failed\n"); grid = -1; return; }
        if (hipOccupancyMaxActiveBlocksPerMultiprocessor(&per_cu, (const void*)mk_fwd, NWAVES * 64, LDS_BYTES) != hipSuccess || per_cu < 1) { fprintf(stderr, "kernel_launch: occupancy query says %d\n", per_cu); per_cu = 1; }
        (void)hipGetLastError();
        if (cus < 256) { fprintf(stderr, "kernel_launch: built for a 256-CU device (got %d CUs)\n", cus); grid = -1; return; }
        grid = 256;
    }
    if (grid < 0) return;
    KArgs a{};
    for (int i = 0; i < 27; ++i) a.in[i] = (const float*)d_in[i];
    a.out = (float*)d_out; a.ws = (unsigned char*)d_ws;
#if MK_SPLIT
#ifndef MK_SKIP_MASK
#define MK_SKIP_MASK 0u
#endif
    for (int p = 0; p < NPH; ++p) { if ((MK_SKIP_MASK >> p) & 1u) continue; a.ph_lo = p; a.ph_hi = p + 1; hipLaunchKernelGGL(mk_fwd, dim3(grid), dim3(NWAVES * 64), LDS_BYTES, stream, a); }
#else
#ifndef MK_REPEAT_MASK
#define MK_REPEAT_MASK 0
#endif
    a.ph_lo = 0; a.ph_hi = NPH; a.rep_mask = MK_REPEAT_MASK;
    void* args[] = {&a};
    hipError_t e = hipLaunchCooperativeKernel((const void*)mk_fwd, dim3(grid), dim3(NWAVES * 64), args, LDS_BYTES, stream);
    if (e != hipSuccess) fprintf(stderr, "kernel_launch: cooperative launch failed: %s (grid %d)\n", hipGetErrorString(e), grid);
#endif
}
```
